# Optimizing an MI355X kernel written in HIP

```python
import math
import jax
import jax.numpy as jnp
from jax import lax
import numpy as np

D_MODEL = 2048
BATCH = 1
SEQ = 8192
DEPTH = 2

EPS = 1e-6
Q_BLOCK = 128
NEG_INF = -1e30
FORCE = 1e9
NSA_HEADS = 16
NSA_GROUPS = 2
NSA_HPG = NSA_HEADS // NSA_GROUPS
NSA_DK = 64
NSA_DV = 64
NSA_CMP_HID = 64
CMP_LEN = 32
CMP_STRIDE = 16
SLC_LEN = 64
SLC_TOPK = 16
WINDOW = 512
MLA_HEADS = 8
Q_LORA = 512
KV_LORA = 512
QK_NOPE = 128
QK_ROPE = 64
V_HEAD = 128
ROPE_THETA = 10000.0
RWKV_HEAD = 64
RWKV_HEADS = D_MODEL // RWKV_HEAD
DECAY_LORA = 96
A_LORA = 96
LNX_EPS = 64e-5
NSA_Q_W = NSA_HEADS * NSA_DK
NSA_KV_W = 6 * NSA_GROUPS * NSA_DK
NSA_G_W = 3 * NSA_HEADS
NSA_Z_W = NSA_HEADS * NSA_DV
MLA_QA_W = Q_LORA
MLA_KVA_W = KV_LORA + QK_ROPE
MLA_Z_W = MLA_HEADS * V_HEAD
IN0_SIZES = (NSA_Q_W, NSA_KV_W, NSA_G_W, NSA_Z_W, MLA_QA_W, MLA_KVA_W, MLA_Z_W)
IN0_W = NSA_Q_W + NSA_KV_W + NSA_G_W + NSA_Z_W + MLA_QA_W + MLA_KVA_W + MLA_Z_W
MIX0_W = NSA_HEADS * NSA_DV + MLA_HEADS * V_HEAD

kernel_name = "nsa_mla_rwkv7_adaln_hybrid"


def rmsnorm(x, g):
    xf = x.astype(jnp.float32)
    y = xf * lax.rsqrt(jnp.mean(xf * xf, axis=-1, keepdims=True) + EPS)
    return (y * g.astype(jnp.float32)).astype(x.dtype)


def masked_softmax(s, mask, axis=-1):
    s = jnp.where(mask, s.astype(jnp.float32), NEG_INF)
    p = jax.nn.softmax(s, axis=axis)
    return jnp.where(mask, p, 0.0)


def alibi_slopes(n):
    return 2.0 ** (-8.0 * jnp.arange(1, n + 1, dtype=jnp.float32) / n)


def rope_angles(S, dim):
    inv = ROPE_THETA ** (-jnp.arange(0, dim, 2, dtype=jnp.float32) / dim)
    ang = jnp.arange(S, dtype=jnp.float32)[:, None] * inv[None]
    return jnp.cos(ang), jnp.sin(ang)


def apply_rope(x, cos, sin):
    x1, x2 = jnp.split(x.astype(jnp.float32), 2, axis=-1)
    extra = x.ndim - 3
    cos = cos.reshape(cos.shape[0], *([1] * extra), cos.shape[-1])
    sin = sin.reshape(sin.shape[0], *([1] * extra), sin.shape[-1])
    return jnp.concatenate([x1 * cos - x2 * sin, x1 * sin + x2 * cos], axis=-1).astype(x.dtype)


def split_cols(x, sizes):
    offs, acc = [], 0
    for s in sizes[:-1]:
        acc += s
        offs.append(acc)
    return jnp.split(x, offs, axis=-1)


def nsa_attention(q, kc, vc, ks, vs, kw, vw, gates,
                  pe_k, w1_k, b1_k, w2_k, pe_v, w1_v, b1_v, w2_v):
    B, S = q.shape[0], q.shape[1]
    G, HPG, DK = NSA_GROUPS, NSA_HPG, NSA_DK
    n_cmp = (S - CMP_LEN) // CMP_STRIDE + 1
    n_slc = S // SLC_LEN
    top = min(SLC_TOPK, n_slc)
    idx = jnp.arange(n_cmp)[:, None] * CMP_STRIDE + jnp.arange(CMP_LEN)[None]

    def compress(t, pe, w1, b1, w2):
        blk = t[:, idx] + pe[None, None, :, None, :]
        hid = jax.nn.silu(jnp.einsum('bnlgd,lde->bnge', blk, w1) + b1)
        return jnp.einsum('bnge,ed->bngd', hid, w2)

    k_cmp = compress(kc, pe_k, w1_k, b1_k, w2_k)
    v_cmp = compress(vc, pe_v, w1_v, b1_v, w2_v)
    cmp_start = jnp.arange(n_cmp) * CMP_STRIDE
    cmp_end = cmp_start + CMP_LEN - 1
    slc_start = jnp.arange(n_slc) * SLC_LEN
    overlap = ((cmp_start[:, None] < slc_start[None] + SLC_LEN)
               & (cmp_start[:, None] + CMP_LEN > slc_start[None])).astype(jnp.float32)
    ks_blk = ks.reshape(B, n_slc, SLC_LEN, G, DK).transpose(0, 3, 1, 2, 4)
    vs_blk = vs.reshape(B, n_slc, SLC_LEN, G, DK).transpose(0, 3, 1, 2, 4)
    pad = ((0, 0), (WINDOW, 0), (0, 0), (0, 0))
    kw_pad = jnp.pad(kw, pad)
    vw_pad = jnp.pad(vw, pad)
    slopes = alibi_slopes(NSA_HEADS).reshape(G, HPG)
    scale = DK ** -0.5
    qg = q.reshape(B, S, G, HPG, DK)
    gg = gates.reshape(B, S, G, HPG, 3)
    bidx = jnp.arange(B)[:, None, None, None]
    gidx = jnp.arange(G)[None, :, None, None]
    jb = jnp.arange(n_slc)

    def block(nb):
        start = nb * Q_BLOCK
        qb = lax.dynamic_slice_in_dim(qg, start, Q_BLOCK, axis=1)
        gb = lax.dynamic_slice_in_dim(gg, start, Q_BLOCK, axis=1)
        t = start + jnp.arange(Q_BLOCK)
        tf = t.astype(jnp.float32)
        s = jnp.einsum('bqghd,bngd->bghqn', qb, k_cmp).astype(jnp.float32) * scale
        s = s - slopes[None, :, :, None, None] * (tf[:, None] - cmp_end[None].astype(jnp.float32))
        p_cmp = masked_softmax(s, cmp_end[None] <= t[:, None])
        o_cmp = jnp.einsum('bghqn,bngd->bqghd', p_cmp.astype(v_cmp.dtype), v_cmp)
        imp = jnp.einsum('bghqn,nj->bgqj', p_cmp, overlap)
        cur = t // SLC_LEN
        forced = (jb[None] == 0) | (jb[None] == cur[:, None]) | (jb[None] == cur[:, None] - 1)
        imp = jnp.where(forced, FORCE, imp)
        imp = jnp.where(slc_start[None] <= t[:, None], imp, NEG_INF)
        _, sel = lax.top_k(imp, top)
        k_sel = ks_blk[bidx, gidx, sel]
        v_sel = vs_blk[bidx, gidx, sel]
        pos = sel[..., None] * SLC_LEN + jnp.arange(SLC_LEN)
        dist = t[None, None, :, None, None] - pos
        s = jnp.einsum('bqghd,bgqnld->bghqnl', qb, k_sel).astype(jnp.float32) * scale
        s = s - slopes[None, :, :, None, None, None] * dist[:, :, None].astype(jnp.float32)
        p = masked_softmax(s, (dist >= 0)[:, :, None], axis=(-2, -1))
        o_slc = jnp.einsum('bghqnl,bgqnld->bqghd', p.astype(v_sel.dtype), v_sel)
        kwb = lax.dynamic_slice_in_dim(kw_pad, start, WINDOW + Q_BLOCK, axis=1)
        vwb = lax.dynamic_slice_in_dim(vw_pad, start, WINDOW + Q_BLOCK, axis=1)
        spos = start - WINDOW + jnp.arange(WINDOW + Q_BLOCK)
        d = t[:, None] - spos[None]
        s = jnp.einsum('bqghd,bkgd->bghqk', qb, kwb).astype(jnp.float32) * scale
        s = s - slopes[None, :, :, None, None] * d.astype(jnp.float32)
        mw = (d >= 0) & (d < WINDOW) & (spos[None] >= 0)
        p = masked_softmax(s, mw)
        o_win = jnp.einsum('bghqk,bkgd->bqghd', p.astype(vwb.dtype), vwb)
        return gb[..., 0:1] * o_cmp + gb[..., 1:2] * o_slc + gb[..., 2:3] * o_win

    out = lax.map(block, jnp.arange(S // Q_BLOCK))
    return out.transpose(1, 0, 2, 3, 4, 5).reshape(B, S, NSA_HEADS * NSA_DV)


def mla_attention(q_a, kv_a, qa_g, w_qb, kva_g, w_kvb):
    B, S = q_a.shape[0], q_a.shape[1]
    q = (rmsnorm(q_a, qa_g) @ w_qb).reshape(B, S, MLA_HEADS, QK_NOPE + QK_ROPE)
    q_nope, q_pe = q[..., :QK_NOPE], q[..., QK_NOPE:]
    c_kv, k_pe = kv_a[..., :KV_LORA], kv_a[..., KV_LORA:]
    kv = (rmsnorm(c_kv, kva_g) @ w_kvb).reshape(B, S, MLA_HEADS, QK_NOPE + V_HEAD)
    k_nope, v = kv[..., :QK_NOPE], kv[..., QK_NOPE:]
    cos, sin = rope_angles(S, QK_ROPE)
    q_pe = apply_rope(q_pe, cos, sin)
    k_pe = apply_rope(k_pe, cos, sin)
    scale = (QK_NOPE + QK_ROPE) ** -0.5
    kpos = jnp.arange(S)

    def block(nb):
        start = nb * Q_BLOCK
        qn = lax.dynamic_slice_in_dim(q_nope, start, Q_BLOCK, axis=1)
        qp = lax.dynamic_slice_in_dim(q_pe, start, Q_BLOCK, axis=1)
        t = start + jnp.arange(Q_BLOCK)
        s = (jnp.einsum('bqhd,bkhd->bhqk', qn, k_nope)
             + jnp.einsum('bqhd,bkd->bhqk', qp, k_pe)).astype(jnp.float32) * scale
        p = masked_softmax(s, kpos[None] <= t[:, None])
        return jnp.einsum('bhqk,bkhd->bqhd', p.astype(v.dtype), v)

    out = lax.map(block, jnp.arange(S // Q_BLOCK))
    return out.transpose(1, 0, 2, 3, 4).reshape(B, S, MLA_HEADS * V_HEAD)


def hybrid_attention_mixer(h, w_in, w_out, pe_k, w1_k, b1_k, w2_k, pe_v, w1_v, b1_v, w2_v,
                           qa_g, w_qb, kva_g, w_kvb):
    B, S, _ = h.shape
    proj = h @ w_in
    nsa_q, nsa_kv, nsa_g, nsa_z, mla_qa, mla_kva, mla_z = split_cols(proj, IN0_SIZES)
    q = nsa_q.reshape(B, S, NSA_HEADS, NSA_DK)
    kv6 = nsa_kv.reshape(B, S, 6, NSA_GROUPS, NSA_DK)
    gates = jax.nn.sigmoid(nsa_g).reshape(B, S, NSA_HEADS, 3)
    o_nsa = nsa_attention(q, kv6[:, :, 0], kv6[:, :, 1], kv6[:, :, 2], kv6[:, :, 3],
                          kv6[:, :, 4], kv6[:, :, 5], gates,
                          pe_k, w1_k, b1_k, w2_k, pe_v, w1_v, b1_v, w2_v)
    o_mla = mla_attention(mla_qa, mla_kva, qa_g, w_qb, kva_g, w_kvb)
    y = jnp.concatenate([o_nsa * jax.nn.silu(nsa_z), o_mla * jax.nn.silu(mla_z)], axis=-1)
    return y @ w_out


def rwkv7_mixer(h, mu, w_r, w_k, w_v, w_z, w_o, w0, w1, w2, a0, a1, a2, k_k, k_a, r_k, lnx_g, lnx_b):
    B, S, D = h.shape
    H, N = RWKV_HEADS, RWKV_HEAD
    xx = jnp.pad(h, ((0, 0), (1, 0), (0, 0)))[:, :-1] - h
    xr, xw, xk, xv, xa, xz = [h + xx * mu[i] for i in range(6)]
    r = xr @ w_r
    k = xk @ w_k
    v = xv @ w_v
    z = xz @ w_z
    w = -jax.nn.softplus(-(w0 + jnp.tanh(xw @ w1) @ w2)) - 0.5
    decay = jnp.exp(-jnp.exp(w.astype(jnp.float32)))
    a = jax.nn.sigmoid(a0 + (xa @ a1) @ a2)

    def heads(t):
        return t.reshape(B, S, H, N).astype(jnp.float32)

    kk = heads(k * k_k)
    kk = kk / jnp.maximum(jnp.sqrt(jnp.sum(kk * kk, axis=-1, keepdims=True)), 1e-12)
    k = k * (1.0 + (a - 1.0) * k_a)
    r_h, k_h, v_h, a_h, w_h = heads(r), heads(k), heads(v), heads(a), heads(decay)

    def step(state, inp):
        r_t, w_t, k_t, v_t, kk_t, a_t = inp
        sa = jnp.einsum('bhvk,bhk->bhv', state, -kk_t)
        state = (state * w_t[:, :, None, :] + sa[..., None] * (kk_t * a_t)[:, :, None, :]
                 + v_t[..., None] * k_t[:, :, None, :])
        return state, jnp.einsum('bhvk,bhk->bhv', state, r_t)

    xs = tuple(t.transpose(1, 0, 2, 3) for t in (r_h, w_h, k_h, v_h, kk, a_h))
    s0 = jnp.zeros((B, H, N, N), jnp.float32)
    _, y = lax.scan(step, s0, xs)
    y = y.transpose(1, 0, 2, 3)
    mean = jnp.mean(y, axis=-1, keepdims=True)
    var = jnp.mean((y - mean) ** 2, axis=-1, keepdims=True)
    y = ((y - mean) * lax.rsqrt(var + LNX_EPS)).reshape(B, S, D) * lnx_g + lnx_b
    bonus = jnp.sum(r_h * k_h * r_k.reshape(H, N), axis=-1, keepdims=True) * v_h
    y = y + bonus.reshape(B, S, D)
    y = (y * jax.nn.silu(z.astype(jnp.float32))).astype(h.dtype)
    return y @ w_o


def setup_inputs(seed: int = 0) -> dict:
    key = jax.random.key(seed)
    keys = iter(jax.random.split(key, 64))
    D = D_MODEL
    E = (DEPTH + 1) // 2
    O = DEPTH // 2

    def nrm(shape, scale):
        return jax.random.normal(next(keys), shape, jnp.float32) * scale

    def uni(shape, lo, hi):
        return jax.random.uniform(next(keys), shape, jnp.float32, lo, hi)

    L, DK, HID = CMP_LEN, NSA_DK, NSA_CMP_HID
    return {
        "x": nrm((BATCH, SEQ, D), 1.0),
        "c": nrm((BATCH, D), 1.0),
        "norm_g": 1.0 + nrm((DEPTH, D), 0.02),
        "ada_w": nrm((DEPTH, D, 3 * D), D ** -0.5),
        "ada_b": nrm((DEPTH, 3 * D), 0.02),
        "final_g": 1.0 + nrm((D,), 0.02),
        "a_w_in": nrm((E, D, IN0_W), D ** -0.5),
        "a_w_out": nrm((E, MIX0_W, D), MIX0_W ** -0.5),
        "nsa_pe_k": nrm((E, L, DK), 0.5),
        "nsa_w1_k": nrm((E, L, DK, HID), (L * DK) ** -0.5),
        "nsa_b1_k": nrm((E, HID), 0.02),
        "nsa_w2_k": nrm((E, HID, DK), HID ** -0.5),
        "nsa_pe_v": nrm((E, L, DK), 0.5),
        "nsa_w1_v": nrm((E, L, DK, HID), (L * DK) ** -0.5),
        "nsa_b1_v": nrm((E, HID), 0.02),
        "nsa_w2_v": nrm((E, HID, DK), HID ** -0.5),
        "mla_qa_g": 1.0 + nrm((E, Q_LORA), 0.02),
        "mla_w_qb": nrm((E, Q_LORA, MLA_HEADS * (QK_NOPE + QK_ROPE)), Q_LORA ** -0.5),
        "mla_kva_g": 1.0 + nrm((E, KV_LORA), 0.02),
        "mla_w_kvb": nrm((E, KV_LORA, MLA_HEADS * (QK_NOPE + V_HEAD)), KV_LORA ** -0.5),
        "r_mu": uni((O, 6, D), 0.0, 1.0),
        "r_w_r": nrm((O, D, D), D ** -0.5),
        "r_w_k": nrm((O, D, D), D ** -0.5),
        "r_w_v": nrm((O, D, D), D ** -0.5),
        "r_w_z": nrm((O, D, D), D ** -0.5),
        "r_w_o": nrm((O, D, D), D ** -0.5),
        "r_w0": uni((O, D), -6.0, 1.0),
        "r_w1": nrm((O, D, DECAY_LORA), D ** -0.5),
        "r_w2": nrm((O, DECAY_LORA, D), 0.1 * DECAY_LORA ** -0.5),
        "r_a0": nrm((O, D), 0.1),
        "r_a1": nrm((O, D, A_LORA), D ** -0.5),
        "r_a2": nrm((O, A_LORA, D), 0.1 * A_LORA ** -0.5),
        "r_k_k": 0.85 + nrm((O, D), 0.05),
        "r_k_a": 1.0 + nrm((O, D), 0.05),
        "r_r_k": nrm((O, D), 0.1),
        "r_lnx_g": 1.0 + nrm((O, D), 0.02),
        "r_lnx_b": nrm((O, D), 0.02),
    }


def reference(x, c, norm_g, ada_w, ada_b, final_g,
              a_w_in, a_w_out, nsa_pe_k, nsa_w1_k, nsa_b1_k, nsa_w2_k,
              nsa_pe_v, nsa_w1_v, nsa_b1_v, nsa_w2_v,
              mla_qa_g, mla_w_qb, mla_kva_g, mla_w_kvb,
              r_mu, r_w_r, r_w_k, r_w_v, r_w_z, r_w_o, r_w0, r_w1, r_w2,
              r_a0, r_a1, r_a2, r_k_k, r_k_a, r_r_k, r_lnx_g, r_lnx_b):
    sc = jax.nn.silu(c)
    for i in range(DEPTH):
        mod = (sc @ ada_w[i] + ada_b[i])[:, None, :]
        shift, scale, gate = jnp.split(mod, 3, axis=-1)
        h = rmsnorm(x, norm_g[i]) * (1.0 + scale) + shift
        j = i // 2
        if i % 2 == 0:
            y = hybrid_attention_mixer(h, a_w_in[j], a_w_out[j],
                                       nsa_pe_k[j], nsa_w1_k[j], nsa_b1_k[j], nsa_w2_k[j],
                                       nsa_pe_v[j], nsa_w1_v[j], nsa_b1_v[j], nsa_w2_v[j],
                                       mla_qa_g[j], mla_w_qb[j], mla_kva_g[j], mla_w_kvb[j])
        else:
            y = rwkv7_mixer(h, r_mu[j], r_w_r[j], r_w_k[j], r_w_v[j], r_w_z[j], r_w_o[j],
                            r_w0[j], r_w1[j], r_w2[j], r_a0[j], r_a1[j], r_a2[j],
                            r_k_k[j], r_k_a[j], r_r_k[j], r_lnx_g[j], r_lnx_b[j])
        x = x + gate * y
    return rmsnorm(x, final_g)
```

```cpp
#include <hip/hip_runtime.h>
#include <hip/hip_cooperative_groups.h>
#include <stdint.h>
#include <stdio.h>
namespace cg = cooperative_groups;

typedef unsigned short bf16_t;
using bf16x8 = __attribute__((ext_vector_type(8))) short;
using f32x4 = __attribute__((ext_vector_type(4))) float;

#ifndef PROBE
#define PROBE 0
#endif
#define S_ 8192
#define D_ 2048
#define NTHR 512

struct Params {
  const float* in[37];
  float* out;
  char* ws;
};
typedef const __attribute__((address_space(4))) Params* KP;

constexpr size_t MBy = 1u << 20;
constexpr size_t O_MODP = 0;
constexpr size_t O_MOD = 393216;
constexpr size_t O_CTR = 442368;
constexpr size_t O_CPE = 442624;
constexpr size_t O_W2T = 443392;
constexpr size_t O_HID = 459776;
constexpr size_t O_KCMP = 721920;
constexpr size_t O_VCMPT = 852992;
constexpr size_t O_BON = 984064;
constexpr size_t O_BAR = 2032640;
constexpr size_t O_WT_IN = 2 * MBy;
constexpr size_t O_WT_OUT = O_WT_IN + 20447232;
constexpr size_t O_WT_QB = O_WT_OUT + 8388608;
constexpr size_t O_WT_KVB = O_WT_QB + 1572864;
constexpr size_t O_W1T = O_WT_KVB + 2097152;
constexpr size_t O_WT_R = 34 * MBy;
constexpr size_t O_WT_K = 42 * MBy;
constexpr size_t O_WT_V = 50 * MBy;
constexpr size_t O_WT_Z = 58 * MBy;
constexpr size_t O_WT_O = 66 * MBy;
constexpr size_t O_WT_W1 = 74 * MBy;
constexpr size_t O_WT_A1 = O_WT_W1 + 524288;
constexpr size_t O_WT_W2 = O_WT_A1 + 524288;
constexpr size_t O_WT_A2 = O_WT_W2 + 524288;
constexpr size_t O_H0 = 76 * MBy;
constexpr size_t O_QN = 108 * MBy;
constexpr size_t O_KC = 124 * MBy;
constexpr size_t O_VC = O_KC + 2 * MBy + 65536;
constexpr size_t O_KS = O_VC + 2 * MBy + 65536;
constexpr size_t O_KW = O_KS + 2 * MBy;
constexpr size_t O_VST = O_KW + 2 * MBy;
constexpr size_t O_VWT = O_VST + 2 * MBy;
constexpr size_t O_ZN = 137 * MBy;
constexpr size_t O_ZM = 153 * MBy;
constexpr size_t O_QA = 169 * MBy;
constexpr size_t O_CKV = 177 * MBy;
constexpr size_t O_KPE = 185 * MBy;
constexpr size_t O_GATES = 187 * MBy;
constexpr size_t O_QM = 189 * MBy;
constexpr size_t O_KM = 213 * MBy;
constexpr size_t O_VMT = 237 * MBy;
constexpr size_t O_Y = 253 * MBy;
constexpr size_t O_ROPE = 285 * MBy;
constexpr size_t O_H1 = 76 * MBy;
constexpr size_t O_XK = 204 * MBy;
constexpr size_t O_XV = 236 * MBy;
constexpr size_t O_XZ = 268 * MBy;
constexpr size_t O_XW = 336 * MBy;
constexpr size_t O_XA = 2 * MBy;
constexpr size_t O_R = 108 * MBy;
constexpr size_t O_K = 140 * MBy;
constexpr size_t O_V = 172 * MBy;
constexpr size_t O_AB = 204 * MBy;
constexpr size_t O_LOGW = 236 * MBy;
constexpr size_t O_ZS = 300 * MBy;
constexpr size_t O_LW = 332 * MBy;
constexpr size_t O_LA = 334 * MBy;
constexpr size_t O_YRAW = 336 * MBy;
constexpr size_t O_S0 = 336 * MBy;
constexpr size_t O_CHP = 2 * MBy;
constexpr size_t O_CHQ = 34 * MBy;
constexpr size_t O_CHG = 76 * MBy;
constexpr size_t O_CHY = 92 * MBy;
constexpr size_t O_YR = 108 * MBy;
constexpr size_t WS_NEED = 368 * MBy;

constexpr int LDS_BYTES = 9 * 64 * 65 * 4 + 1024;

__device__ __forceinline__ int get_tid() { int t = threadIdx.x; asm volatile("" : "+v"(t)); return t; }
__device__ __forceinline__ float bf2f(bf16_t b) { return __uint_as_float(((uint32_t)b) << 16); }
typedef float float2_t __attribute__((ext_vector_type(2)));
typedef __bf16 bf16x2v __attribute__((ext_vector_type(2)));
__device__ __forceinline__ uint32_t pack2(float a, float b) {
  float2_t f = {a, b};
  bf16x2v h = __builtin_convertvector(f, bf16x2v);
  return *(uint32_t*)&h;
}
__device__ __forceinline__ bf16_t f2bf(float f) { return (bf16_t)(pack2(f, 0.f) & 0xffffu); }
__device__ __forceinline__ float siluf(float x) { return x / (1.f + __expf(-x)); }
__device__ __forceinline__ float sigmf(float x) { return 1.f / (1.f + __expf(-x)); }
__device__ __forceinline__ void unpack8(uint4 v, float* f) {
  f[0] = __uint_as_float(v.x << 16); f[1] = __uint_as_float(v.x & 0xffff0000u);
  f[2] = __uint_as_float(v.y << 16); f[3] = __uint_as_float(v.y & 0xffff0000u);
  f[4] = __uint_as_float(v.z << 16); f[5] = __uint_as_float(v.z & 0xffff0000u);
  f[6] = __uint_as_float(v.w << 16); f[7] = __uint_as_float(v.w & 0xffff0000u);
}
__device__ __forceinline__ f32x4 mfma_bf16(bf16x8 a, bf16x8 b, f32x4 c) {
  return __builtin_amdgcn_mfma_f32_16x16x32_bf16(a, b, c, 0, 0, 0);
}
__device__ __forceinline__ float wave_sum(float v) {
#pragma unroll
  for (int o = 32; o > 0; o >>= 1) v += __shfl_xor(v, o);
  return v;
}

template <int AMODE, class Epi, class EpiS = int>
__device__ __forceinline__ void gemm_tile(const bf16_t* __restrict__ A, int lda, const bf16_t* __restrict__ Bt, int ldb,
                                          int K, int m0, int n0, char* smem, const float* __restrict__ mu, Epi epi, EpiS epiS = 0) {
  bf16_t* As = (bf16_t*)smem;
  const int tid = get_tid(), lane = tid & 63, wave = tid >> 6;
  const int wm = wave >> 1, wn = wave & 1, r = lane & 15, quad = lane >> 4;
  f32x4 acc[4][4];
#pragma unroll
  for (int i = 0; i < 4; i++)
#pragma unroll
    for (int j = 0; j < 4; j++) acc[i][j] = f32x4{0.f, 0.f, 0.f, 0.f};
  const int lrow = tid >> 3, lkc = (tid & 7) * 8;
  const int lsw = ((tid & 7) ^ (lrow & 7)) * 8;
  const int rsw0 = ((quad) ^ (r & 7)) * 8, rsw1 = ((4 + quad) ^ (r & 7)) * 8;
  uint4 xa0, xa1, xa2, xa3, xp0, xp1, xp2, xp3, xb0, xb1;
  const bf16_t* abase = A + (size_t)(m0 + lrow) * lda + lkc;
  const bf16_t* bbase = Bt + (size_t)(n0 + lrow) * ldb + lkc;
  const bool row0zero = (AMODE == 1) && (m0 + lrow == 0);
#define GL1(dst_, dstp_, i_, k0_)                                                     \
  {                                                                                   \
    const bf16_t* ap_ = abase + (size_t)(64 * (i_)) * lda + (k0_);                    \
    dst_ = *(const uint4*)ap_;                                                        \
    if (AMODE == 1) {                                                                 \
      if ((i_) == 0 && row0zero) dstp_ = uint4{0, 0, 0, 0};                           \
      else dstp_ = *(const uint4*)(ap_ - lda);                                        \
    }                                                                                 \
  }
#define GLOADS(...) GLOADS_(__VA_ARGS__)
#define GLOADS_(a0, a1, a2, a3, p0, p1, p2, p3, b0, b1, k0_)                           \
  {                                                                                   \
    __builtin_amdgcn_sched_barrier(0);                                                \
    GL1(a0, p0, 0, k0_) GL1(a1, p1, 1, k0_) GL1(a2, p2, 2, k0_) GL1(a3, p3, 3, k0_)   \
    b0 = *(const uint4*)(bbase + (k0_));                                              \
    b1 = *(const uint4*)(bbase + (size_t)64 * ldb + (k0_));                           \
    __builtin_amdgcn_sched_barrier(0);                                                \
  }
#define GS1(src_, srcp_, i_, As_, k0_)                                                                    \
  {                                                                                                       \
    uint4 v = src_;                                                                                       \
    if (AMODE == 1) {                                                                                     \
      float h[8], hp[8];                                                                                  \
      unpack8(src_, h);                                                                                   \
      unpack8(srcp_, hp);                                                                                 \
      const float4 m0v = *(const float4*)(mu + (k0_) + lkc);                                              \
      const float4 m1v = *(const float4*)(mu + (k0_) + lkc + 4);                                          \
      float o0 = h[0] + (hp[0] - h[0]) * m0v.x, o1 = h[1] + (hp[1] - h[1]) * m0v.y;                       \
      float o2 = h[2] + (hp[2] - h[2]) * m0v.z, o3 = h[3] + (hp[3] - h[3]) * m0v.w;                       \
      float o4 = h[4] + (hp[4] - h[4]) * m1v.x, o5 = h[5] + (hp[5] - h[5]) * m1v.y;                       \
      float o6 = h[6] + (hp[6] - h[6]) * m1v.z, o7 = h[7] + (hp[7] - h[7]) * m1v.w;                       \
      v.x = pack2(o0, o1); v.y = pack2(o2, o3); v.z = pack2(o4, o5); v.w = pack2(o6, o7);                 \
    }                                                                                                     \
    *(uint4*)(As_ + (lrow + 64 * (i_)) * 64 + lsw) = v;                                                   \
  }
#define GSTORES(...) GSTORES_(__VA_ARGS__)
#define GSTORES_(a0, a1, a2, a3, p0, p1, p2, p3, b0, b1, bi_, k0_)                      \
  {                                                                                   \
    bf16_t* As_ = As + (bi_) * (384 * 64);                                            \
    bf16_t* Bs_ = As_ + 256 * 64;                                                     \
    GS1(a0, p0, 0, As_, k0_) GS1(a1, p1, 1, As_, k0_) GS1(a2, p2, 2, As_, k0_) GS1(a3, p3, 3, As_, k0_) \
    *(uint4*)(Bs_ + lrow * 64 + lsw) = b0;                                            \
    *(uint4*)(Bs_ + (lrow + 64) * 64 + lsw) = b1;                                     \
  }
#define SET0 xa0, xa1, xa2, xa3, xp0, xp1, xp2, xp3, xb0, xb1
#define SET1 ya0, ya1, ya2, ya3, yp0, yp1, yp2, yp3, yb0, yb1
#define GCOMPUTE(bi_)                                                                                          \
  {                                                                                                            \
    const bf16_t* Ac = As + (bi_) * (384 * 64) + (wm * 64 + r) * 64;                                           \
    const bf16_t* Bc = As + (bi_) * (384 * 64) + 256 * 64 + (wn * 64 + r) * 64;                                \
    bf16x8 af0[4], bf0[4], af1[4], bf1[4];                                                                     \
    _Pragma("unroll") for (int mt = 0; mt < 4; mt++) af0[mt] = *(const bf16x8*)(Ac + mt * 1024 + rsw0);        \
    _Pragma("unroll") for (int nt = 0; nt < 4; nt++) bf0[nt] = *(const bf16x8*)(Bc + nt * 1024 + rsw0);        \
    _Pragma("unroll") for (int mt = 0; mt < 4; mt++) af1[mt] = *(const bf16x8*)(Ac + mt * 1024 + rsw1);        \
    _Pragma("unroll") for (int nt = 0; nt < 4; nt++) bf1[nt] = *(const bf16x8*)(Bc + nt * 1024 + rsw1);        \
    _Pragma("unroll") for (int mt = 0; mt < 4; mt++)                                                           \
      _Pragma("unroll") for (int nt = 0; nt < 4; nt++) acc[mt][nt] = mfma_bf16(af0[mt], bf0[nt], acc[mt][nt]); \
    _Pragma("unroll") for (int mt = 0; mt < 4; mt++)                                                           \
      _Pragma("unroll") for (int nt = 0; nt < 4; nt++) acc[mt][nt] = mfma_bf16(af1[mt], bf1[nt], acc[mt][nt]); \
  }
  const int nk = K >> 6;
  const int lastk = (nk - 1) * 64;
  GLOADS(SET0, 0);
  GSTORES(SET0, 0, 0);
  { const int kk1 = min(64, lastk); GLOADS(SET0, kk1); }
  __syncthreads();
  for (int it = 0; it < nk; it += 2) {
    if (it + 1 < nk) {
      const int ka = (it + 1) * 64, kb2 = min((it + 2) * 64, lastk);
      GSTORES(SET0, 1, ka);
      GLOADS(SET0, kb2);
    }
    GCOMPUTE(0);
    __syncthreads();
    if (it + 1 < nk) {
      const int ka = min((it + 2) * 64, lastk), kb2 = min((it + 3) * 64, lastk);
      GSTORES(SET0, 0, ka);
      GLOADS(SET0, kb2);
      GCOMPUTE(1);
      __syncthreads();
    }
  }
  epi(acc, m0 + wm * 64, n0 + wn * 64);
  if constexpr (!__is_same(EpiS, int)) {
    float* Cs = (float*)smem;
#pragma unroll
    for (int mt = 0; mt < 4; mt++)
#pragma unroll
      for (int nt = 0; nt < 4; nt++)
#pragma unroll
        for (int i = 0; i < 4; i++) Cs[(wm * 64 + mt * 16 + quad * 4 + i) * 132 + wn * 64 + nt * 16 + r] = acc[mt][nt][i];
    __syncthreads();
    epiS(Cs, m0, n0, tid);
    __syncthreads();
  }
}
#define STAGE_LOOP8(row, c8, va, vb)                        \
  for (int e_ = tid; e_ < 256 * 16; e_ += NTHR) {           \
    const int row = e_ >> 4, c8 = (e_ & 15) * 8;            \
    const float4 va = *(const float4*)(Cs + row * 132 + c8); \
    const float4 vb = *(const float4*)(Cs + row * 132 + c8 + 4);
#define STAGE_LOOP4(row, c4, va)                            \
  for (int e_ = tid; e_ < 256 * 32; e_ += NTHR) {           \
    const int row = e_ >> 5, c4 = (e_ & 31) * 4;            \
    const float4 va = *(const float4*)(Cs + row * 132 + c4);
#define STAGE_END }
__device__ __forceinline__ uint4 pack8(float4 a, float4 b) {
  uint4 u;
  u.x = pack2(a.x, a.y); u.y = pack2(a.z, a.w); u.z = pack2(b.x, b.y); u.w = pack2(b.z, b.w);
  return u;
}

__device__ __forceinline__ int g8_lds_byte(int r, int c) {
  int st = (r >> 4) * 2 + (c >> 5), rr = r & 15, cc = c & 31, ob = rr * 64 + cc * 2;
  return st * 1024 + (ob ^ (((ob >> 9) & 1) << 5));
}
__device__ __forceinline__ void g8_stage_rc(int b, int& R, int& C) {
  int st = b / 1024, sb = b % 1024, swz = sb ^ (((sb >> 9) & 1) << 5);
  R = (st >> 1) * 16 + swz / 64;
  C = (st & 1) * 32 + (swz % 64) / 2;
}
template <class EpiS>
__device__ __forceinline__ void gemm256_tile(const bf16_t* __restrict__ A, int lda, const bf16_t* __restrict__ Bt, int ldb, int K,
                                             int brow, int bcol, char* smem, EpiS epiS) {
  constexpr int G8_HT = 128 * 64;
  bf16_t* shm = (bf16_t*)smem;
  typedef __attribute__((address_space(1))) const void* gptr_t;
  typedef __attribute__((address_space(3))) void* lptr_t;
  const int tid = get_tid();
  const int wid = tid >> 6, lane = tid & 63, wr = wid >> 2, wc = wid & 3, fr = lane & 15, fq = lane >> 4;
  unsigned oa0, oa1, ob0, ob1;
  {
    int sr0, sc0, sr1, sc1;
    g8_stage_rc(tid * 16, sr0, sc0);
    g8_stage_rc(tid * 16 + 8192, sr1, sc1);
    oa0 = (unsigned)(sr0 * lda + sc0); oa1 = (unsigned)(sr1 * lda + sc1);
    ob0 = (unsigned)(sr0 * ldb + sc0); ob1 = (unsigned)(sr1 * ldb + sc1);
  }
#define G8_SA(b, h) (shm + ((b) * 2 + (h)) * G8_HT)
#define G8_SB(b, h) (shm + (4 + (b) * 2 + (h)) * G8_HT)
#define G8_STAGE(P, BASE, LD, br, kt, O0, O1)                                                                      \
  do {                                                                                                             \
    const bf16_t* g_ = (BASE) + (size_t)(br) * (LD) + (size_t)(kt) * 64;                                           \
    __builtin_amdgcn_global_load_lds((gptr_t)(g_ + O0), (lptr_t)((char*)(P) + tid * 16), 16, 0, 0);               \
    __builtin_amdgcn_global_load_lds((gptr_t)(g_ + O1), (lptr_t)((char*)(P) + tid * 16 + 8192), 16, 0, 0);        \
  } while (0)
#define G8_LDA(dst, b, h)                                                                                          \
  _Pragma("unroll") for (int m = 0; m < 4; ++m) _Pragma("unroll") for (int k = 0; k < 2; ++k)                      \
    dst[m][k] = *reinterpret_cast<const bf16x8*>((char*)G8_SA(b, h) + g8_lds_byte(wr * 64 + m * 16 + fr, k * 32 + fq * 8))
#define G8_LDB(dst, b, h)                                                                                          \
  _Pragma("unroll") for (int n = 0; n < 2; ++n) _Pragma("unroll") for (int k = 0; k < 2; ++k)                      \
    dst[n][k] = *reinterpret_cast<const bf16x8*>((char*)G8_SB(b, h) + g8_lds_byte(wc * 32 + n * 16 + fr, k * 32 + fq * 8))
#define G8_MMA(ai, bj, At_, Bt_)                                                                                   \
  do {                                                                                                             \
    __builtin_amdgcn_s_setprio(1);                                                                                 \
    _Pragma("unroll") for (int m = 0; m < 4; ++m) _Pragma("unroll") for (int n = 0; n < 2; ++n)                    \
      _Pragma("unroll") for (int k = 0; k < 2; ++k)                                                                \
        acc[ai][bj][m][n] = __builtin_amdgcn_mfma_f32_16x16x32_bf16(At_[m][k], Bt_[n][k], acc[ai][bj][m][n], 0, 0, 0); \
    __builtin_amdgcn_s_setprio(0);                                                                                 \
  } while (0)
#define G8_WAIT_V(n) asm volatile("s_waitcnt vmcnt(" #n ")" ::: "memory")
#define G8_WAIT_L(n) asm volatile("s_waitcnt lgkmcnt(" #n ")" ::: "memory")
#define G8_BAR __builtin_amdgcn_s_barrier()
#define G8_SCHED __builtin_amdgcn_sched_barrier(0)
  f32x4 acc[2][2][4][2];
#pragma unroll
  for (int a_ = 0; a_ < 2; a_++)
#pragma unroll
    for (int b_ = 0; b_ < 2; b_++)
#pragma unroll
      for (int m = 0; m < 4; m++)
#pragma unroll
        for (int n = 0; n < 2; n++) acc[a_][b_][m][n] = f32x4{0.f, 0.f, 0.f, 0.f};
  bf16x8 At[4][2], B0[2][2], B1[2][2];
  const int nt = K / 64;
  __syncthreads();
  G8_STAGE(G8_SB(0, 0), Bt, ldb, bcol, 0, ob0, ob1); G8_STAGE(G8_SA(0, 0), A, lda, brow, 0, oa0, oa1);
  G8_STAGE(G8_SB(0, 1), Bt, ldb, bcol + 128, 0, ob0, ob1); G8_STAGE(G8_SA(0, 1), A, lda, brow + 128, 0, oa0, oa1);
  if (wr == 1) G8_BAR;
  G8_WAIT_V(4); G8_BAR;
  G8_STAGE(G8_SB(1, 0), Bt, ldb, bcol, 1, ob0, ob1); G8_STAGE(G8_SA(1, 0), A, lda, brow, 1, oa0, oa1); G8_STAGE(G8_SB(1, 1), Bt, ldb, bcol + 128, 1, ob0, ob1);
  G8_WAIT_V(6); G8_BAR;
  for (int t = 0; t < nt - 2; t += 2) {
    G8_LDB(B0, 0, 0); G8_SCHED; G8_LDA(At, 0, 0); G8_STAGE(G8_SA(1, 1), A, lda, brow + 128, t + 1, oa0, oa1);
    G8_WAIT_L(8); G8_BAR; G8_WAIT_L(0); G8_MMA(0, 0, At, B0); G8_BAR; G8_SCHED;
    G8_LDB(B1, 0, 1); G8_STAGE(G8_SB(0, 0), Bt, ldb, bcol, t + 2, ob0, ob1);
    G8_BAR; G8_WAIT_L(0); G8_MMA(0, 1, At, B1); G8_BAR;
    G8_LDA(At, 0, 1); G8_STAGE(G8_SA(0, 0), A, lda, brow, t + 2, oa0, oa1);
    G8_BAR; G8_WAIT_L(0); G8_MMA(1, 0, At, B0); G8_BAR; G8_SCHED;
    G8_STAGE(G8_SB(0, 1), Bt, ldb, bcol + 128, t + 2, ob0, ob1);
    G8_WAIT_V(6); G8_BAR; G8_MMA(1, 1, At, B1); G8_BAR;
    G8_LDB(B0, 1, 0); G8_SCHED; G8_LDA(At, 1, 0); G8_STAGE(G8_SA(0, 1), A, lda, brow + 128, t + 2, oa0, oa1);
    G8_WAIT_L(8); G8_BAR; G8_WAIT_L(0); G8_MMA(0, 0, At, B0); G8_BAR; G8_SCHED;
    G8_LDB(B1, 1, 1); G8_STAGE(G8_SB(1, 0), Bt, ldb, bcol, t + 3, ob0, ob1);
    G8_BAR; G8_WAIT_L(0); G8_MMA(0, 1, At, B1); G8_BAR;
    G8_LDA(At, 1, 1); G8_STAGE(G8_SA(1, 0), A, lda, brow, t + 3, oa0, oa1);
    G8_BAR; G8_WAIT_L(0); G8_MMA(1, 0, At, B0); G8_BAR; G8_SCHED;
    G8_STAGE(G8_SB(1, 1), Bt, ldb, bcol + 128, t + 3, ob0, ob1);
    G8_WAIT_V(6); G8_BAR; G8_MMA(1, 1, At, B1); G8_BAR;
  }
  { G8_LDB(B0, 0, 0); G8_LDA(At, 0, 0); G8_STAGE(G8_SA(1, 1), A, lda, brow + 128, nt - 1, oa0, oa1);
    G8_BAR; G8_WAIT_L(0); G8_MMA(0, 0, At, B0); G8_BAR;
    G8_LDB(B1, 0, 1); G8_BAR; G8_WAIT_L(0); G8_MMA(0, 1, At, B1); G8_BAR;
    G8_LDA(At, 0, 1); G8_WAIT_V(4); G8_BAR; G8_WAIT_L(0); G8_MMA(1, 0, At, B0); G8_MMA(1, 1, At, B1); G8_BAR; }
  { G8_LDB(B0, 1, 0); G8_LDA(At, 1, 0); G8_WAIT_V(2); G8_BAR; G8_WAIT_L(0); G8_MMA(0, 0, At, B0); G8_BAR;
    G8_LDB(B1, 1, 1); G8_WAIT_V(0); G8_BAR; G8_WAIT_L(0); G8_MMA(0, 1, At, B1); G8_BAR;
    G8_LDA(At, 1, 1); G8_BAR; G8_WAIT_L(0); G8_MMA(1, 0, At, B0); G8_MMA(1, 1, At, B1); G8_BAR; }
  if (wr == 0) G8_BAR;
  float* Cs = (float*)smem;
#pragma unroll
  for (int bj = 0; bj < 2; bj++) {
    __syncthreads();
#pragma unroll
    for (int ai = 0; ai < 2; ai++)
#pragma unroll
      for (int m = 0; m < 4; m++)
#pragma unroll
        for (int n = 0; n < 2; n++)
#pragma unroll
          for (int j = 0; j < 4; j++)
            Cs[(ai * 128 + wr * 64 + m * 16 + fq * 4 + j) * 132 + wc * 32 + n * 16 + fr] = acc[ai][bj][m][n][j];
    __syncthreads();
    epiS(Cs, brow, bcol + bj * 128, tid);
  }
  __syncthreads();
}
__device__ __forceinline__ void g8_map(int wgid, int nM, int nN, int& pm, int& pn) {
  const int nwg = nM * nN;
  { int q = nwg / 8, r = nwg % 8, xcd = wgid % 8, off = wgid / 8;
    wgid = (xcd < r ? xcd * (q + 1) : r * (q + 1) + (xcd - r) * q) + off; }
  const int nig = 8 * nN, gid = wgid / nig, fm = gid * 8, gsz = min(nM - fm, 8);
  pm = fm + ((wgid % nig) % gsz);
  pn = (wgid % nig) / gsz;
}

__device__ __forceinline__ float rope_inv(int i) { return exp2f(-(float)i * (13.287712379549449f / 32.f)); }
__device__ __forceinline__ void conv_finish(float4 v0, float4 v1, float s0, float s1, bf16_t* __restrict__ dst, int lddst, int ndst0, int k0,
                                            float* sm) {
  const int tid = get_tid();
  const int kr = tid >> 4, nc = (tid & 15) * 4;
  sm[kr * 65 + nc + 0] = v0.x * s0; sm[kr * 65 + nc + 1] = v0.y * s0; sm[kr * 65 + nc + 2] = v0.z * s0; sm[kr * 65 + nc + 3] = v0.w * s0;
  sm[(kr + 32) * 65 + nc + 0] = v1.x * s1; sm[(kr + 32) * 65 + nc + 1] = v1.y * s1; sm[(kr + 32) * 65 + nc + 2] = v1.z * s1; sm[(kr + 32) * 65 + nc + 3] = v1.w * s1;
  __syncthreads();
  {
    int n = tid >> 3, kc = (tid & 7) * 8;
    float o[8];
#pragma unroll
    for (int j = 0; j < 8; j++) o[j] = sm[(kc + j) * 65 + n];
    uint4 v;
    v.x = pack2(o[0], o[1]); v.y = pack2(o[2], o[3]); v.z = pack2(o[4], o[5]); v.w = pack2(o[6], o[7]);
    *(uint4*)(dst + (size_t)(ndst0 + n) * lddst + k0 + kc) = v;
  }
  __syncthreads();
}

__device__ __forceinline__ void phase0(KP p, float* sm) {
  const int tid = get_tid();
  char* ws = p->ws;
  if (blockIdx.x == 0 && tid < 16) ((unsigned int*)(ws + O_CTR))[tid] = 0u;
  const int NCONV = 9410;
  bool have_prev = false;
  float4 pv0 = float4{0.f, 0.f, 0.f, 0.f}, pv1 = pv0;
  float ps0 = 1.f, ps1 = 1.f;
  bf16_t* pdst = nullptr;
  int plddst = 0, pndst0 = 0, pk0 = 0;
  const int total = 130 + NCONV;
  for (int item = blockIdx.x; item < total; item += gridDim.x) {
    if (item < 96) {
      int l = item / 48, rem = item % 48, cb = rem / 8, ks = rem % 8;
      int c4 = (tid & 255) * 4, rh = tid >> 8;
      const float* W = p->in[3] + (size_t)l * 2048 * 6144 + cb * 1024 + c4;
      const float* c = p->in[1];
      float4 a = float4{0.f, 0.f, 0.f, 0.f};
      int rbase = ks * 256 + rh * 128;
#pragma unroll 4
      for (int i = 0; i < 128; i++) {
        int row = rbase + i;
        float sc = siluf(c[row]);
        float4 w = *(const float4*)(W + (size_t)row * 6144);
        a.x += sc * w.x; a.y += sc * w.y; a.z += sc * w.z; a.w += sc * w.w;
      }
      if (rh == 1) { sm[c4] = a.x; sm[c4 + 1] = a.y; sm[c4 + 2] = a.z; sm[c4 + 3] = a.w; }
      __syncthreads();
      if (rh == 0) {
        a.x += sm[c4]; a.y += sm[c4 + 1]; a.z += sm[c4 + 2]; a.w += sm[c4 + 3];
        float* dst = (float*)(ws + O_MODP) + (size_t)(ks * 2 + l) * 6144 + cb * 1024 + c4;
        *(float4*)dst = a;
      }
      __syncthreads();
    } else if (item < 98) {
      int ty = item - 96;
      const float* pe = p->in[ty ? 12 : 8];
      const float* w1 = p->in[ty ? 13 : 9];
      const float* b1 = p->in[ty ? 14 : 10];
      int e = tid & 63, part = tid >> 6;
      float a = 0.f;
      for (int i = 0; i < 256; i++) { int k = part * 256 + i; a += pe[k] * w1[(size_t)k * 64 + e]; }
      sm[part * 64 + e] = a;
      __syncthreads();
      if (tid < 64) {
        float s = b1[tid];
        for (int q = 0; q < 8; q++) s += sm[q * 64 + tid];
        ((float*)(ws + O_CPE))[ty * 64 + tid] = s;
      }
      __syncthreads();
    } else if (item < 130) {
      float* rope = (float*)(ws + O_ROPE);
      const int base = (item - 98) * 8192;
      for (int e = tid; e < 8192; e += NTHR) {
        const int idx = base + e, t = idx >> 5, ii = idx & 31;
        float sn, cs;
        sincosf((float)t * rope_inv(ii), &sn, &cs);
        *(float2*)(rope + (size_t)idx * 2) = float2{cs, sn};
      }
    } else {
      int ci = item - 130;
      const float* src; int ldsrc, Kvalid, ktiles; bf16_t* dst; int lddst; const float* scale = nullptr;
      int kt, nt, nsrc0, nvalid = 64, ndst0;
      if (ci < 2496) {
        src = p->in[6]; ldsrc = 4976; Kvalid = 2048; ktiles = 32; dst = (bf16_t*)(ws + O_WT_IN); lddst = 2048;
        kt = ci % 32; nt = ci / 32;
        int my = nt * 64;
        ndst0 = my;
        if (my < 1792) nsrc0 = my;
        else if (my < 3840) nsrc0 = my + 48;
        else if (my < 4864) nsrc0 = my + 112;
        else if (my < 4928) nsrc0 = my - 976;
        else { nsrc0 = 1792; nvalid = 48; }
      } else {
        ci -= 2496;
        int mid;
        if (ci < 1024) { mid = 1; }
        else if (ci < 1024 + 192) { mid = 2; ci -= 1024; }
        else if (ci < 1024 + 192 + 256) { mid = 3; ci -= 1216; }
        else if (ci < 1472 + 5120) { ci -= 1472; mid = 4 + ci / 1024; ci %= 1024; }
        else if (ci < 6592 + 128) { ci -= 6592; mid = 9 + ci / 64; ci %= 64; }
        else if (ci < 6720 + 128) { ci -= 6720; mid = 11 + ci / 64; ci %= 64; }
        else if (ci < 6848 + 64) { ci -= 6848; mid = 13 + ci / 32; ci %= 32; }
        else { ci -= 6912; mid = 15 + ci; ci = 0; }
        switch (mid) {
          case 1: src = p->in[7]; ldsrc = 2048; Kvalid = 2048; ktiles = 32; dst = (bf16_t*)(ws + O_WT_OUT); lddst = 2048; break;
          case 2: src = p->in[17]; ldsrc = 1536; Kvalid = 512; ktiles = 8; dst = (bf16_t*)(ws + O_WT_QB); lddst = 512; scale = p->in[16]; break;
          case 3: src = p->in[19]; ldsrc = 2048; Kvalid = 512; ktiles = 8; dst = (bf16_t*)(ws + O_WT_KVB); lddst = 512; scale = p->in[18]; break;
          case 4: src = p->in[21]; ldsrc = 2048; Kvalid = 2048; ktiles = 32; dst = (bf16_t*)(ws + O_WT_R); lddst = 2048; break;
          case 5: src = p->in[22]; ldsrc = 2048; Kvalid = 2048; ktiles = 32; dst = (bf16_t*)(ws + O_WT_K); lddst = 2048; break;
          case 6: src = p->in[23]; ldsrc = 2048; Kvalid = 2048; ktiles = 32; dst = (bf16_t*)(ws + O_WT_V); lddst = 2048; break;
          case 7: src = p->in[24]; ldsrc = 2048; Kvalid = 2048; ktiles = 32; dst = (bf16_t*)(ws + O_WT_Z); lddst = 2048; break;
          case 8: src = p->in[25]; ldsrc = 2048; Kvalid = 2048; ktiles = 32; dst = (bf16_t*)(ws + O_WT_O); lddst = 2048; break;
          case 9: src = p->in[27]; ldsrc = 96; Kvalid = 2048; ktiles = 32; dst = (bf16_t*)(ws + O_WT_W1); lddst = 2048; break;
          case 10: src = p->in[30]; ldsrc = 96; Kvalid = 2048; ktiles = 32; dst = (bf16_t*)(ws + O_WT_A1); lddst = 2048; break;
          case 11: src = p->in[28]; ldsrc = 2048; Kvalid = 96; ktiles = 2; dst = (bf16_t*)(ws + O_WT_W2); lddst = 128; break;
          case 12: src = p->in[31]; ldsrc = 2048; Kvalid = 96; ktiles = 2; dst = (bf16_t*)(ws + O_WT_A2); lddst = 128; break;
          case 13: src = p->in[9]; ldsrc = 64; Kvalid = 2048; ktiles = 32; dst = (bf16_t*)(ws + O_W1T); lddst = 2048; break;
          case 14: src = p->in[13]; ldsrc = 64; Kvalid = 2048; ktiles = 32; dst = (bf16_t*)(ws + O_W1T) + 64 * 2048; lddst = 2048; break;
          case 15: src = p->in[11]; ldsrc = 64; Kvalid = 64; ktiles = 1; dst = (bf16_t*)(ws + O_W2T); lddst = 64; break;
          default: src = p->in[15]; ldsrc = 64; Kvalid = 64; ktiles = 1; dst = (bf16_t*)(ws + O_W2T) + 64 * 64; lddst = 64; break;
        }
        kt = ci % ktiles; nt = ci / ktiles;
        nsrc0 = nt * 64; ndst0 = nt * 64;
        if (mid == 9 || mid == 10) { if (nt == 1) nvalid = 32; }
      }
      const int k0 = kt * 64;
      const int kr = tid >> 4, nc = (tid & 15) * 4;
      float4 v0 = float4{0.f, 0.f, 0.f, 0.f}, v1 = v0;
      float s0 = 1.f, s1 = 1.f;
      if (k0 + kr < Kvalid && nc < nvalid) {
        v0 = *(const float4*)(src + (size_t)(k0 + kr) * ldsrc + nsrc0 + nc);
        if (scale) s0 = scale[k0 + kr];
      }
      if (k0 + kr + 32 < Kvalid && nc < nvalid) {
        v1 = *(const float4*)(src + (size_t)(k0 + kr + 32) * ldsrc + nsrc0 + nc);
        if (scale) s1 = scale[k0 + kr + 32];
      }
      if (have_prev) conv_finish(pv0, pv1, ps0, ps1, pdst, plddst, pndst0, pk0, sm);
      pv0 = v0; pv1 = v1; ps0 = s0; ps1 = s1; pdst = dst; plddst = lddst; pndst0 = ndst0; pk0 = k0;
      have_prev = true;
    }
  }
  if (have_prev) conv_finish(pv0, pv1, ps0, ps1, pdst, plddst, pndst0, pk0, sm);
}

__device__ __forceinline__ void norm_phase(KP p, int layer, const float* __restrict__ xsrc, bf16_t* __restrict__ hdst, float* sm) {
  const int tid = get_tid(), lane = tid & 63, wave = tid >> 6;
  const float* modp = (const float*)(p->ws + O_MODP);
  const float* ada_b = p->in[4];
  const float* g = p->in[2] + layer * 2048;
  for (int col = tid; col < 2048; col += NTHR) {
    float sh = ada_b[layer * 6144 + col], sc = ada_b[layer * 6144 + 2048 + col];
    for (int ks = 0; ks < 8; ks++) {
      sh += modp[(size_t)(ks * 2 + layer) * 6144 + col];
      sc += modp[(size_t)(ks * 2 + layer) * 6144 + 2048 + col];
    }
    sm[col] = g[col] * (1.f + sc);
    sm[2048 + col] = sh;
  }
  if (layer == 0 && blockIdx.x == 0) {
    float* mod = (float*)(p->ws + O_MOD);
    for (int i = tid; i < 12288; i += NTHR) {
      int l = i / 6144, col = i % 6144;
      float v = ada_b[i];
      for (int ks = 0; ks < 8; ks++) v += modp[(size_t)(ks * 2 + l) * 6144 + col];
      mod[i] = v;
    }
  }
  __syncthreads();
  for (int row = blockIdx.x * 8 + wave; row < S_; row += gridDim.x * 8) {
    const float* xr = xsrc + (size_t)row * 2048;
    float4 v[8];
    float ss = 0.f;
#pragma unroll
    for (int j = 0; j < 8; j++) {
      v[j] = *(const float4*)(xr + lane * 4 + 256 * j);
      ss += v[j].x * v[j].x + v[j].y * v[j].y + v[j].z * v[j].z + v[j].w * v[j].w;
    }
    ss = wave_sum(ss);
    float rstd = rsqrtf(ss * (1.f / 2048.f) + 1e-6f);
#pragma unroll
    for (int j = 0; j < 8; j++) {
      int col = lane * 4 + 256 * j;
      float o0 = v[j].x * rstd * sm[col] + sm[2048 + col];
      float o1 = v[j].y * rstd * sm[col + 1] + sm[2048 + col + 1];
      float o2 = v[j].z * rstd * sm[col + 2] + sm[2048 + col + 2];
      float o3 = v[j].w * rstd * sm[col + 3] + sm[2048 + col + 3];
      uint2 o;
      o.x = pack2(o0, o1); o.y = pack2(o2, o3);
      *(uint2*)(hdst + (size_t)row * 2048 + col) = o;
    }
  }
}

__device__ __forceinline__ void norm_shift_phase(KP p, float* sm) {
  const int tid = get_tid(), lane = tid & 63, wave = tid >> 6;
  const int layer = 1;
  char* ws = p->ws;
  const float* modp = (const float*)(ws + O_MODP);
  const float* ada_b = p->in[4];
  const float* g = p->in[2] + layer * 2048;
  const float* mu = p->in[20];
  const float* xsrc = p->out;
  for (int col = tid; col < 2048; col += NTHR) {
    float sh = ada_b[layer * 6144 + col], sc = ada_b[layer * 6144 + 2048 + col];
    for (int ks = 0; ks < 8; ks++) {
      sh += modp[(size_t)(ks * 2 + layer) * 6144 + col];
      sc += modp[(size_t)(ks * 2 + layer) * 6144 + 2048 + col];
    }
    sm[col] = g[col] * (1.f + sc);
    sm[2048 + col] = sh;
  }
  __syncthreads();
  bf16_t* dst0 = (bf16_t*)(ws + O_H1);
  bf16_t* dst1 = (bf16_t*)(ws + O_XW);
  bf16_t* dst2 = (bf16_t*)(ws + O_XK);
  bf16_t* dst3 = (bf16_t*)(ws + O_XV);
  bf16_t* dst4 = (bf16_t*)(ws + O_XA);
  bf16_t* dst5 = (bf16_t*)(ws + O_XZ);
  for (int row = blockIdx.x * 8 + wave; row < S_; row += gridDim.x * 8) {
    const float* xr = xsrc + (size_t)row * 2048;
    float4 v[8], vp[8];
    float ss = 0.f, sp = 0.f;
#pragma unroll
    for (int j = 0; j < 8; j++) {
      v[j] = *(const float4*)(xr + lane * 4 + 256 * j);
      ss += v[j].x * v[j].x + v[j].y * v[j].y + v[j].z * v[j].z + v[j].w * v[j].w;
      if (row > 0) vp[j] = *(const float4*)(xr - 2048 + lane * 4 + 256 * j);
      else vp[j] = float4{0.f, 0.f, 0.f, 0.f};
      sp += vp[j].x * vp[j].x + vp[j].y * vp[j].y + vp[j].z * vp[j].z + vp[j].w * vp[j].w;
    }
    ss = wave_sum(ss);
    sp = wave_sum(sp);
    const float rstd = rsqrtf(ss * (1.f / 2048.f) + 1e-6f);
    const float rstdp = rsqrtf(sp * (1.f / 2048.f) + 1e-6f);
#pragma unroll
    for (int j = 0; j < 8; j++) {
      const int col = lane * 4 + 256 * j;
      float h[4], hp[4];
      h[0] = v[j].x * rstd * sm[col] + sm[2048 + col];
      h[1] = v[j].y * rstd * sm[col + 1] + sm[2048 + col + 1];
      h[2] = v[j].z * rstd * sm[col + 2] + sm[2048 + col + 2];
      h[3] = v[j].w * rstd * sm[col + 3] + sm[2048 + col + 3];
      if (row > 0) {
        hp[0] = vp[j].x * rstdp * sm[col] + sm[2048 + col];
        hp[1] = vp[j].y * rstdp * sm[col + 1] + sm[2048 + col + 1];
        hp[2] = vp[j].z * rstdp * sm[col + 2] + sm[2048 + col + 2];
        hp[3] = vp[j].w * rstdp * sm[col + 3] + sm[2048 + col + 3];
      } else { hp[0] = hp[1] = hp[2] = hp[3] = 0.f; }
      const unsigned ob = ((unsigned)row * 2048u + (unsigned)col) * 2u;
#define MIXOUT(dst_, mi_)                                                              \
      {                                                                                \
        const float4 m4 = *(const float4*)(mu + (mi_) * 2048 + col);                   \
        uint2 u;                                                                       \
        u.x = pack2(h[0] + (hp[0] - h[0]) * m4.x, h[1] + (hp[1] - h[1]) * m4.y);       \
        u.y = pack2(h[2] + (hp[2] - h[2]) * m4.z, h[3] + (hp[3] - h[3]) * m4.w);       \
        *(uint2*)((char*)dst_ + ob) = u;                                               \
      }
      MIXOUT(dst0, 0) MIXOUT(dst1, 1) MIXOUT(dst2, 2) MIXOUT(dst3, 3) MIXOUT(dst4, 4) MIXOUT(dst5, 5)
    }
  }
}

__device__ __forceinline__ float4 silu4(float4 v) { return float4{siluf(v.x), siluf(v.y), siluf(v.z), siluf(v.w)}; }
__device__ __forceinline__ float4 sigm4(float4 v) { return float4{sigmf(v.x), sigmf(v.y), sigmf(v.z), sigmf(v.w)}; }
__device__ __forceinline__ void phase2(KP p, char* smem) {
  char* ws = p->ws;
  const bf16_t* A = (const bf16_t*)(ws + O_H0);
  const bf16_t* Bt = (const bf16_t*)(ws + O_WT_IN);
  const int lane = get_tid() & 63, r = lane & 15, quad = lane >> 4;
  bf16_t* qn = (bf16_t*)(ws + O_QN);
  bf16_t* zn = (bf16_t*)(ws + O_ZN);
  bf16_t* zm = (bf16_t*)(ws + O_ZM);
  bf16_t* qa = (bf16_t*)(ws + O_QA);
  bf16_t* ckv = (bf16_t*)(ws + O_CKV);
  float* kpe = (float*)(ws + O_KPE);
  float* gates = (float*)(ws + O_GATES);
  auto epiD = [&](f32x4(&acc)[4][4], int row0, int col0) {
    if (col0 < 1024 || col0 >= 1792) return;
    const int idx = (col0 - 1024) >> 7;
    if (idx != 3 && idx != 5) return;
#pragma unroll
    for (int nt = 0; nt < 4; nt++) {
      const int cc = col0 + nt * 16 + r - 1024, g = (cc >> 6) & 1, d = cc & 63;
#pragma unroll
      for (int mt = 0; mt < 4; mt++) {
        const int rw = row0 + mt * 16 + quad * 4;
        const f32x4 v = acc[mt][nt];
        bf16_t* dst = (bf16_t*)(ws + (idx == 3 ? O_VST : O_VWT)) + (((size_t)g * 256 + (rw >> 5)) * 64 + d) * 32 + (rw & 31);
        uint2 o; o.x = pack2(v[0], v[1]); o.y = pack2(v[2], v[3]);
        *(uint2*)dst = o;
      }
    }
  };
  auto epiS = [&](const float* Cs, int m0, int n0, int tid) {
    STAGE_LOOP8(row, c8, va, vb)
      const int c = n0 + c8;
      const size_t t = (size_t)(m0 + row);
      if (c < 1024) {
        *(uint4*)(qn + t * 1024 + c) = pack8(va, vb);
      } else if (c < 1792) {
        const int cc = c - 1024, idx = cc >> 7, g = (cc >> 6) & 1, d = cc & 63;
        if (idx != 3 && idx != 5) {
          const size_t off = idx == 0 ? O_KC : idx == 1 ? O_VC : idx == 2 ? O_KS : O_KW;
          *(uint4*)((bf16_t*)(ws + off) + ((size_t)g * S_ + t) * 64 + d) = pack8(va, vb);
        }
      } else if (c < 2816) {
        *(uint4*)(zn + t * 1024 + (c - 1792)) = pack8(silu4(va), silu4(vb));
      } else if (c < 3328) {
        *(uint4*)(qa + t * 512 + (c - 2816)) = pack8(va, vb);
      } else if (c < 3840) {
        *(uint4*)(ckv + t * 512 + (c - 3328)) = pack8(va, vb);
      } else if (c < 4864) {
        *(uint4*)(zm + t * 1024 + (c - 3840)) = pack8(silu4(va), silu4(vb));
      } else if (c < 4928) {
        *(float4*)(kpe + t * 64 + (c - 4864)) = va;
        *(float4*)(kpe + t * 64 + (c - 4864) + 4) = vb;
      } else if (c < 4976) {
        *(float4*)(gates + t * 48 + (c - 4928)) = sigm4(va);
        *(float4*)(gates + t * 48 + (c - 4928) + 4) = sigm4(vb);
      }
    STAGE_END
  };
  auto epiS2 = [&](const float* Cs, int m0, int n0, int tid) {
    if (n0 == 1408 || n0 == 1664) {
      bf16_t* vb_ = (bf16_t*)(ws + (n0 == 1408 ? O_VST : O_VWT));
      for (int e_ = tid; e_ < 128 * 32; e_ += NTHR) {
        const int col = e_ & 127, rg = e_ >> 7;
        float f[8];
#pragma unroll
        for (int j = 0; j < 8; j++) f[j] = Cs[(rg * 8 + j) * 132 + col];
        const int t = m0 + rg * 8, g = col >> 6, d = col & 63;
        uint4 u;
        u.x = pack2(f[0], f[1]); u.y = pack2(f[2], f[3]); u.z = pack2(f[4], f[5]); u.w = pack2(f[6], f[7]);
        *(uint4*)(vb_ + (((size_t)g * 256 + (t >> 5)) * 64 + d) * 32 + (t & 31)) = u;
      }
    } else {
      epiS(Cs, m0, n0, tid);
    }
  };
  auto epiNone = [&](f32x4(&acc)[4][4], int row0, int col0) {};
  (void)epiD;
  const int nbig = 32 * 16, nsmall = 32 * 7;
  for (int t = blockIdx.x; t < nbig + nsmall; t += gridDim.x) {
    if (t < nbig) {
      int pm, pn;
      g8_map(t, 32, 16, pm, pn);
      gemm256_tile(A, 2048, Bt, 2048, 2048, pm * 256, pn * 256, smem, epiS2);
    } else {
      const int u = t - nbig;
      const int mt = u & 31, nt = 32 + (u >> 5);
      gemm_tile<0>(A, 2048, Bt, 2048, 2048, mt * 256, nt * 128, smem, nullptr, epiNone, epiS);
    }
  }
}


__device__ __forceinline__ void phase3(KP p, char* smem) {
  char* ws = p->ws;
  float* rstd_s = (float*)(smem + 136 * 1024);
  const float* rope = (const float*)(ws + O_ROPE);
  auto epiNone = [&](f32x4(&acc)[4][4], int row0, int col0) {};
  const int total = 8 + 192 + 256 + 32;
  for (int item = blockIdx.x; item < total; item += gridDim.x) {
    if (item < 8) {
      int prob = item >> 1, mtile = item & 1;
      int ty = prob >> 1, g = prob & 1;
      const bf16_t* A = (const bf16_t*)(ws + (ty ? O_VC : O_KC)) + (size_t)g * S_ * 64;
      const bf16_t* Bt = (const bf16_t*)(ws + O_W1T);
      bf16_t* hid = (bf16_t*)(ws + O_HID) + (size_t)prob * 512 * 64;
      const float* cpe = (const float*)(ws + O_CPE) + ty * 64;
      auto epi1 = [&](f32x4(&acc)[4][4], int row0, int col0) {
        if ((col0 >> 6) != ty) return;
        const int lane = get_tid() & 63, r = lane & 15, quad = lane >> 4;
#pragma unroll
        for (int nt = 0; nt < 4; nt++) {
          int e = nt * 16 + r;
          float b = cpe[e];
#pragma unroll
          for (int mt = 0; mt < 4; mt++) {
            int rw = row0 + mt * 16 + quad * 4;
#pragma unroll
            for (int i = 0; i < 4; i++) hid[(size_t)(rw + i) * 64 + e] = f2bf(siluf(acc[mt][nt][i] + b));
          }
        }
      };
      gemm_tile<0>(A, 1024, Bt, 2048, 2048, mtile * 256, 0, smem, nullptr, epi1);
      __threadfence();
      __syncthreads();
      bf16_t* kcmp = (bf16_t*)(ws + O_KCMP) + (size_t)g * 512 * 64;
      bf16_t* vcmpT = (bf16_t*)(ws + O_VCMPT) + (size_t)g * 64 * 512;
      auto epi2 = [&](f32x4(&acc)[4][4], int row0, int col0) {
        if ((col0 >> 6) != ty) return;
        const int lane = get_tid() & 63, r = lane & 15, quad = lane >> 4;
#pragma unroll
        for (int nt = 0; nt < 4; nt++) {
          int d = nt * 16 + r;
#pragma unroll
          for (int mt = 0; mt < 4; mt++) {
            int rw = row0 + mt * 16 + quad * 4;
            f32x4 v = acc[mt][nt];
#pragma unroll
            for (int i = 0; i < 4; i++) if (rw + i >= 511) v[i] = 0.f;
            if (ty == 0) {
#pragma unroll
              for (int i = 0; i < 4; i++) kcmp[(size_t)(rw + i) * 64 + d] = f2bf(v[i]);
            } else {
              uint2 o; o.x = pack2(v[0], v[1]); o.y = pack2(v[2], v[3]);
              *(uint2*)(vcmpT + ((size_t)(rw >> 5) * 64 + d) * 32 + (rw & 31)) = o;
            }
          }
        }
      };
      gemm_tile<0>(hid, 64, (const bf16_t*)(ws + O_W2T), 64, 64, mtile * 256, 0, smem, nullptr, epi2);
    } else if (item < 8 + 192 + 256) {
      int it = item - 8;
      bool isq = it < 192;
      if (!isq) it -= 192;
      int mt_, nt_;
      g8_map(it, 32, isq ? 6 : 8, mt_, nt_);
      const bf16_t* A = (const bf16_t*)(ws + (isq ? O_QA : O_CKV));
      __syncthreads();
      {
        const int tid = get_tid();
        int row = tid >> 1, hf = tid & 1;
        const bf16_t* ap = A + (size_t)(mt_ * 256 + row) * 512 + hf * 256;
        float ss = 0.f;
#pragma unroll 4
        for (int j = 0; j < 32; j++) {
          float f[8];
          unpack8(*(const uint4*)(ap + j * 8), f);
#pragma unroll
          for (int q = 0; q < 8; q++) ss += f[q] * f[q];
        }
        ss += __shfl_xor(ss, 1);
        if (hf == 0) rstd_s[row] = rsqrtf(ss * (1.f / 512.f) + 1e-6f);
      }
      __syncthreads();
      if (isq) {
        bf16_t* qm = (bf16_t*)(ws + O_QM);
        auto epiS = [&](const float* Cs, int m0, int n0, int tid) {
          STAGE_LOOP8(row, c8, va, vb)
            const int c = n0 + c8, hd = c / 192, dd = c - hd * 192;
            const int t = m0 + row;
            const float rs = rstd_s[row];
            bf16_t* dst = qm + ((size_t)hd * S_ + t) * 192;
            if (dd < 128) {
              float4 a = va, b = vb;
              a.x *= rs; a.y *= rs; a.z *= rs; a.w *= rs; b.x *= rs; b.y *= rs; b.z *= rs; b.w *= rs;
              *(uint4*)(dst + dd) = pack8(a, b);
            } else if (dd < 160) {
              const int i0 = dd - 128;
              const float4 xa = *(const float4*)(Cs + row * 132 + c8 + 32), xb = *(const float4*)(Cs + row * 132 + c8 + 36);
              const float x1[8] = {va.x * rs, va.y * rs, va.z * rs, va.w * rs, vb.x * rs, vb.y * rs, vb.z * rs, vb.w * rs};
              const float x2[8] = {xa.x * rs, xa.y * rs, xa.z * rs, xa.w * rs, xb.x * rs, xb.y * rs, xb.z * rs, xb.w * rs};
              const float* rp = rope + ((size_t)t * 32 + i0) * 2;
              float o1[8], o2[8];
#pragma unroll
              for (int j = 0; j < 4; j++) {
                const float4 cs = *(const float4*)(rp + 4 * j);
                o1[2 * j] = x1[2 * j] * cs.x - x2[2 * j] * cs.y;
                o2[2 * j] = x1[2 * j] * cs.y + x2[2 * j] * cs.x;
                o1[2 * j + 1] = x1[2 * j + 1] * cs.z - x2[2 * j + 1] * cs.w;
                o2[2 * j + 1] = x1[2 * j + 1] * cs.w + x2[2 * j + 1] * cs.z;
              }
              uint4 u1, u2;
              u1.x = pack2(o1[0], o1[1]); u1.y = pack2(o1[2], o1[3]); u1.z = pack2(o1[4], o1[5]); u1.w = pack2(o1[6], o1[7]);
              u2.x = pack2(o2[0], o2[1]); u2.y = pack2(o2[2], o2[3]); u2.z = pack2(o2[4], o2[5]); u2.w = pack2(o2[6], o2[7]);
              *(uint4*)(dst + 128 + i0) = u1;
              *(uint4*)(dst + 160 + i0) = u2;
            }
          STAGE_END
        };
        gemm256_tile(A, 512, (const bf16_t*)(ws + O_WT_QB), 512, 512, mt_ * 256, nt_ * 256, smem, epiS);
      } else {
        bf16_t* km = (bf16_t*)(ws + O_KM);
        bf16_t* vmT = (bf16_t*)(ws + O_VMT);
        auto epiD = [&](f32x4(&acc)[4][4], int row0, int col0) {
          const int lane = get_tid() & 63, r = lane & 15, quad = lane >> 4;
          int hd = col0 >> 8, dd0 = col0 & 255;
          if (dd0 < 128) return;
          int lrow0 = row0 - mt_ * 256;
#pragma unroll
          for (int nt = 0; nt < 4; nt++)
#pragma unroll
            for (int mt = 0; mt < 4; mt++) {
              int rl = lrow0 + mt * 16 + quad * 4;
              int t = mt_ * 256 + rl;
              f32x4 v = acc[mt][nt];
#pragma unroll
              for (int i = 0; i < 4; i++) v[i] *= rstd_s[rl + i];
              int d = dd0 - 128 + nt * 16 + r;
              uint2 o; o.x = pack2(v[0], v[1]); o.y = pack2(v[2], v[3]);
              *(uint2*)(vmT + ((size_t)hd * 128 + d) * S_ + t) = o;
            }
        };
        auto epiS = [&](const float* Cs, int m0, int n0, int tid) {
          STAGE_LOOP8(row, c8, va, vb)
            const int c = n0 + c8, hd = c >> 8, dd = c & 255;
            if (dd < 128) {
              const float rs = rstd_s[row];
              float4 a = va, b = vb;
              a.x *= rs; a.y *= rs; a.z *= rs; a.w *= rs; b.x *= rs; b.y *= rs; b.z *= rs; b.w *= rs;
              *(uint4*)(km + ((size_t)hd * S_ + m0 + row) * 192 + dd) = pack8(a, b);
            }
          STAGE_END
        };
        (void)epiD;
        auto epiS2 = [&](const float* Cs, int m0, int n0, int tid) {
          if ((n0 & 255) == 128) {
            const int hd = n0 >> 8;
            for (int e_ = tid; e_ < 128 * 32; e_ += NTHR) {
              const int col = e_ & 127, rg = e_ >> 7;
              float f[8];
#pragma unroll
              for (int j = 0; j < 8; j++) f[j] = Cs[(rg * 8 + j) * 132 + col] * rstd_s[rg * 8 + j];
              uint4 u;
              u.x = pack2(f[0], f[1]); u.y = pack2(f[2], f[3]); u.z = pack2(f[4], f[5]); u.w = pack2(f[6], f[7]);
              *(uint4*)(vmT + ((size_t)hd * 128 + col) * S_ + m0 + rg * 8) = u;
            }
          } else {
            epiS(Cs, m0, n0, tid);
          }
        };
        gemm256_tile(A, 512, (const bf16_t*)(ws + O_WT_KVB), 512, 512, mt_ * 256, nt_ * 256, smem, epiS2);
      }
    } else {
      int it = item - (8 + 192 + 256);
      const float* kpe = (const float*)(ws + O_KPE);
      bf16_t* km = (bf16_t*)(ws + O_KM);
      const int tid = get_tid();
      for (int e = tid; e < 256 * 32; e += NTHR) {
        int t = it * 256 + (e >> 5), ii = e & 31;
        float x1 = kpe[(size_t)t * 64 + ii], x2 = kpe[(size_t)t * 64 + 32 + ii];
        const float2 cs = *(const float2*)(rope + ((size_t)t * 32 + ii) * 2);
        bf16_t o1 = f2bf(x1 * cs.x - x2 * cs.y), o2 = f2bf(x1 * cs.y + x2 * cs.x);
#pragma unroll
        for (int hd = 0; hd < 8; hd++) {
          bf16_t* dst = km + ((size_t)hd * S_ + t) * 192 + 128;
          dst[ii] = o1; dst[32 + ii] = o2;
        }
      }
    }
  }
}

template <int DQK, int NCT>
__device__ __forceinline__ void qk_step(const bf16_t* __restrict__ Kb, int ldk, int kb, const bf16x8 (&qf)[DQK / 32][NCT],
                                        f32x4 (&s)[2][NCT], int r, int quad) {
#pragma unroll
  for (int sub = 0; sub < 2; sub++) {
    const bf16_t* kp = Kb + (size_t)(kb + sub * 16 + r) * ldk + quad * 8;
#pragma unroll
    for (int ct = 0; ct < NCT; ct++) s[sub][ct] = f32x4{0.f, 0.f, 0.f, 0.f};
#pragma unroll
    for (int ks = 0; ks < DQK / 32; ks++) {
      bf16x8 kf = *(const bf16x8*)(kp + ks * 32);
#pragma unroll
      for (int ct = 0; ct < NCT; ct++) s[sub][ct] = mfma_bf16(kf, qf[ks][ct], s[sub][ct]);
    }
  }
}

template <int DV, int NCT>
__device__ __forceinline__ void pv_step(const bf16_t* __restrict__ VT, size_t ldv, int kb, const bf16x8 (&pf)[NCT],
                                        f32x4 (&o)[DV / 16][NCT], int r, int quad) {
#pragma unroll
  for (int dt = 0; dt < DV / 16; dt++) {
    const bf16_t* vp = VT + (size_t)(dt * 16 + r) * ldv + kb + quad * 4;
    uint2 lo = *(const uint2*)vp;
    uint2 hi = *(const uint2*)(vp + 16);
    uint4 u = uint4{lo.x, lo.y, hi.x, hi.y};
    bf16x8 vf = *(bf16x8*)&u;
#pragma unroll
    for (int ct = 0; ct < NCT; ct++) o[dt][ct] = mfma_bf16(vf, pf[ct], o[dt][ct]);
  }
}

template <int DV>
__device__ __forceinline__ bf16x8 softmax_step(float (&sc)[8], unsigned vmask, float& m, float& l, f32x4 (&o)[DV / 16][1]) {
  return bf16x8{};
}

__device__ __forceinline__ float quad_max(float v) {
  v = fmaxf(v, __shfl_xor(v, 16));
  v = fmaxf(v, __shfl_xor(v, 32));
  return v;
}
__device__ __forceinline__ float quad_sum(float v) {
  v += __shfl_xor(v, 16);
  v += __shfl_xor(v, 32);
  return v;
}

#define SOFTMAX_UPDATE(DVT, NCTV, ct, sc, vm, mvar, lvar, oarr, pfout)                                   \
  {                                                                                                      \
    float mx_ = -1e30f;                                                                                  \
    _Pragma("unroll") for (int j_ = 0; j_ < 8; j_++) if ((vm >> j_) & 1) mx_ = fmaxf(mx_, sc[j_]);       \
    mx_ = quad_max(mx_);                                                                                 \
    const float mn_ = fmaxf(mvar, mx_);                                                                  \
    if (__ballot(mn_ > mvar) != 0ull) {                                                                  \
      const float al_ = __builtin_amdgcn_exp2f(mvar - mn_);                                              \
      lvar *= al_;                                                                                       \
      _Pragma("unroll") for (int dt_ = 0; dt_ < DVT / 16; dt_++) {                                       \
        oarr[dt_][ct][0] *= al_; oarr[dt_][ct][1] *= al_; oarr[dt_][ct][2] *= al_; oarr[dt_][ct][3] *= al_; \
      }                                                                                                  \
      mvar = mn_;                                                                                        \
    }                                                                                                    \
    float pp_[8];                                                                                        \
    float ls_ = 0.f;                                                                                     \
    _Pragma("unroll") for (int j_ = 0; j_ < 8; j_++) {                                                   \
      pp_[j_] = ((vm >> j_) & 1) ? __builtin_amdgcn_exp2f(sc[j_] - mn_) : 0.f;                           \
      ls_ += pp_[j_];                                                                                    \
    }                                                                                                    \
    lvar += ls_;                                                                                         \
    uint4 u_;                                                                                            \
    u_.x = pack2(pp_[0], pp_[1]); u_.y = pack2(pp_[2], pp_[3]);                                          \
    u_.z = pack2(pp_[4], pp_[5]); u_.w = pack2(pp_[6], pp_[7]);                                          \
    pfout = *(bf16x8*)&u_;                                                                               \
  }

struct KF { bf16x8 k[2][2]; };
struct VF { bf16x8 v[4]; };
__device__ __forceinline__ void load_kf(KF& f, const bf16_t* __restrict__ Kb, int kb, int r, int quad) {
#pragma unroll
  for (int sub = 0; sub < 2; sub++)
#pragma unroll
    for (int ks = 0; ks < 2; ks++) f.k[sub][ks] = *(const bf16x8*)(Kb + (size_t)(kb + sub * 16 + r) * 64 + ks * 32 + quad * 8);
}
__device__ __forceinline__ void load_vf(VF& f, const bf16_t* __restrict__ VT, size_t ldv, int kb, int r, int quad) {
  (void)ldv;
  const bf16_t* vb = VT + (size_t)(kb >> 5) * 2048 + r * 32 + quad * 4;
#pragma unroll
  for (int dt = 0; dt < 4; dt++) {
    const bf16_t* vp = vb + dt * 512;
    uint2 lo = *(const uint2*)vp;
    uint2 hi = *(const uint2*)(vp + 16);
    uint4 u = uint4{lo.x, lo.y, hi.x, hi.y};
    f.v[dt] = *(bf16x8*)&u;
  }
}
__device__ __forceinline__ void qk_from(const KF& f, const bf16x8 (&qf)[2][2], f32x4 (&s)[2][2]) {
#pragma unroll
  for (int sub = 0; sub < 2; sub++)
#pragma unroll
    for (int ct = 0; ct < 2; ct++) {
      s[sub][ct] = f32x4{0.f, 0.f, 0.f, 0.f};
#pragma unroll
      for (int ks = 0; ks < 2; ks++) s[sub][ct] = mfma_bf16(f.k[sub][ks], qf[ks][ct], s[sub][ct]);
    }
}
__device__ __forceinline__ void pv_from(const VF& f, const bf16x8 (&pf)[2], f32x4 (&o)[4][2]) {
#pragma unroll
  for (int dt = 0; dt < 4; dt++)
#pragma unroll
    for (int ct = 0; ct < 2; ct++) o[dt][ct] = mfma_bf16(f.v[dt], pf[ct], o[dt][ct]);
}

__device__ __forceinline__ void nsa_item(KP p, int g, int tile, float* wsm) {
  char* ws = p->ws;
  const int lane = get_tid() & 63, r = lane & 15, quad = lane >> 4;
  float* impc = wsm;
  float* vals = wsm + 2048;
  const bf16_t* qn = (const bf16_t*)(ws + O_QN);
  const bf16_t* kcmp = (const bf16_t*)(ws + O_KCMP) + (size_t)g * 512 * 64;
  const bf16_t* vcmpT = (const bf16_t*)(ws + O_VCMPT) + (size_t)g * 64 * 512;
  const bf16_t* ksb = (const bf16_t*)(ws + O_KS) + (size_t)g * S_ * 64;
  const bf16_t* kwb = (const bf16_t*)(ws + O_KW) + (size_t)g * S_ * 64;
  const bf16_t* vsT = (const bf16_t*)(ws + O_VST) + (size_t)g * 64 * S_;
  const bf16_t* vwT = (const bf16_t*)(ws + O_VWT) + (size_t)g * 64 * S_;
  const float* gates = (const float*)(ws + O_GATES);
  const int t0 = tile * 4;
  const int head = g * 8 + (r & 7);
  const float slope = exp2f(-0.5f * (float)(head + 1)) * 1.4426950408889634f;
  const float qs2 = 0.125f * 1.4426950408889634f;
  int tok[2];
  bf16x8 qf[2][2];
#pragma unroll
  for (int ct = 0; ct < 2; ct++) {
    tok[ct] = t0 + ct * 2 + (r >> 3);
#pragma unroll
    for (int ks = 0; ks < 2; ks++) qf[ks][ct] = *(const bf16x8*)(qn + (size_t)tok[ct] * 1024 + head * 64 + ks * 32 + quad * 8);
  }
  f32x4 oacc[4][2];
#pragma unroll
  for (int dt = 0; dt < 4; dt++)
#pragma unroll
    for (int ct = 0; ct < 2; ct++) oacc[dt][ct] = f32x4{0.f, 0.f, 0.f, 0.f};
  f32x4 o[4][2];
  float m[2], l[2];
  for (int i = lane; i < 2048; i += 64) impc[i] = 0.f;
  const int tlast = t0 + 3;
  if (tlast >= 31) {
    const int nmax = (tlast - 31) >> 4;
    const int nsteps = (nmax >> 5) + 1;
    const int lastkb = (nsteps - 1) * 32;
    m[0] = m[1] = -1e30f; l[0] = l[1] = 0.f;
    {
      KF kc_, kn_;
      load_kf(kc_, kcmp, 0, r, quad);
      for (int st = 0; st < nsteps; st++) {
        const int kb = st * 32;
        load_kf(kn_, kcmp, min(kb + 32, lastkb), r, quad);
        f32x4 s[2][2];
        qk_from(kc_, qf, s);
#pragma unroll
        for (int ct = 0; ct < 2; ct++) {
          float mx = -1e30f;
          float sc[8];
          unsigned vm = 0;
#pragma unroll
          for (int j = 0; j < 8; j++) {
            int n = kb + (j >> 2) * 16 + quad * 4 + (j & 3);
            int ce = n * 16 + 31;
            sc[j] = s[j >> 2][ct][j & 3] * qs2 - slope * (float)(tok[ct] - ce);
            if (ce <= tok[ct]) { vm |= 1u << j; mx = fmaxf(mx, sc[j]); }
          }
          mx = quad_max(mx);
          float mn = fmaxf(m[ct], mx);
          float al = __builtin_amdgcn_exp2f(m[ct] - mn);
          float ls = 0.f;
#pragma unroll
          for (int j = 0; j < 8; j++) if ((vm >> j) & 1) ls += __builtin_amdgcn_exp2f(sc[j] - mn);
          l[ct] = l[ct] * al + ls;
          m[ct] = mn;
        }
        kc_ = kn_;
      }
    }
    float il[2];
#pragma unroll
    for (int ct = 0; ct < 2; ct++) { float lt = quad_sum(l[ct]); il[ct] = lt > 0.f ? 1.f / lt : 0.f; }
#pragma unroll
    for (int dt = 0; dt < 4; dt++)
#pragma unroll
      for (int ct = 0; ct < 2; ct++) o[dt][ct] = f32x4{0.f, 0.f, 0.f, 0.f};
    {
      KF kc_, kn_;
      VF vc_, vn_;
      load_kf(kc_, kcmp, 0, r, quad);
      load_vf(vc_, vcmpT, 512, 0, r, quad);
      for (int st = 0; st < nsteps; st++) {
        const int kb = st * 32;
        const int nkb = min(kb + 32, lastkb);
        load_kf(kn_, kcmp, nkb, r, quad);
        load_vf(vn_, vcmpT, 512, nkb, r, quad);
        f32x4 s[2][2];
        qk_from(kc_, qf, s);
        bf16x8 pf[2];
#pragma unroll
        for (int ct = 0; ct < 2; ct++) {
          float pp[8];
#pragma unroll
          for (int j = 0; j < 8; j++) {
            int n = kb + (j >> 2) * 16 + quad * 4 + (j & 3);
            int ce = n * 16 + 31;
            float sc = s[j >> 2][ct][j & 3] * qs2 - slope * (float)(tok[ct] - ce);
            pp[j] = (ce <= tok[ct]) ? __builtin_amdgcn_exp2f(sc - m[ct]) * il[ct] : 0.f;
            float hs = pp[j];
            hs += __shfl_xor(hs, 1);
            hs += __shfl_xor(hs, 2);
            hs += __shfl_xor(hs, 4);
            if ((r & 7) == 0) impc[(ct * 2 + (r >> 3)) * 512 + n] = hs;
          }
          uint4 u;
          u.x = pack2(pp[0], pp[1]); u.y = pack2(pp[2], pp[3]); u.z = pack2(pp[4], pp[5]); u.w = pack2(pp[6], pp[7]);
          pf[ct] = *(bf16x8*)&u;
        }
        pv_from(vc_, pf, o);
        kc_ = kn_;
        vc_ = vn_;
      }
    }
#pragma unroll
    for (int ct = 0; ct < 2; ct++) {
      float gt = gates[(size_t)tok[ct] * 48 + head * 3 + 0];
#pragma unroll
      for (int dt = 0; dt < 4; dt++)
#pragma unroll
        for (int i = 0; i < 4; i++) oacc[dt][ct][i] += gt * o[dt][ct][i];
    }
  }
  __builtin_amdgcn_s_waitcnt(0);
  __builtin_amdgcn_wave_barrier();
  unsigned long long mlo[4], mhi[4];
  const int cur = t0 >> 6;
#pragma unroll
  for (int tk = 0; tk < 4; tk++) {
    float va, vb;
    {
      int j = lane;
      float s5 = 0.f;
#pragma unroll
      for (int q = -1; q <= 3; q++) { int n = 4 * j + q; if (n >= 0) s5 += impc[tk * 512 + n]; }
      va = (j > cur) ? -1e30f : ((j == 0 || j == cur || j == cur - 1) ? 1e9f : s5);
      j = lane + 64;
      s5 = 0.f;
#pragma unroll
      for (int q = -1; q <= 3; q++) { int n = 4 * j + q; if (n < 512) s5 += impc[tk * 512 + n]; }
      vb = (j > cur) ? -1e30f : ((j == cur || j == cur - 1) ? 1e9f : s5);
    }
    __builtin_amdgcn_wave_barrier();
    vals[lane] = va;
    vals[lane + 64] = vb;
    __builtin_amdgcn_s_waitcnt(0);
    __builtin_amdgcn_wave_barrier();
    int ra_ = 0, rb_ = 0;
    for (int jj = 0; jj <= cur; jj += 4) {
      const float4 x4 = *(const float4*)(vals + jj);
      const float xs_[4] = {x4.x, x4.y, x4.z, x4.w};
#pragma unroll
      for (int e = 0; e < 4; e++) {
        const float x = xs_[e];
        ra_ += (x > va || (x == va && jj + e < lane)) ? 1 : 0;
        rb_ += (x > vb || (x == vb && jj + e < lane + 64)) ? 1 : 0;
      }
    }
    mlo[tk] = __ballot(ra_ < 16);
    mhi[tk] = __ballot(rb_ < 16);
    __builtin_amdgcn_wave_barrier();
  }
  unsigned long long mylo[2], myhi[2];
#pragma unroll
  for (int ct = 0; ct < 2; ct++) {
    int ti = ct * 2 + (r >> 3);
    mylo[ct] = (ti == 0) ? mlo[0] : (ti == 1) ? mlo[1] : (ti == 2) ? mlo[2] : mlo[3];
    myhi[ct] = (ti == 0) ? mhi[0] : (ti == 1) ? mhi[1] : (ti == 2) ? mhi[2] : mhi[3];
  }
  const unsigned long long ulo = mlo[0] | mlo[1] | mlo[2] | mlo[3];
  const unsigned long long uhi = mhi[0] | mhi[1] | mhi[2] | mhi[3];
  {
    m[0] = m[1] = -1e30f; l[0] = l[1] = 0.f;
#pragma unroll
    for (int dt = 0; dt < 4; dt++)
#pragma unroll
      for (int ct = 0; ct < 2; ct++) o[dt][ct] = f32x4{0.f, 0.f, 0.f, 0.f};
    const unsigned long long vlo = (cur >= 63) ? ~0ull : ((1ull << (cur + 1)) - 1ull);
    const unsigned long long vhi = (cur < 64) ? 0ull : ((cur - 64 >= 63) ? ~0ull : ((1ull << (cur - 63)) - 1ull));
    const unsigned long long wlo = ulo & vlo, whi = uhi & vhi;
    int kb = (wlo != 0ull) ? (__builtin_ctzll(wlo) * 64) : ((64 + __builtin_ctzll(whi | (1ull << 63))) * 64);
    KF kc_, kn_;
    VF vc_, vn_;
    load_kf(kc_, ksb, kb, r, quad);
    load_vf(vc_, vsT, S_, kb, r, quad);
    for (;;) {
      int nkb;
      if (!(kb & 32)) nkb = kb + 32;
      else {
        const int j = kb >> 6;
        int jn = -1;
        const unsigned long long mlo_ = (j < 63) ? (wlo >> (j + 1)) : 0ull;
        if (mlo_ != 0ull) jn = j + 1 + __builtin_ctzll(mlo_);
        else {
          const int jj = (j < 64) ? 0 : (j - 63);
          const unsigned long long mhi_ = (jj < 64) ? (whi >> jj) : 0ull;
          if (mhi_ != 0ull) jn = 64 + jj + __builtin_ctzll(mhi_);
        }
        nkb = (jn >= 0) ? jn * 64 : -1;
      }
      const int pkb = (nkb >= 0) ? nkb : kb;
      load_kf(kn_, ksb, pkb, r, quad);
      load_vf(vn_, vsT, S_, pkb, r, quad);
      {
        const int j = kb >> 6;
        f32x4 s[2][2];
        qk_from(kc_, qf, s);
        bf16x8 pf[2];
#pragma unroll
        for (int ct = 0; ct < 2; ct++) {
          const unsigned bit = (unsigned)(((j < 64) ? (mylo[ct] >> j) : (myhi[ct] >> (j - 64))) & 1ull);
          float sc[8];
          unsigned vm = 0;
#pragma unroll
          for (int q = 0; q < 8; q++) {
            int pos = kb + (q >> 2) * 16 + quad * 4 + (q & 3);
            sc[q] = s[q >> 2][ct][q & 3] * qs2 - slope * (float)(tok[ct] - pos);
            if (bit && pos <= tok[ct]) vm |= 1u << q;
          }
          SOFTMAX_UPDATE(64, 2, ct, sc, vm, m[ct], l[ct], o, pf[ct]);
        }
        pv_from(vc_, pf, o);
      }
      if (nkb < 0) break;
      kb = nkb;
      kc_ = kn_;
      vc_ = vn_;
    }
#pragma unroll
    for (int ct = 0; ct < 2; ct++) {
      float lt = quad_sum(l[ct]);
      float gt = gates[(size_t)tok[ct] * 48 + head * 3 + 1] * (lt > 0.f ? 1.f / lt : 0.f);
#pragma unroll
      for (int dt = 0; dt < 4; dt++)
#pragma unroll
        for (int i = 0; i < 4; i++) oacc[dt][ct][i] += gt * o[dt][ct][i];
    }
  }
  {
    m[0] = m[1] = -1e30f; l[0] = l[1] = 0.f;
#pragma unroll
    for (int dt = 0; dt < 4; dt++)
#pragma unroll
      for (int ct = 0; ct < 2; ct++) o[dt][ct] = f32x4{0.f, 0.f, 0.f, 0.f};
    int start = t0 - 511;
    if (start < 0) start = 0;
    start &= ~31;
    const int lastkb = tlast & ~31;
    KF kc_, kn_;
    VF vc_, vn_;
    load_kf(kc_, kwb, start, r, quad);
    load_vf(vc_, vwT, S_, start, r, quad);
    for (int kb = start; kb <= lastkb; kb += 32) {
      const int nkb = min(kb + 32, lastkb);
      load_kf(kn_, kwb, nkb, r, quad);
      load_vf(vn_, vwT, S_, nkb, r, quad);
      f32x4 s[2][2];
      qk_from(kc_, qf, s);
      bf16x8 pf[2];
#pragma unroll
      for (int ct = 0; ct < 2; ct++) {
        float sc[8];
        unsigned vm = 0;
#pragma unroll
        for (int q = 0; q < 8; q++) {
          int pos = kb + (q >> 2) * 16 + quad * 4 + (q & 3);
          int d = tok[ct] - pos;
          sc[q] = s[q >> 2][ct][q & 3] * qs2 - slope * (float)d;
          if (d >= 0 && d < 512) vm |= 1u << q;
        }
        SOFTMAX_UPDATE(64, 2, ct, sc, vm, m[ct], l[ct], o, pf[ct]);
      }
      pv_from(vc_, pf, o);
      kc_ = kn_;
      vc_ = vn_;
    }
#pragma unroll
    for (int ct = 0; ct < 2; ct++) {
      float lt = quad_sum(l[ct]);
      float gt = gates[(size_t)tok[ct] * 48 + head * 3 + 2] * (lt > 0.f ? 1.f / lt : 0.f);
#pragma unroll
      for (int dt = 0; dt < 4; dt++)
#pragma unroll
        for (int i = 0; i < 4; i++) oacc[dt][ct][i] += gt * o[dt][ct][i];
    }
  }
  const bf16_t* zn = (const bf16_t*)(ws + O_ZN);
  bf16_t* Y = (bf16_t*)(ws + O_Y);
#pragma unroll
  for (int ct = 0; ct < 2; ct++)
#pragma unroll
    for (int dt = 0; dt < 4; dt++) {
      int d = dt * 16 + quad * 4;
      uint2 zz = *(const uint2*)(zn + (size_t)tok[ct] * 1024 + head * 64 + d);
      float z0 = __uint_as_float(zz.x << 16), z1 = __uint_as_float(zz.x & 0xffff0000u);
      float z2 = __uint_as_float(zz.y << 16), z3 = __uint_as_float(zz.y & 0xffff0000u);
      uint2 ov;
      ov.x = pack2(oacc[dt][ct][0] * z0, oacc[dt][ct][1] * z1);
      ov.y = pack2(oacc[dt][ct][2] * z2, oacc[dt][ct][3] * z3);
      *(uint2*)(Y + (size_t)tok[ct] * 2048 + head * 64 + d) = ov;
    }
  __builtin_amdgcn_wave_barrier();
}

__device__ __forceinline__ void mla_block_item(KP p, int hd, int tile, char* smem) {
  char* ws = p->ws;
  const int tid = get_tid(), lane = tid & 63, wave = tid >> 6, r = lane & 15, quad = lane >> 4;
  const bf16_t* qm = (const bf16_t*)(ws + O_QM) + (size_t)hd * S_ * 192;
  const bf16_t* km = (const bf16_t*)(ws + O_KM) + (size_t)hd * S_ * 192;
  const bf16_t* vmT = (const bf16_t*)(ws + O_VMT) + (size_t)hd * 128 * S_;
  bf16_t* Kbuf = (bf16_t*)smem;
  bf16_t* Vbuf = (bf16_t*)(smem + 51200);
  const int t0 = tile * 256 + wave * 32;
  bf16x8 qf[6][2];
  int tok[2];
#pragma unroll
  for (int ct = 0; ct < 2; ct++) {
    tok[ct] = t0 + ct * 16 + r;
#pragma unroll
    for (int ks = 0; ks < 6; ks++) qf[ks][ct] = *(const bf16x8*)(qm + (size_t)tok[ct] * 192 + ks * 32 + quad * 8);
  }
  f32x4 o[8][2];
#pragma unroll
  for (int dt = 0; dt < 8; dt++)
#pragma unroll
    for (int ct = 0; ct < 2; ct++) o[dt][ct] = f32x4{0.f, 0.f, 0.f, 0.f};
  float m[2] = {-1e30f, -1e30f}, l[2] = {0.f, 0.f};
  const float scale = 0.07216878364870322f * 1.4426950408889634f;
  const int nsteps = 4 * (tile + 1);
  const int kr0 = tid / 24, kc0 = (tid % 24) * 8;
  const int kr1 = (tid + 512) / 24, kc1 = ((tid + 512) % 24) * 8;
  const int kr2 = (tid + 1024) / 24, kc2 = ((tid + 1024) % 24) * 8;
  const int vr0 = tid >> 3, vc0 = (tid & 7) * 8;
  const int vr1 = (tid + 512) >> 3;
  uint4 k0r, k1r, k2r, v0r, v1r;
#define MLA_GLOAD(kb_)                                                   \
  {                                                                      \
    k0r = *(const uint4*)(km + (size_t)((kb_) + kr0) * 192 + kc0);       \
    k1r = *(const uint4*)(km + (size_t)((kb_) + kr1) * 192 + kc1);       \
    k2r = *(const uint4*)(km + (size_t)((kb_) + kr2) * 192 + kc2);       \
    v0r = *(const uint4*)(vmT + (size_t)vr0 * S_ + (kb_) + vc0);         \
    v1r = *(const uint4*)(vmT + (size_t)vr1 * S_ + (kb_) + vc0);         \
  }
#define MLA_LSTORE(bi_)                                                  \
  {                                                                      \
    bf16_t* Kb_ = Kbuf + (bi_) * 64 * 200;                               \
    bf16_t* Vb_ = Vbuf + (bi_) * 128 * 72;                               \
    *(uint4*)(Kb_ + kr0 * 200 + kc0) = k0r;                              \
    *(uint4*)(Kb_ + kr1 * 200 + kc1) = k1r;                              \
    *(uint4*)(Kb_ + kr2 * 200 + kc2) = k2r;                              \
    *(uint4*)(Vb_ + vr0 * 72 + vc0) = v0r;                               \
    *(uint4*)(Vb_ + vr1 * 72 + vc0) = v1r;                               \
  }
  __syncthreads();
  MLA_GLOAD(0);
  MLA_LSTORE(0);
  __syncthreads();
  for (int st = 0; st < nsteps; st++) {
    const int kb = st * 64;
    if (st + 1 < nsteps) MLA_GLOAD(kb + 64);
    if (kb <= t0 + 31) {
      const bf16_t* Kb_ = Kbuf + (st & 1) * 64 * 200;
      const bf16_t* Vb_ = Vbuf + (st & 1) * 128 * 72;
#pragma unroll
      for (int hf = 0; hf < 2; hf++) {
        if (kb + hf * 32 <= t0 + 31) {
          f32x4 s[2][2];
          qk_step<192, 2>(Kb_, 200, hf * 32, qf, s, r, quad);
          bf16x8 pf[2];
          if (kb + hf * 32 + 31 <= t0) {
#pragma unroll
            for (int ct = 0; ct < 2; ct++) {
              float sc[8];
              const unsigned vm = 0xffu;
#pragma unroll
              for (int j = 0; j < 8; j++) sc[j] = s[j >> 2][ct][j & 3] * scale;
              SOFTMAX_UPDATE(128, 2, ct, sc, vm, m[ct], l[ct], o, pf[ct]);
            }
          } else {
#pragma unroll
            for (int ct = 0; ct < 2; ct++) {
              float sc[8];
              unsigned vm = 0;
#pragma unroll
              for (int j = 0; j < 8; j++) {
                int key = kb + hf * 32 + (j >> 2) * 16 + quad * 4 + (j & 3);
                sc[j] = s[j >> 2][ct][j & 3] * scale;
                if (key <= tok[ct]) vm |= 1u << j;
              }
              SOFTMAX_UPDATE(128, 2, ct, sc, vm, m[ct], l[ct], o, pf[ct]);
            }
          }
          pv_step<128, 2>(Vb_, 72, hf * 32, pf, o, r, quad);
        }
      }
    }
    if (st + 1 < nsteps) MLA_LSTORE((st + 1) & 1);
    __syncthreads();
  }
  const bf16_t* zm = (const bf16_t*)(ws + O_ZM);
  bf16_t* Y = (bf16_t*)(ws + O_Y);
#pragma unroll
  for (int ct = 0; ct < 2; ct++) {
    float lt = quad_sum(l[ct]);
    float il = lt > 0.f ? 1.f / lt : 0.f;
#pragma unroll
    for (int dt = 0; dt < 8; dt++) {
      int d = dt * 16 + quad * 4;
      const bf16_t* zp = zm + (size_t)tok[ct] * 1024 + hd * 128 + d;
      uint2 zz = *(const uint2*)zp;
      float z0 = __uint_as_float(zz.x << 16), z1 = __uint_as_float(zz.x & 0xffff0000u);
      float z2 = __uint_as_float(zz.y << 16), z3 = __uint_as_float(zz.y & 0xffff0000u);
      uint2 ov;
      ov.x = pack2(o[dt][ct][0] * il * z0, o[dt][ct][1] * il * z1);
      ov.y = pack2(o[dt][ct][2] * il * z2, o[dt][ct][3] * il * z3);
      *(uint2*)(Y + (size_t)tok[ct] * 2048 + 1024 + hd * 128 + d) = ov;
    }
  }
}

__device__ __forceinline__ void phase4(KP p, char* smem, int cidx) {
  const int lane = get_tid() & 63, wave = get_tid() >> 6;
  unsigned int* ctr = (unsigned int*)(p->ws + O_CTR) + cidx;
  for (int item = blockIdx.x; item < 256; item += gridDim.x) {
    int tile = 31 - (item >> 3), hd = item & 7;
    mla_block_item(p, hd, tile, smem);
  }
  __syncthreads();
  float* wsm = (float*)(smem + (size_t)wave * 8704);
  const int NNSA = 4096;
  for (;;) {
    int item = 0;
    if (lane == 0) item = (int)atomicAdd(ctr, 1u);
    item = __builtin_amdgcn_readfirstlane(item);
    if (item >= NNSA) break;
    int tile = 2047 - (item >> 1), g = item & 1;
    nsa_item(p, g, tile, wsm);
  }
}

__device__ __forceinline__ void outproj_phase(KP p, const bf16_t* A, const bf16_t* Bt, const float* xres, int layer, char* smem) {
  const float* gate = (const float*)(p->ws + O_MOD) + layer * 6144 + 4096;
  float* out = p->out;
  auto epiD = [&](f32x4(&acc)[4][4], int row0, int col0) {};
  auto epiS = [&](const float* Cs, int m0, int n0, int tid) {
    STAGE_LOOP4(row, c4, v)
      const size_t idx = (size_t)(m0 + row) * 2048 + n0 + c4;
      const float4 x = *(const float4*)(xres + idx);
      const float4 g = *(const float4*)(gate + n0 + c4);
      float4 o;
      o.x = x.x + g.x * v.x; o.y = x.y + g.y * v.y; o.z = x.z + g.z * v.z; o.w = x.w + g.w * v.w;
      *(float4*)(out + idx) = o;
    STAGE_END
  };
  for (int t = blockIdx.x; t < 32 * 8; t += gridDim.x) {
    int pm, pn;
    g8_map(t, 32, 8, pm, pn);
    gemm256_tile(A, 2048, Bt, 2048, 2048, pm * 256, pn * 256, smem, epiS);
  }
}


__device__ __forceinline__ void phase7(KP p, char* smem) {
  char* ws = p->ws;
  auto epiD = [&](f32x4(&acc)[4][4], int row0, int col0) {};
  const int total = 1024 + 64;
  for (int item = blockIdx.x; item < total; item += gridDim.x) {
    if (item >= 1024) {
      const int li = item - 1024;
      int which = li >> 5, mt_ = li & 31;
      bf16_t* dst = (bf16_t*)(ws + (which ? O_LA : O_LW));
      auto epiS = [&](const float* Cs, int m0, int n0, int tid) {
        STAGE_LOOP8(row, c8, va, vb)
          float4 a = va, b = vb;
          if (which == 0) {
            a.x = tanhf(a.x); a.y = tanhf(a.y); a.z = tanhf(a.z); a.w = tanhf(a.w);
            b.x = tanhf(b.x); b.y = tanhf(b.y); b.z = tanhf(b.z); b.w = tanhf(b.w);
          }
          *(uint4*)(dst + (size_t)(m0 + row) * 128 + c8) = pack8(a, b);
        STAGE_END
      };
      gemm_tile<0>((const bf16_t*)(ws + (which ? O_XA : O_XW)), 2048, (const bf16_t*)(ws + (which ? O_WT_A1 : O_WT_W1)), 2048, 2048, mt_ * 256, 0, smem,
                   nullptr, epiD, epiS);
    } else {
      const int prob = item >> 8, tt = item & 255;
      int pm, pn;
      g8_map(tt, 32, 8, pm, pn);
      const size_t woff = prob == 0 ? O_WT_R : prob == 1 ? O_WT_K : prob == 2 ? O_WT_V : O_WT_Z;
      bf16_t* dst = (bf16_t*)(ws + (prob == 0 ? O_R : prob == 1 ? O_K : prob == 2 ? O_V : O_ZS));
      auto epiS = [&](const float* Cs, int m0, int n0, int tid) {
        STAGE_LOOP8(row, c8, va, vb)
          float4 a = va, b = vb;
          if (prob == 3) {
            a.x = siluf(a.x); a.y = siluf(a.y); a.z = siluf(a.z); a.w = siluf(a.w);
            b.x = siluf(b.x); b.y = siluf(b.y); b.z = siluf(b.z); b.w = siluf(b.w);
          }
          *(uint4*)(dst + (size_t)(m0 + row) * 2048 + n0 + c8) = pack8(a, b);
        STAGE_END
      };
      const size_t aoff = prob == 0 ? O_H1 : prob == 1 ? O_XK : prob == 2 ? O_XV : O_XZ;
      gemm256_tile((const bf16_t*)(ws + aoff), 2048, (const bf16_t*)(ws + woff), 2048, 2048, pm * 256, pn * 256, smem, epiS);
    }
  }
}

__device__ __forceinline__ float logdecay_of(float v) {
  return -0.6065306597126334f / (1.f + __expf(-v));
}
__device__ __forceinline__ void phase8(KP p, char* smem) {
  char* ws = p->ws;
  auto epiD = [&](f32x4(&acc)[4][4], int row0, int col0) {};
  for (int item = blockIdx.x; item < 2 * 512; item += gridDim.x) {
    int which = item >> 9, tt = item & 511;
    int mt_ = tt & 31, nt_ = tt >> 5;
    const float* bias = p->in[which ? 29 : 26];
    float* logw = (float*)(ws + O_LOGW);
    bf16_t* ab = (bf16_t*)(ws + O_AB);
    auto epiS = [&](const float* Cs, int m0, int n0, int tid) {
      if (which == 0) {
        STAGE_LOOP4(row, c4, v)
          const float4 b = *(const float4*)(bias + n0 + c4);
          float4 o;
          o.x = logdecay_of(v.x + b.x); o.y = logdecay_of(v.y + b.y); o.z = logdecay_of(v.z + b.z); o.w = logdecay_of(v.w + b.w);
          *(float4*)(logw + (size_t)(m0 + row) * 2048 + n0 + c4) = o;
        STAGE_END
      } else {
        STAGE_LOOP8(row, c8, va, vb)
          const float4 b0 = *(const float4*)(bias + n0 + c8), b1 = *(const float4*)(bias + n0 + c8 + 4);
          float4 a, b;
          a.x = sigmf(va.x + b0.x); a.y = sigmf(va.y + b0.y); a.z = sigmf(va.z + b0.z); a.w = sigmf(va.w + b0.w);
          b.x = sigmf(vb.x + b1.x); b.y = sigmf(vb.y + b1.y); b.z = sigmf(vb.z + b1.z); b.w = sigmf(vb.w + b1.w);
          *(uint4*)(ab + (size_t)(m0 + row) * 2048 + n0 + c8) = pack8(a, b);
        STAGE_END
      }
    };
    gemm_tile<0>((const bf16_t*)(ws + (which ? O_LA : O_LW)), 128, (const bf16_t*)(ws + (which ? O_WT_A2 : O_WT_W2)), 128, 128,
                 mt_ * 256, nt_ * 128, smem, nullptr, epiD, epiS);
  }
}

__device__ __forceinline__ f32x4 mmt(const float* A, int ars, int acs, const float* B, int brs, int bcs, int nks, f32x4 acc,
                                     int lane) {
  const int r = lane & 15, q = lane >> 4;
  const float* ap = A + r * ars + q * acs;
  const float* bp = B + q * brs + r * bcs;
#pragma unroll 4
  for (int ks = 0; ks < nks; ks++) {
    acc = __builtin_amdgcn_mfma_f32_16x16x4f32(ap[4 * ks * acs], bp[4 * ks * brs], acc, 0, 0, 0);
  }
  return acc;
}

__device__ __forceinline__ void phase9(KP p, int half, float* sm) {
  char* ws = p->ws;
  constexpr int LS = 65;
  constexpr int US = 64 * LS;
  float* U0 = sm;
  float* U1 = sm + 1 * US;
  float* U2 = sm + 2 * US;
  float* U3 = sm + 3 * US;
  float* U4 = sm + 4 * US;
  float* U5 = sm + 5 * US;
  float* U6 = sm + 6 * US;
  float* U7 = sm + 7 * US;
  float* U8 = sm + 8 * US;
  float* gC = sm + 9 * US;
  const int tid = get_tid(), lane = tid & 63, wave = tid >> 6, r = lane & 15, quad = lane >> 4;
  const bf16_t* Rb = (const bf16_t*)(ws + O_R);
  const bf16_t* Kb = (const bf16_t*)(ws + O_K);
  const bf16_t* Vb = (const bf16_t*)(ws + O_V);
  const bf16_t* Ab = (const bf16_t*)(ws + O_AB);
  const float* LW = (const float*)(ws + O_LOGW);
  float* bon = (float*)(ws + O_BON);
  float* CHP = (float*)(ws + O_CHP);
  float* CHQ = (float*)(ws + O_CHQ);
  bf16_t* CHG = (bf16_t*)(ws + O_CHG);
  bf16_t* CHY = (bf16_t*)(ws + O_CHY);
  const float* k_k = p->in[32];
  const float* k_a = p->in[33];
  const float* r_k = p->in[34];
  uint4 nR, nK, nV, nA;
  float4 nL0, nL1;
#define P9_PREFETCH(slot_)                                                        \
  {                                                                               \
    const int hl_ = (slot_) >> 7, c_ = (slot_) & 127;                             \
    const size_t gi_ = (size_t)(c_ * 64 + (tid >> 3)) * 2048 + (half * 16 + hl_) * 64 + (tid & 7) * 8; \
    nR = *(const uint4*)(Rb + gi_); nK = *(const uint4*)(Kb + gi_);               \
    nV = *(const uint4*)(Vb + gi_); nA = *(const uint4*)(Ab + gi_);               \
    nL0 = *(const float4*)(LW + gi_); nL1 = *(const float4*)(LW + gi_ + 4);       \
  }
  if ((int)blockIdx.x < 2048) P9_PREFETCH((int)blockIdx.x);
  for (int slot = blockIdx.x; slot < 2048; slot += gridDim.x) {
    const int hl = slot >> 7, c = slot & 127;
    const int hd = half * 16 + hl;
    {
      const int i = tid >> 3, kg = (tid & 7) * 8;
      const int t = c * 64 + i, ch = hd * 64 + kg;
      float rr[8], kk_[8], vv[8], aa[8], lw[8];
      unpack8(nR, rr);
      unpack8(nK, kk_);
      unpack8(nV, vv);
      unpack8(nA, aa);
      {
        float4 l0 = nL0, l1 = nL1;
        { const int ns_ = slot + (int)gridDim.x; P9_PREFETCH(ns_ < 2048 ? ns_ : slot); }
        lw[0] = l0.x; lw[1] = l0.y; lw[2] = l0.z; lw[3] = l0.w; lw[4] = l1.x; lw[5] = l1.y; lw[6] = l1.z; lw[7] = l1.w;
      }
      float kn[8], k2[8];
      float ss = 0.f, bs = 0.f;
#pragma unroll
      for (int j = 0; j < 8; j++) {
        kn[j] = kk_[j] * k_k[ch + j];
        ss += kn[j] * kn[j];
        k2[j] = kk_[j] * (1.f + (aa[j] - 1.f) * k_a[ch + j]);
        bs += rr[j] * k2[j] * r_k[ch + j];
      }
      ss += __shfl_xor(ss, 1); ss += __shfl_xor(ss, 2); ss += __shfl_xor(ss, 4);
      bs += __shfl_xor(bs, 1); bs += __shfl_xor(bs, 2); bs += __shfl_xor(bs, 4);
      const float inrm = 1.f / fmaxf(sqrtf(ss), 1e-12f);
      if ((tid & 7) == 0) bon[(size_t)t * 32 + hd] = bs;
#pragma unroll
      for (int j = 0; j < 8; j++) U5[i * LS + kg + j] = lw[j];
      __syncthreads();
      if (tid < 64) {
        float xs[64];
#pragma unroll
        for (int ii = 0; ii < 64; ii++) xs[ii] = U5[ii * LS + tid];
        float run = 0.f;
#pragma unroll
        for (int ii = 0; ii < 64; ii++) { run += xs[ii]; U5[ii * LS + tid] = run; }
        gC[tid] = __expf(run);
      }
      __syncthreads();
#pragma unroll
      for (int j = 0; j < 8; j++) {
        float L = U5[i * LS + kg + j];
        float Lp = L - lw[j];
        float eL = __expf(L), eLp = __expf(Lp), enL = __expf(-L);
        float kkn = kn[j] * inrm;
        int o = i * LS + kg + j;
        U3[o] = -kkn * eLp;
        U4[o] = rr[j] * eL;
        U0[o] = k2[j] * enL;
        U1[o] = kkn * aa[j] * enL;
        U2[o] = vv[j];
      }
    }
    __syncthreads();
    f32x4 ginit[2];
    {
      const int mI = wave >> 1, hf = wave & 1;
      const float* As_ = (mI < 2) ? U3 : U4;
      const float* Bs_ = (mI & 1) ? U1 : U0;
      float* dst = U5 + mI * US;
#pragma unroll
      for (int pass = 0; pass < 2; pass++) {
        const int it = (pass == 0) ? (hf ? 1 : 0) : (hf ? 2 : 3);
        f32x4 acc4[4];
#pragma unroll
        for (int jt = 0; jt < 4; jt++) acc4[jt] = f32x4{0.f, 0.f, 0.f, 0.f};
        const float* ap = As_ + (it * 16 + r) * LS + quad;
        const float* bp = Bs_ + r * LS + quad;
#pragma unroll 4
        for (int ks = 0; ks < 16; ks++) {
          const float av = ap[4 * ks];
#pragma unroll
          for (int jt = 0; jt < 4; jt++)
            if (jt <= it) acc4[jt] = __builtin_amdgcn_mfma_f32_16x16x4f32(av, bp[jt * 16 * LS + 4 * ks], acc4[jt], 0, 0, 0);
        }
#pragma unroll
        for (int jt = 0; jt < 4; jt++) {
#pragma unroll
          for (int v = 0; v < 4; v++) {
            int i = it * 16 + quad * 4 + v, j = jt * 16 + r;
            bool keep = (mI < 2) ? (j < i) : (j <= i);
            dst[i * LS + j] = keep ? acc4[jt][v] : 0.f;
          }
        }
      }
      const int it = wave >> 1;
#pragma unroll
      for (int x = 0; x < 2; x++) {
        int jt = (wave & 1) * 2 + x;
#pragma unroll
        for (int v = 0; v < 4; v++) ginit[x][v] = U4[(it * 16 + quad * 4 + v) * LS + jt * 16 + r];
      }
    }
    __syncthreads();
    {
      const int it = wave >> 1, jt0 = (wave & 1) * 2;
      f32x4 xa0 = f32x4{0.f, 0.f, 0.f, 0.f}, xa1 = f32x4{0.f, 0.f, 0.f, 0.f};
      const float* ap = U5 + (it * 16 + r) * LS + quad;
      const float* bp = U2 + quad * LS + jt0 * 16 + r;
#pragma unroll 4
      for (int ks = 0; ks < 16; ks++) {
        const float av = ap[4 * ks];
        xa0 = __builtin_amdgcn_mfma_f32_16x16x4f32(av, bp[4 * ks * LS], xa0, 0, 0, 0);
        xa1 = __builtin_amdgcn_mfma_f32_16x16x4f32(av, bp[4 * ks * LS + 16], xa1, 0, 0, 0);
      }
      __syncthreads();
#pragma unroll
      for (int v = 0; v < 4; v++) {
        U5[(it * 16 + quad * 4 + v) * LS + jt0 * 16 + r] = xa0[v];
        U5[(it * 16 + quad * 4 + v) * LS + jt0 * 16 + 16 + r] = xa1[v];
      }
    }
    __syncthreads();
    {
      float* Rb_ = (wave < 4) ? (U3 + wave * 16) : (U5 + (wave - 4) * 16);
#pragma unroll 1
      for (int blk = 0; blk < 4; blk++) {
        f32x4 sv;
#pragma unroll
        for (int v = 0; v < 4; v++) sv[v] = Rb_[(16 * blk + quad * 4 + v) * LS + r];
        {
          const float* ap = U6 + (16 * blk + r) * LS + quad;
          const float* bp = Rb_ + quad * LS + r;
          for (int ks = 0; ks < 4 * blk; ks++)
            sv = __builtin_amdgcn_mfma_f32_16x16x4f32(ap[4 * ks], bp[4 * ks * LS], sv, 0, 0, 0);
        }
        float nd[4][16];
#pragma unroll
        for (int v = 0; v < 4; v++)
#pragma unroll
          for (int i = 0; i < 16; i++) nd[v][i] = U6[(16 * blk + quad * 4 + v) * LS + 16 * blk + i];
#pragma unroll
        for (int i = 0; i < 15; i++) {
          const float ui = __shfl(sv[i & 3], (i >> 2) * 16 + r);
#pragma unroll
          for (int v = 0; v < 4; v++) sv[v] += nd[v][i] * ui;
        }
#pragma unroll
        for (int v = 0; v < 4; v++) Rb_[(16 * blk + quad * 4 + v) * LS + r] = sv[v];
        __builtin_amdgcn_s_waitcnt(0);
        __builtin_amdgcn_wave_barrier();
      }
    }
    __syncthreads();
    {
      const int it = wave >> 1, jt0 = (wave & 1) * 2;
      const size_t sbase = (size_t)slot * 4096;
      f32x4 g_[2], y1[2], y2[2], p_[2], q1[2], q2[2];
#pragma unroll
      for (int x = 0; x < 2; x++) {
        g_[x] = ginit[x];
        y1[x] = y2[x] = p_[x] = q1[x] = q2[x] = f32x4{0.f, 0.f, 0.f, 0.f};
      }
      const float* a_rb = U8 + (it * 16 + r) * LS + quad;
      const float* a_rk = U7 + (it * 16 + r) * LS + quad;
      const float* a_bt = U1 + quad * LS + it * 16 + r;
      const float* a_kt = U0 + quad * LS + it * 16 + r;
      const float* b_w1 = U3 + quad * LS + jt0 * 16 + r;
      const float* b_v = U2 + quad * LS + jt0 * 16 + r;
      const float* b_w2 = U5 + quad * LS + jt0 * 16 + r;
#pragma unroll 2
      for (int ks = 0; ks < 16; ks++) {
        const float arb = a_rb[4 * ks], ark = a_rk[4 * ks], abt = a_bt[4 * ks * LS], akt = a_kt[4 * ks * LS];
#pragma unroll
        for (int x = 0; x < 2; x++) {
          const float w1 = b_w1[4 * ks * LS + 16 * x], vv_ = b_v[4 * ks * LS + 16 * x], w2 = b_w2[4 * ks * LS + 16 * x];
          g_[x] = __builtin_amdgcn_mfma_f32_16x16x4f32(arb, w1, g_[x], 0, 0, 0);
          y1[x] = __builtin_amdgcn_mfma_f32_16x16x4f32(ark, vv_, y1[x], 0, 0, 0);
          y2[x] = __builtin_amdgcn_mfma_f32_16x16x4f32(arb, w2, y2[x], 0, 0, 0);
          p_[x] = __builtin_amdgcn_mfma_f32_16x16x4f32(abt, w1, p_[x], 0, 0, 0);
          q1[x] = __builtin_amdgcn_mfma_f32_16x16x4f32(akt, vv_, q1[x], 0, 0, 0);
          q2[x] = __builtin_amdgcn_mfma_f32_16x16x4f32(abt, w2, q2[x], 0, 0, 0);
        }
      }
#pragma unroll
      for (int x = 0; x < 2; x++) {
#pragma unroll
        for (int v = 0; v < 4; v++) {
          int row = it * 16 + quad * 4 + v, colx = (jt0 + x) * 16 + r;
          size_t o = sbase + row * 64 + colx;
          CHG[o] = f2bf(g_[x][v]);
          CHY[o] = f2bf(y1[x][v] + y2[x][v]);
          float gc = gC[row];
          CHP[o] = gc * (p_[x][v] + (row == colx ? 1.f : 0.f));
          CHQ[o] = gc * (q1[x][v] + q2[x][v]);
        }
      }
    }
    __syncthreads();
  }
}

__device__ __forceinline__ void phase10(KP p, int half, float* sm) {
  char* ws = p->ws;
  if (blockIdx.x >= 64) return;
  const int bidx = blockIdx.x;
  const int hl = bidx >> 2, vs = bidx & 3;
  const int tid = get_tid(), lane = tid & 63, wave = tid >> 6, r = lane & 15, q = lane >> 4;
  const float* CHP = (const float*)(ws + O_CHP);
  const float* CHQ = (const float*)(ws + O_CHQ);
  float* S0 = (float*)(ws + O_S0);
  float* Sb = sm;
  const size_t hbase = (size_t)(hl * 128) * 4096;
  if (wave < 4) {
    const float* Pb = CHP + hbase + (16 * wave + r) * 64 + 16 * q;
    const float* Qb = CHQ + hbase + (16 * wave + 4 * q) * 64 + vs * 16 + r;
    float4 A0, B0, C0, D0, A1, B1, C1, D1, A2, B2, C2, D2, A3, B3, C3, D3;
    f32x4 Q0, Q1, Q2, Q3;
#define PF_S(k_, c_)                                                         \
  {                                                                          \
    __builtin_amdgcn_sched_barrier(0);                                       \
    const size_t so_ = (size_t)min((c_), 127) * 4096;                        \
    A##k_ = *(const float4*)(Pb + so_);                                      \
    B##k_ = *(const float4*)(Pb + so_ + 4);                                  \
    C##k_ = *(const float4*)(Pb + so_ + 8);                                  \
    D##k_ = *(const float4*)(Pb + so_ + 12);                                 \
    Q##k_[0] = Qb[so_]; Q##k_[1] = Qb[so_ + 64]; Q##k_[2] = Qb[so_ + 128]; Q##k_[3] = Qb[so_ + 192]; \
    __builtin_amdgcn_sched_barrier(0);                                       \
  }
    f32x4 st = f32x4{0.f, 0.f, 0.f, 0.f};
#define STEP_S(k_, c_)                                                                         \
  {                                                                                            \
    float* sbuf = Sb + ((c_) & 1) * 16 * 68;                                                   \
    *(float4*)(sbuf + r * 68 + 16 * wave + 4 * q) = float4{st[0], st[1], st[2], st[3]};        \
    float a[16] = {A##k_.x, A##k_.y, A##k_.z, A##k_.w, B##k_.x, B##k_.y, B##k_.z, B##k_.w,      \
                   C##k_.x, C##k_.y, C##k_.z, C##k_.w, D##k_.x, D##k_.y, D##k_.z, D##k_.w};     \
    f32x4 acc = Q##k_;                                                                         \
    asm volatile("s_waitcnt lgkmcnt(0)\n\ts_barrier" ::: "memory");                            \
    f32x4 acc2 = f32x4{0.f, 0.f, 0.f, 0.f};                                                    \
    {                                                                                          \
      const float4 s0_ = *(const float4*)(sbuf + r * 68 + 16 * q), s1_ = *(const float4*)(sbuf + r * 68 + 16 * q + 4);  \
      const float4 s2_ = *(const float4*)(sbuf + r * 68 + 16 * q + 8), s3_ = *(const float4*)(sbuf + r * 68 + 16 * q + 12); \
      const float sv_[16] = {s0_.x, s0_.y, s0_.z, s0_.w, s1_.x, s1_.y, s1_.z, s1_.w, s2_.x, s2_.y, s2_.z, s2_.w, s3_.x, s3_.y, s3_.z, s3_.w}; \
      _Pragma("unroll") for (int ks = 0; ks < 16; ks += 2) {                                   \
        acc = __builtin_amdgcn_mfma_f32_16x16x4f32(a[ks], sv_[ks], acc, 0, 0, 0);              \
        acc2 = __builtin_amdgcn_mfma_f32_16x16x4f32(a[ks + 1], sv_[ks + 1], acc2, 0, 0, 0);    \
      }                                                                                        \
    }                                                                                          \
    PF_S(k_, (c_) + 4)                                                                         \
    _Pragma("unroll") for (int v = 0; v < 4; v++) acc[v] += acc2[v];                           \
    st = acc;                                                                                  \
  }
    PF_S(0, 0) PF_S(1, 1) PF_S(2, 2) PF_S(3, 3)
    for (int c = 0; c < 128; c += 4) {
      STEP_S(0, c) STEP_S(1, c + 1) STEP_S(2, c + 2) STEP_S(3, c + 3)
    }
  } else {
    const int w4 = wave - 4;
    for (int c = 0; c < 128; c++) {
      const float* sbuf = Sb + (c & 1) * 16 * 68;
      asm volatile("s_waitcnt lgkmcnt(0)\n\ts_barrier" ::: "memory");
      float* dst = S0 + hbase + (size_t)c * 4096 + vs * 16;
      const float4 sv4 = *(const float4*)(sbuf + r * 68 + 16 * w4 + 4 * q);
      const int k0_ = 16 * w4 + 4 * q;
      dst[(k0_ + 0) * 64 + r] = sv4.x; dst[(k0_ + 1) * 64 + r] = sv4.y; dst[(k0_ + 2) * 64 + r] = sv4.z; dst[(k0_ + 3) * 64 + r] = sv4.w;
    }
  }
}

__device__ __forceinline__ void phase10b(KP p, int half, float* sm) {
  char* ws = p->ws;
  constexpr int LS = 65;
  constexpr int TS = 64 * LS;
  float* S0s = sm;
  float* Ys = sm + 2 * TS;
  const int tid = get_tid(), lane = tid & 63, wave = tid >> 6, r = lane & 15, quad = lane >> 4;
  const float* S0 = (const float*)(ws + O_S0);
  const bf16_t* CHG = (const bf16_t*)(ws + O_CHG);
  const bf16_t* CHY = (const bf16_t*)(ws + O_CHY);
  const bf16_t* Vb = (const bf16_t*)(ws + O_V);
  const bf16_t* Zs = (const bf16_t*)(ws + O_ZS);
  const float* bon = (const float*)(ws + O_BON);
  const float* lg = p->in[35];
  const float* lb = p->in[36];
  bf16_t* YR = (bf16_t*)(ws + O_YR);
  const int it = wave >> 1, vt0 = (wave & 1) * 2;
  for (int s0 = blockIdx.x; s0 < 2048; s0 += 2 * (int)gridDim.x) {
    const int s1raw = s0 + (int)gridDim.x;
    const bool two = s1raw < 2048;
    const int slots[2] = {s0, two ? s1raw : s0};
    __syncthreads();
#pragma unroll
    for (int u = 0; u < 2; u++) {
      const size_t sbase = (size_t)slots[u] * 4096;
      for (int e = tid; e < 1024; e += NTHR) {
        const int k = e >> 4, v4 = (e & 15) * 4;
        const float4 f = *(const float4*)(S0 + sbase + k * 64 + v4);
        float* d_ = S0s + u * TS + k * LS + v4;
        d_[0] = f.x; d_[1] = f.y; d_[2] = f.z; d_[3] = f.w;
      }
    }
    float a[2][16];
    f32x4 acc[2][2];
#pragma unroll
    for (int u = 0; u < 2; u++) {
      const size_t sbase = (size_t)slots[u] * 4096;
      const bf16_t* G = CHG + sbase + (16 * it + r) * 64 + 16 * quad;
      unpack8(*(const uint4*)G, a[u]);
      unpack8(*(const uint4*)(G + 8), a[u] + 8);
#pragma unroll
      for (int v = 0; v < 4; v++) {
        acc[u][0][v] = bf2f(CHY[sbase + (16 * it + 4 * quad + v) * 64 + vt0 * 16 + r]);
        acc[u][1][v] = bf2f(CHY[sbase + (16 * it + 4 * quad + v) * 64 + vt0 * 16 + 16 + r]);
      }
    }
    __syncthreads();
#pragma unroll
    for (int ks = 0; ks < 16; ks++) {
#pragma unroll
      for (int u = 0; u < 2; u++) {
        const float* sp = S0s + u * TS + (16 * quad + ks) * LS + vt0 * 16 + r;
        acc[u][0] = __builtin_amdgcn_mfma_f32_16x16x4f32(a[u][ks], sp[0], acc[u][0], 0, 0, 0);
        acc[u][1] = __builtin_amdgcn_mfma_f32_16x16x4f32(a[u][ks], sp[16], acc[u][1], 0, 0, 0);
      }
    }
#pragma unroll
    for (int u = 0; u < 2; u++)
#pragma unroll
      for (int v = 0; v < 4; v++) {
        Ys[u * TS + (16 * it + 4 * quad + v) * LS + vt0 * 16 + r] = acc[u][0][v];
        Ys[u * TS + (16 * it + 4 * quad + v) * LS + vt0 * 16 + 16 + r] = acc[u][1][v];
      }
    __syncthreads();
#pragma unroll
    for (int u = 0; u < 2; u++) {
      if (u == 1 && !two) break;
      const int hl = slots[u] >> 7, c = slots[u] & 127, hd = half * 16 + hl;
      const int i = tid >> 3, vg = (tid & 7) * 8;
      const int t = c * 64 + i, ch = hd * 64 + vg;
      float y[8];
      float s = 0.f;
#pragma unroll
      for (int j = 0; j < 8; j++) { y[j] = Ys[u * TS + i * LS + vg + j]; s += y[j]; }
      s += __shfl_xor(s, 1); s += __shfl_xor(s, 2); s += __shfl_xor(s, 4);
      const float mean = s * (1.f / 64.f);
      float vr = 0.f;
#pragma unroll
      for (int j = 0; j < 8; j++) { float d = y[j] - mean; vr += d * d; }
      vr += __shfl_xor(vr, 1); vr += __shfl_xor(vr, 2); vr += __shfl_xor(vr, 4);
      const float rstd = rsqrtf(vr * (1.f / 64.f) + 64e-5f);
      const float bo = bon[(size_t)t * 32 + hd];
      const size_t gi = (size_t)t * 2048 + ch;
      float vv[8], zz[8];
      unpack8(*(const uint4*)(Vb + gi), vv);
      unpack8(*(const uint4*)(Zs + gi), zz);
      float o[8];
#pragma unroll
      for (int j = 0; j < 8; j++) o[j] = ((y[j] - mean) * rstd * lg[ch + j] + lb[ch + j] + bo * vv[j]) * zz[j];
      uint4 uu;
      uu.x = pack2(o[0], o[1]); uu.y = pack2(o[2], o[3]); uu.z = pack2(o[4], o[5]); uu.w = pack2(o[6], o[7]);
      *(uint4*)(YR + gi) = uu;
    }
  }
}

__device__ __forceinline__ void phase11(KP p) {
  char* ws = p->ws;
  const int lane = get_tid() & 63, wave = get_tid() >> 6;
  const bf16_t* yraw = (const bf16_t*)(ws + O_YRAW);
  const bf16_t* Vb = (const bf16_t*)(ws + O_V);
  const bf16_t* Zs = (const bf16_t*)(ws + O_ZS);
  const float* bon = (const float*)(ws + O_BON);
  const float* lg = p->in[35];
  const float* lb = p->in[36];
  bf16_t* YR = (bf16_t*)(ws + O_YR);
  for (int t = blockIdx.x * 8 + wave; t < S_; t += gridDim.x * 8) {
    const size_t base = (size_t)t * 2048 + lane * 32;
    float y[32];
#pragma unroll
    for (int x = 0; x < 4; x++) unpack8(*(const uint4*)(yraw + base + 8 * x), y + 8 * x);
    float s = 0.f;
#pragma unroll
    for (int x = 0; x < 32; x++) s += y[x];
    s += __shfl_xor(s, 1);
    float mean = s * (1.f / 64.f);
    float vr = 0.f;
#pragma unroll
    for (int x = 0; x < 32; x++) { float d = y[x] - mean; vr += d * d; }
    vr += __shfl_xor(vr, 1);
    float rstd = rsqrtf(vr * (1.f / 64.f) + 64e-5f);
    float bo = bon[(size_t)t * 32 + (lane >> 1)];
#pragma unroll
    for (int x = 0; x < 4; x++) {
      float vv[8], zz[8];
      unpack8(*(const uint4*)(Vb + base + 8 * x), vv);
      unpack8(*(const uint4*)(Zs + base + 8 * x), zz);
      float o[8];
#pragma unroll
      for (int j = 0; j < 8; j++) {
        int ch = lane * 32 + 8 * x + j;
        o[j] = ((y[8 * x + j] - mean) * rstd * lg[ch] + lb[ch] + bo * vv[j]) * zz[j];
      }
      uint4 u;
      u.x = pack2(o[0], o[1]); u.y = pack2(o[2], o[3]); u.z = pack2(o[4], o[5]); u.w = pack2(o[6], o[7]);
      *(uint4*)(YR + base + 8 * x) = u;
    }
  }
}

__device__ __forceinline__ void phase13(KP p) {
  const int lane = get_tid() & 63, wave = get_tid() >> 6;
  const float* g = p->in[5];
  for (int row = blockIdx.x * 8 + wave; row < S_; row += gridDim.x * 8) {
    float* xr = p->out + (size_t)row * 2048;
    float4 v[8];
    float ss = 0.f;
#pragma unroll
    for (int j = 0; j < 8; j++) {
      v[j] = *(const float4*)(xr + lane * 4 + 256 * j);
      ss += v[j].x * v[j].x + v[j].y * v[j].y + v[j].z * v[j].z + v[j].w * v[j].w;
    }
    ss = wave_sum(ss);
    float rstd = rsqrtf(ss * (1.f / 2048.f) + 1e-6f);
#pragma unroll
    for (int j = 0; j < 8; j++) {
      int col = lane * 4 + 256 * j;
      float4 gg = *(const float4*)(g + col);
      float4 o;
      o.x = v[j].x * rstd * gg.x; o.y = v[j].y * rstd * gg.y; o.z = v[j].z * rstd * gg.z; o.w = v[j].w * rstd * gg.w;
      *(float4*)(xr + col) = o;
    }
  }
}

#include <vector>

#define XB_TMO      128
#define XB_XCNT(j)  (256  + 64 * (j))
#define XB_XSUB(j)  (1280 + 64 * (j))
#define XB_XGEN(j)  (2304 + 64 * (j))
#define XB_TOP      3328
#define XB_TOPGEN   3392
#define XCD_BAR_WORDS 3456
#define XB_SPIN_CAP (1u << 18)
#define LAS __attribute__((address_space(3)))

__device__ __forceinline__ unsigned xb_ld(unsigned* p)              { return __hip_atomic_load(p, __ATOMIC_RELAXED, __HIP_MEMORY_SCOPE_AGENT); }
__device__ __forceinline__ unsigned xb_add(unsigned* p, unsigned v) { return __hip_atomic_fetch_add(p, v, __ATOMIC_RELAXED, __HIP_MEMORY_SCOPE_AGENT); }
__device__ __forceinline__ unsigned xb_xcc_id() { return (unsigned)__builtin_amdgcn_s_getreg((3 << 11) | 20) & 0xFu; }
#define XB_SPIN(cond, bar) do { unsigned _sp = 0; while (cond) { __builtin_amdgcn_s_sleep(1); \
    if ((++_sp & 255u) == 0u) { if (xb_ld(&(bar)[XB_TMO])) break; if (_sp > XB_SPIN_CAP) { atomicAdd(&(bar)[XB_TMO], 1u); break; } } } } while (0)

struct XcdBarrier {
    unsigned* bar; unsigned x;
    volatile LAS unsigned* st;
};

__device__ __forceinline__ XcdBarrier xcd_barrier_post(unsigned* bar, volatile LAS unsigned* st) {
    XcdBarrier b; b.bar = bar; b.x = xb_xcc_id(); b.st = st;
    if (threadIdx.x == 0) (void)xb_add(&bar[XB_XCNT(b.x)], 1u);
    return b;
}
__device__ __forceinline__ void xcd_barrier_complete(unsigned* bar, unsigned x, unsigned& nloc, unsigned& nx) {
    const unsigned G = gridDim.x * gridDim.y * gridDim.z;
    unsigned sum, cnt, mine, sp = 0u;
    for (;;) {
        sum = 0u; cnt = 0u; mine = 0u;
#pragma unroll
        for (unsigned j = 0; j < 16; ++j) { const unsigned c = xb_ld(&bar[XB_XCNT(j)]); sum += c; cnt += (c > 0u) ? 1u : 0u; mine = (j == x) ? c : mine; }
        if (sum == G) break;
        __builtin_amdgcn_s_sleep(1);
        if ((++sp & 255u) == 0u) { if (xb_ld(&bar[XB_TMO])) break; if (sp > XB_SPIN_CAP) { atomicAdd(&bar[XB_TMO], 1u); break; } }
    }
    nloc = mine > 0u ? mine : 1u; nx = cnt > 0u ? cnt : 1u;
}

__device__ __forceinline__ void xcd_barrier(const XcdBarrier& b) {
    asm volatile("s_waitcnt vmcnt(0)" ::: "memory");
    __syncthreads();
    if (threadIdx.x == 0) {
        unsigned* bar = b.bar;
        __builtin_amdgcn_s_waitcnt(0);
        unsigned nloc = b.st[0], nx = b.st[1];
        if (nloc == 0u) { xcd_barrier_complete(bar, b.x, nloc, nx); b.st[0] = nloc; b.st[1] = nx; }
        const unsigned old = xb_add(&bar[XB_XSUB(b.x)], 1u);
        const unsigned gen = old / nloc;
        if (old + 1u == (gen + 1u) * nloc) {
            __builtin_amdgcn_fence(__ATOMIC_RELEASE, "agent");
            asm volatile("s_waitcnt vmcnt(0)" ::: "memory");
            const unsigned og = xb_add(&bar[XB_TOP], 1u);
            const unsigned tg = og / nx;
            if (og + 1u == (tg + 1u) * nx) xb_add(&bar[XB_TOPGEN], 1u);
            else XB_SPIN(xb_ld(&bar[XB_TOPGEN]) == tg, bar);
            __builtin_amdgcn_fence(__ATOMIC_ACQUIRE, "agent");
            xb_add(&bar[XB_XGEN(b.x)], 1u);
            asm volatile("s_waitcnt vmcnt(0)" ::: "memory");
        } else {
            XB_SPIN(xb_ld(&bar[XB_XGEN(b.x)]) == gen, bar);
            __builtin_amdgcn_fence(__ATOMIC_ACQUIRE, "agent");
            asm volatile("s_waitcnt vmcnt(0)" ::: "memory");
        }
    }
    __syncthreads();
}

__global__ void __launch_bounds__(NTHR) fwd_megakernel(Params p_unused) {
  extern __shared__ __attribute__((aligned(16))) char smem[];
  cg::grid_group grid = cg::this_grid();
  float* smf = (float*)smem;
  KP p = (KP)__builtin_amdgcn_kernarg_segment_ptr();
#define LAUNDER() asm volatile("" : "+s"(p))
  {
    volatile LAS unsigned* st0 = (volatile LAS unsigned*)(smem + 150528);
    if (threadIdx.x == 0) { st0[0] = 0u; st0[1] = 0u; st0[2] = 0u; st0[3] = 0u; }
    __syncthreads();
    (void)xcd_barrier_post((unsigned*)(p->ws + O_BAR), st0);
  }
#define GRID_BARRIER()                                                       \
  {                                                                          \
    XcdBarrier xb_;                                                          \
    xb_.bar = (unsigned*)(p->ws + O_BAR);                                    \
    xb_.x = xb_xcc_id();                                                     \
    xb_.st = (volatile LAS unsigned*)(smem + 150528);                        \
    xcd_barrier(xb_);                                                        \
  }
  phase0(p, smf);
  if (p->out == nullptr) grid.sync();
  GRID_BARRIER();
  LAUNDER();
  norm_phase(p, 0, p->in[0], (bf16_t*)(p->ws + O_H0), smf);
  GRID_BARRIER();
  LAUNDER();
  phase2(p, smem);
  GRID_BARRIER();
  LAUNDER();
  phase3(p, smem);
  GRID_BARRIER();
  LAUNDER();
  phase4(p, smem, 0);
  GRID_BARRIER();
  LAUNDER();
  outproj_phase(p, (const bf16_t*)(p->ws + O_Y), (const bf16_t*)(p->ws + O_WT_OUT), p->in[0], 0, smem);
  GRID_BARRIER();
  LAUNDER();
#if PROBE == 1
  phase2(p, smem);
  GRID_BARRIER();
  LAUNDER();
  phase3(p, smem);
  GRID_BARRIER();
  LAUNDER();
  phase4(p, smem, 1);
  GRID_BARRIER();
  LAUNDER();
  outproj_phase(p, (const bf16_t*)(p->ws + O_Y), (const bf16_t*)(p->ws + O_WT_OUT), p->in[0], 0, smem);
  GRID_BARRIER();
  LAUNDER();
#endif
#if PROBE == 2
  phase4(p, smem, 1);
  GRID_BARRIER();
  LAUNDER();
#endif
  norm_shift_phase(p, smf);
  GRID_BARRIER();
  LAUNDER();
  phase7(p, smem);
  GRID_BARRIER();
  LAUNDER();
  phase8(p, smem);
  GRID_BARRIER();
  LAUNDER();
  for (int half = 0; half < 2; half++) {
    phase9(p, half, smf);
    GRID_BARRIER();
    LAUNDER();
    phase10(p, half, smf);
    GRID_BARRIER();
    LAUNDER();
    phase10b(p, half, smf);
    GRID_BARRIER();
    LAUNDER();
  }
  outproj_phase(p, (const bf16_t*)(p->ws + O_YR), (const bf16_t*)(p->ws + O_WT_O), p->out, 1, smem);
  GRID_BARRIER();
  LAUNDER();
  phase13(p);
}

extern "C" void kernel_launch(void* const* d_in, const int* in_sizes, int n_in, void* d_out, int out_size, void* d_ws,
                              size_t ws_size, hipStream_t stream) {
  static int grid_blocks = 0;
  if (!grid_blocks) {
    int dev = 0, cus = 0, per_cu = 0;
    hipGetDevice(&dev);
    hipDeviceGetAttribute(&cus, hipDeviceAttributeMultiprocessorCount, dev);
    hipFuncSetAttribute((const void*)fwd_megakernel, hipFuncAttributeMaxDynamicSharedMemorySize, LDS_BYTES);
    hipOccupancyMaxActiveBlocksPerMultiprocessor(&per_cu, (const void*)fwd_megakernel, NTHR, LDS_BYTES);
    if (per_cu < 1) per_cu = 1;
    grid_blocks = cus * per_cu;
    if (ws_size < WS_NEED) fprintf(stderr, "workspace too small: %zu < %zu\n", ws_size, (size_t)WS_NEED);
  }
  Params hp{};
  for (int i = 0; i < 37; i++) hp.in[i] = (const float*)d_in[i];
  hp.out = (float*)d_out;
  hp.ws = (char*)d_ws;
  (void)hipMemsetAsync((char*)d_ws + O_BAR, 0, XCD_BAR_WORDS * sizeof(unsigned), stream);
  void* args[] = {&hp};
  hipError_t e = hipLaunchCooperativeKernel((const void*)fwd_megakernel, dim3(grid_blocks), dim3(NTHR), args, LDS_BYTES, stream);
  if (e != hipSuccess) fprintf(stderr, "cooperative launch failed: %s (grid %d)\n", hipGetErrorString(e), grid_blocks);
}
```

```cpp
#include <hip/hip_runtime.h>
#include <hip/hip_cooperative_groups.h>
#include <stdint.h>
#include <stdio.h>
namespace cg = cooperative_groups;

typedef unsigned short bf16_t;
using bf16x8 = __attribute__((ext_vector_type(8))) short;
using f32x4 = __attribute__((ext_vector_type(4))) float;

#ifndef PROBE
#define PROBE 0
#endif
#define S_ 8192
#define D_ 2048
#define NTHR 512

struct Params {
  const float* in[37];
  float* out;
  char* ws;
};
typedef const __attribute__((address_space(4))) Params* KP;

constexpr size_t MBy = 1u << 20;
constexpr size_t O_MODP = 0;
constexpr size_t O_MOD = 393216;
constexpr size_t O_CTR = 442368;
constexpr size_t O_CPE = 442624;
constexpr size_t O_W2T = 443392;
constexpr size_t O_HID = 459776;
constexpr size_t O_KCMP = 721920;
constexpr size_t O_VCMPT = 852992;
constexpr size_t O_BON = 984064;
constexpr size_t O_BAR = 2032640;
constexpr size_t O_WT_IN = 2 * MBy;
constexpr size_t O_WT_OUT = O_WT_IN + 20447232;
constexpr size_t O_WT_QB = O_WT_OUT + 8388608;
constexpr size_t O_WT_KVB = O_WT_QB + 1572864;
constexpr size_t O_W1T = O_WT_KVB + 2097152;
constexpr size_t O_WT_R = 34 * MBy;
constexpr size_t O_WT_K = 42 * MBy;
constexpr size_t O_WT_V = 50 * MBy;
constexpr size_t O_WT_Z = 58 * MBy;
constexpr size_t O_WT_O = 66 * MBy;
constexpr size_t O_WT_W1 = 74 * MBy;
constexpr size_t O_WT_A1 = O_WT_W1 + 524288;
constexpr size_t O_WT_W2 = O_WT_A1 + 524288;
constexpr size_t O_WT_A2 = O_WT_W2 + 524288;
constexpr size_t O_H0 = 76 * MBy;
constexpr size_t O_QN = 108 * MBy;
constexpr size_t O_KC = 124 * MBy;
constexpr size_t O_VC = O_KC + 2 * MBy + 65536;
constexpr size_t O_KS = O_VC + 2 * MBy + 65536;
constexpr size_t O_KW = O_KS + 2 * MBy;
constexpr size_t O_VST = O_KW + 2 * MBy;
constexpr size_t O_VWT = O_VST + 2 * MBy;
constexpr size_t O_ZN = 137 * MBy;
constexpr size_t O_ZM = 153 * MBy;
constexpr size_t O_QA = 169 * MBy;
constexpr size_t O_CKV = 177 * MBy;
constexpr size_t O_KPE = 185 * MBy;
constexpr size_t O_GATES = 187 * MBy;
constexpr size_t O_QM = 189 * MBy;
constexpr size_t O_KM = 213 * MBy;
constexpr size_t O_VMT = 237 * MBy;
constexpr size_t O_Y = 253 * MBy;
constexpr size_t O_ROPE = 285 * MBy;
constexpr size_t O_H1 = 76 * MBy;
constexpr size_t O_XK = 204 * MBy;
constexpr size_t O_XV = 236 * MBy;
constexpr size_t O_XZ = 268 * MBy;
constexpr size_t O_XW = 336 * MBy;
constexpr size_t O_XA = 2 * MBy;
constexpr size_t O_R = 108 * MBy;
constexpr size_t O_K = 140 * MBy;
constexpr size_t O_V = 172 * MBy;
constexpr size_t O_AB = 204 * MBy;
constexpr size_t O_LOGW = 236 * MBy;
constexpr size_t O_ZS = 300 * MBy;
constexpr size_t O_LW = 332 * MBy;
constexpr size_t O_LA = 334 * MBy;
constexpr size_t O_YRAW = 336 * MBy;
constexpr size_t O_S0 = 336 * MBy;
constexpr size_t O_CHP = 2 * MBy;
constexpr size_t O_CHQ = 34 * MBy;
constexpr size_t O_CHG = 76 * MBy;
constexpr size_t O_CHY = 92 * MBy;
constexpr size_t O_YR = 108 * MBy;
constexpr size_t WS_NEED = 368 * MBy;

constexpr int LDS_BYTES = 9 * 64 * 65 * 4 + 1024;

__device__ __forceinline__ int get_tid() { int t = threadIdx.x; asm volatile("" : "+v"(t)); return t; }
__device__ __forceinline__ float bf2f(bf16_t b) { return __uint_as_float(((uint32_t)b) << 16); }
typedef float float2_t __attribute__((ext_vector_type(2)));
typedef __bf16 bf16x2v __attribute__((ext_vector_type(2)));
__device__ __forceinline__ uint32_t pack2(float a, float b) {
  float2_t f = {a, b};
  bf16x2v h = __builtin_convertvector(f, bf16x2v);
  return *(uint32_t*)&h;
}
__device__ __forceinline__ bf16_t f2bf(float f) { return (bf16_t)(pack2(f, 0.f) & 0xffffu); }
__device__ __forceinline__ float siluf(float x) { return x / (1.f + __expf(-x)); }
__device__ __forceinline__ float sigmf(float x) { return 1.f / (1.f + __expf(-x)); }
__device__ __forceinline__ void unpack8(uint4 v, float* f) {
  f[0] = __uint_as_float(v.x << 16); f[1] = __uint_as_float(v.x & 0xffff0000u);
  f[2] = __uint_as_float(v.y << 16); f[3] = __uint_as_float(v.y & 0xffff0000u);
  f[4] = __uint_as_float(v.z << 16); f[5] = __uint_as_float(v.z & 0xffff0000u);
  f[6] = __uint_as_float(v.w << 16); f[7] = __uint_as_float(v.w & 0xffff0000u);
}
__device__ __forceinline__ f32x4 mfma_bf16(bf16x8 a, bf16x8 b, f32x4 c) {
  return __builtin_amdgcn_mfma_f32_16x16x32_bf16(a, b, c, 0, 0, 0);
}
__device__ __forceinline__ float wave_sum(float v) {
#pragma unroll
  for (int o = 32; o > 0; o >>= 1) v += __shfl_xor(v, o);
  return v;
}

template <int AMODE, class Epi, class EpiS = int>
__device__ __forceinline__ void gemm_tile(const bf16_t* __restrict__ A, int lda, const bf16_t* __restrict__ Bt, int ldb,
                                          int K, int m0, int n0, char* smem, const float* __restrict__ mu, Epi epi, EpiS epiS = 0) {
  bf16_t* As = (bf16_t*)smem;
  const int tid = get_tid(), lane = tid & 63, wave = tid >> 6;
  const int wm = wave >> 1, wn = wave & 1, r = lane & 15, quad = lane >> 4;
  f32x4 acc[4][4];
#pragma unroll
  for (int i = 0; i < 4; i++)
#pragma unroll
    for (int j = 0; j < 4; j++) acc[i][j] = f32x4{0.f, 0.f, 0.f, 0.f};
  const int lrow = tid >> 3, lkc = (tid & 7) * 8;
  const int lsw = ((tid & 7) ^ (lrow & 7)) * 8;
  const int rsw0 = ((quad) ^ (r & 7)) * 8, rsw1 = ((4 + quad) ^ (r & 7)) * 8;
  uint4 xa0, xa1, xa2, xa3, xp0, xp1, xp2, xp3, xb0, xb1;
  const bf16_t* abase = A + (size_t)(m0 + lrow) * lda + lkc;
  const bf16_t* bbase = Bt + (size_t)(n0 + lrow) * ldb + lkc;
  const bool row0zero = (AMODE == 1) && (m0 + lrow == 0);
#define GL1(dst_, dstp_, i_, k0_)                                                     \
  {                                                                                   \
    const bf16_t* ap_ = abase + (size_t)(64 * (i_)) * lda + (k0_);                    \
    dst_ = *(const uint4*)ap_;                                                        \
    if (AMODE == 1) {                                                                 \
      if ((i_) == 0 && row0zero) dstp_ = uint4{0, 0, 0, 0};                           \
      else dstp_ = *(const uint4*)(ap_ - lda);                                        \
    }                                                                                 \
  }
#define GLOADS(...) GLOADS_(__VA_ARGS__)
#define GLOADS_(a0, a1, a2, a3, p0, p1, p2, p3, b0, b1, k0_)                           \
  {                                                                                   \
    __builtin_amdgcn_sched_barrier(0);                                                \
    GL1(a0, p0, 0, k0_) GL1(a1, p1, 1, k0_) GL1(a2, p2, 2, k0_) GL1(a3, p3, 3, k0_)   \
    b0 = *(const uint4*)(bbase + (k0_));                                              \
    b1 = *(const uint4*)(bbase + (size_t)64 * ldb + (k0_));                           \
    __builtin_amdgcn_sched_barrier(0);                                                \
  }
#define GS1(src_, srcp_, i_, As_, k0_)                                                                    \
  {                                                                                                       \
    uint4 v = src_;                                                                                       \
    if (AMODE == 1) {                                                                                     \
      float h[8], hp[8];                                                                                  \
      unpack8(src_, h);                                                                                   \
      unpack8(srcp_, hp);                                                                                 \
      const float4 m0v = *(const float4*)(mu + (k0_) + lkc);                                              \
      const float4 m1v = *(const float4*)(mu + (k0_) + lkc + 4);                                          \
      float o0 = h[0] + (hp[0] - h[0]) * m0v.x, o1 = h[1] + (hp[1] - h[1]) * m0v.y;                       \
      float o2 = h[2] + (hp[2] - h[2]) * m0v.z, o3 = h[3] + (hp[3] - h[3]) * m0v.w;                       \
      float o4 = h[4] + (hp[4] - h[4]) * m1v.x, o5 = h[5] + (hp[5] - h[5]) * m1v.y;                       \
      float o6 = h[6] + (hp[6] - h[6]) * m1v.z, o7 = h[7] + (hp[7] - h[7]) * m1v.w;                       \
      v.x = pack2(o0, o1); v.y = pack2(o2, o3); v.z = pack2(o4, o5); v.w = pack2(o6, o7);                 \
    }                                                                                                     \
    *(uint4*)(As_ + (lrow + 64 * (i_)) * 64 + lsw) = v;                                                   \
  }
#define GSTORES(...) GSTORES_(__VA_ARGS__)
#define GSTORES_(a0, a1, a2, a3, p0, p1, p2, p3, b0, b1, bi_, k0_)                      \
  {                                                                                   \
    bf16_t* As_ = As + (bi_) * (384 * 64);                                            \
    bf16_t* Bs_ = As_ + 256 * 64;                                                     \
    GS1(a0, p0, 0, As_, k0_) GS1(a1, p1, 1, As_, k0_) GS1(a2, p2, 2, As_, k0_) GS1(a3, p3, 3, As_, k0_) \
    *(uint4*)(Bs_ + lrow * 64 + lsw) = b0;                                            \
    *(uint4*)(Bs_ + (lrow + 64) * 64 + lsw) = b1;                                     \
  }
#define SET0 xa0, xa1, xa2, xa3, xp0, xp1, xp2, xp3, xb0, xb1
#define SET1 ya0, ya1, ya2, ya3, yp0, yp1, yp2, yp3, yb0, yb1
#define GCOMPUTE(bi_)                                                                                          \
  {                                                                                                            \
    const bf16_t* Ac = As + (bi_) * (384 * 64) + (wm * 64 + r) * 64;                                           \
    const bf16_t* Bc = As + (bi_) * (384 * 64) + 256 * 64 + (wn * 64 + r) * 64;                                \
    bf16x8 af0[4], bf0[4], af1[4], bf1[4];                                                                     \
    _Pragma("unroll") for (int mt = 0; mt < 4; mt++) af0[mt] = *(const bf16x8*)(Ac + mt * 1024 + rsw0);        \
    _Pragma("unroll") for (int nt = 0; nt < 4; nt++) bf0[nt] = *(const bf16x8*)(Bc + nt * 1024 + rsw0);        \
    _Pragma("unroll") for (int mt = 0; mt < 4; mt++) af1[mt] = *(const bf16x8*)(Ac + mt * 1024 + rsw1);        \
    _Pragma("unroll") for (int nt = 0; nt < 4; nt++) bf1[nt] = *(const bf16x8*)(Bc + nt * 1024 + rsw1);        \
    _Pragma("unroll") for (int mt = 0; mt < 4; mt++)                                                           \
      _Pragma("unroll") for (int nt = 0; nt < 4; nt++) acc[mt][nt] = mfma_bf16(af0[mt], bf0[nt], acc[mt][nt]); \
    _Pragma("unroll") for (int mt = 0; mt < 4; mt++)                                                           \
      _Pragma("unroll") for (int nt = 0; nt < 4; nt++) acc[mt][nt] = mfma_bf16(af1[mt], bf1[nt], acc[mt][nt]); \
  }
  const int nk = K >> 6;
  const int lastk = (nk - 1) * 64;
  GLOADS(SET0, 0);
  GSTORES(SET0, 0, 0);
  { const int kk1 = min(64, lastk); GLOADS(SET0, kk1); }
  __syncthreads();
  for (int it = 0; it < nk; it += 2) {
    if (it + 1 < nk) {
      const int ka = (it + 1) * 64, kb2 = min((it + 2) * 64, lastk);
      GSTORES(SET0, 1, ka);
      GLOADS(SET0, kb2);
    }
    GCOMPUTE(0);
    __syncthreads();
    if (it + 1 < nk) {
      const int ka = min((it + 2) * 64, lastk), kb2 = min((it + 3) * 64, lastk);
      GSTORES(SET0, 0, ka);
      GLOADS(SET0, kb2);
      GCOMPUTE(1);
      __syncthreads();
    }
  }
  epi(acc, m0 + wm * 64, n0 + wn * 64);
  if constexpr (!__is_same(EpiS, int)) {
    float* Cs = (float*)smem;
#pragma unroll
    for (int mt = 0; mt < 4; mt++)
#pragma unroll
      for (int nt = 0; nt < 4; nt++)
#pragma unroll
        for (int i = 0; i < 4; i++) Cs[(wm * 64 + mt * 16 + quad * 4 + i) * 132 + wn * 64 + nt * 16 + r] = acc[mt][nt][i];
    __syncthreads();
    epiS(Cs, m0, n0, tid);
    __syncthreads();
  }
}
#define STAGE_LOOP8(row, c8, va, vb)                        \
  for (int e_ = tid; e_ < 256 * 16; e_ += NTHR) {           \
    const int row = e_ >> 4, c8 = (e_ & 15) * 8;            \
    const float4 va = *(const float4*)(Cs + row * 132 + c8); \
    const float4 vb = *(const float4*)(Cs + row * 132 + c8 + 4);
#define STAGE_LOOP4(row, c4, va)                            \
  for (int e_ = tid; e_ < 256 * 32; e_ += NTHR) {           \
    const int row = e_ >> 5, c4 = (e_ & 31) * 4;            \
    const float4 va = *(const float4*)(Cs + row * 132 + c4);
#define STAGE_END }
__device__ __forceinline__ uint4 pack8(float4 a, float4 b) {
  uint4 u;
  u.x = pack2(a.x, a.y); u.y = pack2(a.z, a.w); u.z = pack2(b.x, b.y); u.w = pack2(b.z, b.w);
  return u;
}

__device__ __forceinline__ int g8_lds_byte(int r, int c) {
  int st = (r >> 4) * 2 + (c >> 5), rr = r & 15, cc = c & 31, ob = rr * 64 + cc * 2;
  return st * 1024 + (ob ^ (((ob >> 9) & 1) << 5));
}
__device__ __forceinline__ void g8_stage_rc(int b, int& R, int& C) {
  int st = b / 1024, sb = b % 1024, swz = sb ^ (((sb >> 9) & 1) << 5);
  R = (st >> 1) * 16 + swz / 64;
  C = (st & 1) * 32 + (swz % 64) / 2;
}
template <class EpiS>
__device__ __forceinline__ void gemm256_tile(const bf16_t* __restrict__ A, int lda, const bf16_t* __restrict__ Bt, int ldb, int K,
                                             int brow, int bcol, char* smem, EpiS epiS) {
  constexpr int G8_HT = 128 * 64;
  bf16_t* shm = (bf16_t*)smem;
  typedef __attribute__((address_space(1))) const void* gptr_t;
  typedef __attribute__((address_space(3))) void* lptr_t;
  const int tid = get_tid();
  const int wid = tid >> 6, lane = tid & 63, wr = wid >> 2, wc = wid & 3, fr = lane & 15, fq = lane >> 4;
  unsigned oa0, oa1, ob0, ob1;
  {
    int sr0, sc0, sr1, sc1;
    g8_stage_rc(tid * 16, sr0, sc0);
    g8_stage_rc(tid * 16 + 8192, sr1, sc1);
    oa0 = (unsigned)(sr0 * lda + sc0); oa1 = (unsigned)(sr1 * lda + sc1);
    ob0 = (unsigned)(sr0 * ldb + sc0); ob1 = (unsigned)(sr1 * ldb + sc1);
  }
#define G8_SA(b, h) (shm + ((b) * 2 + (h)) * G8_HT)
#define G8_SB(b, h) (shm + (4 + (b) * 2 + (h)) * G8_HT)
#define G8_STAGE(P, BASE, LD, br, kt, O0, O1)                                                                      \
  do {                                                                                                             \
    const bf16_t* g_ = (BASE) + (size_t)(br) * (LD) + (size_t)(kt) * 64;                                           \
    __builtin_amdgcn_global_load_lds((gptr_t)(g_ + O0), (lptr_t)((char*)(P) + tid * 16), 16, 0, 0);               \
    __builtin_amdgcn_global_load_lds((gptr_t)(g_ + O1), (lptr_t)((char*)(P) + tid * 16 + 8192), 16, 0, 0);        \
  } while (0)
#define G8_LDA(dst, b, h)                                                                                          \
  _Pragma("unroll") for (int m = 0; m < 4; ++m) _Pragma("unroll") for (int k = 0; k < 2; ++k)                      \
    dst[m][k] = *reinterpret_cast<const bf16x8*>((char*)G8_SA(b, h) + g8_lds_byte(wr * 64 + m * 16 + fr, k * 32 + fq * 8))
#define G8_LDB(dst, b, h)                                                                                          \
  _Pragma("unroll") for (int n = 0; n < 2; ++n) _Pragma("unroll") for (int k = 0; k < 2; ++k)                      \
    dst[n][k] = *reinterpret_cast<const bf16x8*>((char*)G8_SB(b, h) + g8_lds_byte(wc * 32 + n * 16 + fr, k * 32 + fq * 8))
#define G8_MMA(ai, bj, At_, Bt_)                                                                                   \
  do {                                                                                                             \
    __builtin_amdgcn_s_setprio(1);                                                                                 \
    _Pragma("unroll") for (int m = 0; m < 4; ++m) _Pragma("unroll") for (int n = 0; n < 2; ++n)                    \
      _Pragma("unroll") for (int k = 0; k < 2; ++k)                                                                \
        acc[ai][bj][m][n] = __builtin_amdgcn_mfma_f32_16x16x32_bf16(At_[m][k], Bt_[n][k], acc[ai][bj][m][n], 0, 0, 0); \
    __builtin_amdgcn_s_setprio(0);                                                                                 \
  } while (0)
#define G8_WAIT_V(n) asm volatile("s_waitcnt vmcnt(" #n ")" ::: "memory")
#define G8_WAIT_L(n) asm volatile("s_waitcnt lgkmcnt(" #n ")" ::: "memory")
#define G8_BAR __builtin_amdgcn_s_barrier()
#define G8_SCHED __builtin_amdgcn_sched_barrier(0)
  f32x4 acc[2][2][4][2];
#pragma unroll
  for (int a_ = 0; a_ < 2; a_++)
#pragma unroll
    for (int b_ = 0; b_ < 2; b_++)
#pragma unroll
      for (int m = 0; m < 4; m++)
#pragma unroll
        for (int n = 0; n < 2; n++) acc[a_][b_][m][n] = f32x4{0.f, 0.f, 0.f, 0.f};
  bf16x8 At[4][2], B0[2][2], B1[2][2];
  const int nt = K / 64;
  __syncthreads();
  G8_STAGE(G8_SB(0, 0), Bt, ldb, bcol, 0, ob0, ob1); G8_STAGE(G8_SA(0, 0), A, lda, brow, 0, oa0, oa1);
  G8_STAGE(G8_SB(0, 1), Bt, ldb, bcol + 128, 0, ob0, ob1); G8_STAGE(G8_SA(0, 1), A, lda, brow + 128, 0, oa0, oa1);
  if (wr == 1) G8_BAR;
  G8_WAIT_V(4); G8_BAR;
  G8_STAGE(G8_SB(1, 0), Bt, ldb, bcol, 1, ob0, ob1); G8_STAGE(G8_SA(1, 0), A, lda, brow, 1, oa0, oa1); G8_STAGE(G8_SB(1, 1), Bt, ldb, bcol + 128, 1, ob0, ob1);
  G8_WAIT_V(6); G8_BAR;
  for (int t = 0; t < nt - 2; t += 2) {
    G8_LDB(B0, 0, 0); G8_SCHED; G8_LDA(At, 0, 0); G8_STAGE(G8_SA(1, 1), A, lda, brow + 128, t + 1, oa0, oa1);
    G8_WAIT_L(8); G8_BAR; G8_WAIT_L(0); G8_MMA(0, 0, At, B0); G8_BAR; G8_SCHED;
    G8_LDB(B1, 0, 1); G8_STAGE(G8_SB(0, 0), Bt, ldb, bcol, t + 2, ob0, ob1);
    G8_BAR; G8_WAIT_L(0); G8_MMA(0, 1, At, B1); G8_BAR;
    G8_LDA(At, 0, 1); G8_STAGE(G8_SA(0, 0), A, lda, brow, t + 2, oa0, oa1);
    G8_BAR; G8_WAIT_L(0); G8_MMA(1, 0, At, B0); G8_BAR; G8_SCHED;
    G8_STAGE(G8_SB(0, 1), Bt, ldb, bcol + 128, t + 2, ob0, ob1);
    G8_WAIT_V(6); G8_BAR; G8_MMA(1, 1, At, B1); G8_BAR;
    G8_LDB(B0, 1, 0); G8_SCHED; G8_LDA(At, 1, 0); G8_STAGE(G8_SA(0, 1), A, lda, brow + 128, t + 2, oa0, oa1);
    G8_WAIT_L(8); G8_BAR; G8_WAIT_L(0); G8_MMA(0, 0, At, B0); G8_BAR; G8_SCHED;
    G8_LDB(B1, 1, 1); G8_STAGE(G8_SB(1, 0), Bt, ldb, bcol, t + 3, ob0, ob1);
    G8_BAR; G8_WAIT_L(0); G8_MMA(0, 1, At, B1); G8_BAR;
    G8_LDA(At, 1, 1); G8_STAGE(G8_SA(1, 0), A, lda, brow, t + 3, oa0, oa1);
    G8_BAR; G8_WAIT_L(0); G8_MMA(1, 0, At, B0); G8_BAR; G8_SCHED;
    G8_STAGE(G8_SB(1, 1), Bt, ldb, bcol + 128, t + 3, ob0, ob1);
    G8_WAIT_V(6); G8_BAR; G8_MMA(1, 1, At, B1); G8_BAR;
  }
  { G8_LDB(B0, 0, 0); G8_LDA(At, 0, 0); G8_STAGE(G8_SA(1, 1), A, lda, brow + 128, nt - 1, oa0, oa1);
    G8_BAR; G8_WAIT_L(0); G8_MMA(0, 0, At, B0); G8_BAR;
    G8_LDB(B1, 0, 1); G8_BAR; G8_WAIT_L(0); G8_MMA(0, 1, At, B1); G8_BAR;
    G8_LDA(At, 0, 1); G8_WAIT_V(4); G8_BAR; G8_WAIT_L(0); G8_MMA(1, 0, At, B0); G8_MMA(1, 1, At, B1); G8_BAR; }
  { G8_LDB(B0, 1, 0); G8_LDA(At, 1, 0); G8_WAIT_V(2); G8_BAR; G8_WAIT_L(0); G8_MMA(0, 0, At, B0); G8_BAR;
    G8_LDB(B1, 1, 1); G8_WAIT_V(0); G8_BAR; G8_WAIT_L(0); G8_MMA(0, 1, At, B1); G8_BAR;
    G8_LDA(At, 1, 1); G8_BAR; G8_WAIT_L(0); G8_MMA(1, 0, At, B0); G8_MMA(1, 1, At, B1); G8_BAR; }
  if (wr == 0) G8_BAR;
  float* Cs = (float*)smem;
#pragma unroll
  for (int bj = 0; bj < 2; bj++) {
    __syncthreads();
#pragma unroll
    for (int ai = 0; ai < 2; ai++)
#pragma unroll
      for (int m = 0; m < 4; m++)
#pragma unroll
        for (int n = 0; n < 2; n++)
#pragma unroll
          for (int j = 0; j < 4; j++)
            Cs[(ai * 128 + wr * 64 + m * 16 + fq * 4 + j) * 132 + wc * 32 + n * 16 + fr] = acc[ai][bj][m][n][j];
    __syncthreads();
    epiS(Cs, brow, bcol + bj * 128, tid);
  }
  __syncthreads();
}
__device__ __forceinline__ void g8_map(int wgid, int nM, int nN, int& pm, int& pn) {
  const int nwg = nM * nN;
  { int q = nwg / 8, r = nwg % 8, xcd = wgid % 8, off = wgid / 8;
    wgid = (xcd < r ? xcd * (q + 1) : r * (q + 1) + (xcd - r) * q) + off; }
  const int nig = 8 * nN, gid = wgid / nig, fm = gid * 8, gsz = min(nM - fm, 8);
  pm = fm + ((wgid % nig) % gsz);
  pn = (wgid % nig) / gsz;
}

__device__ __forceinline__ float rope_inv(int i) { return exp2f(-(float)i * (13.287712379549449f / 32.f)); }
__device__ __forceinline__ void conv_finish(float4 v0, float4 v1, float s0, float s1, bf16_t* __restrict__ dst, int lddst, int ndst0, int k0,
                                            float* sm) {
  const int tid = get_tid();
  const int kr = tid >> 4, nc = (tid & 15) * 4;
  sm[kr * 65 + nc + 0] = v0.x * s0; sm[kr * 65 + nc + 1] = v0.y * s0; sm[kr * 65 + nc + 2] = v0.z * s0; sm[kr * 65 + nc + 3] = v0.w * s0;
  sm[(kr + 32) * 65 + nc + 0] = v1.x * s1; sm[(kr + 32) * 65 + nc + 1] = v1.y * s1; sm[(kr + 32) * 65 + nc + 2] = v1.z * s1; sm[(kr + 32) * 65 + nc + 3] = v1.w * s1;
  __syncthreads();
  {
    int n = tid >> 3, kc = (tid & 7) * 8;
    float o[8];
#pragma unroll
    for (int j = 0; j < 8; j++) o[j] = sm[(kc + j) * 65 + n];
    uint4 v;
    v.x = pack2(o[0], o[1]); v.y = pack2(o[2], o[3]); v.z = pack2(o[4], o[5]); v.w = pack2(o[6], o[7]);
    *(uint4*)(dst + (size_t)(ndst0 + n) * lddst + k0 + kc) = v;
  }
  __syncthreads();
}

__device__ __forceinline__ void phase0(KP p, float* sm) {
  const int tid = get_tid();
  char* ws = p->ws;
  if (blockIdx.x == 0 && tid < 16) ((unsigned int*)(ws + O_CTR))[tid] = 0u;
  const int NCONV = 9410;
  bool have_prev = false;
  float4 pv0 = float4{0.f, 0.f, 0.f, 0.f}, pv1 = pv0;
  float ps0 = 1.f, ps1 = 1.f;
  bf16_t* pdst = nullptr;
  int plddst = 0, pndst0 = 0, pk0 = 0;
  const int total = 130 + NCONV;
  for (int item = blockIdx.x; item < total; item += gridDim.x) {
    if (item < 96) {
      int l = item / 48, rem = item % 48, cb = rem / 8, ks = rem % 8;
      int c4 = (tid & 255) * 4, rh = tid >> 8;
      const float* W = p->in[3] + (size_t)l * 2048 * 6144 + cb * 1024 + c4;
      const float* c = p->in[1];
      float4 a = float4{0.f, 0.f, 0.f, 0.f};
      int rbase = ks * 256 + rh * 128;
#pragma unroll 4
      for (int i = 0; i < 128; i++) {
        int row = rbase + i;
        float sc = siluf(c[row]);
        float4 w = *(const float4*)(W + (size_t)row * 6144);
        a.x += sc * w.x; a.y += sc * w.y; a.z += sc * w.z; a.w += sc * w.w;
      }
      if (rh == 1) { sm[c4] = a.x; sm[c4 + 1] = a.y; sm[c4 + 2] = a.z; sm[c4 + 3] = a.w; }
      __syncthreads();
      if (rh == 0) {
        a.x += sm[c4]; a.y += sm[c4 + 1]; a.z += sm[c4 + 2]; a.w += sm[c4 + 3];
        float* dst = (float*)(ws + O_MODP) + (size_t)(ks * 2 + l) * 6144 + cb * 1024 + c4;
        *(float4*)dst = a;
      }
      __syncthreads();
    } else if (item < 98) {
      int ty = item - 96;
      const float* pe = p->in[ty ? 12 : 8];
      const float* w1 = p->in[ty ? 13 : 9];
      const float* b1 = p->in[ty ? 14 : 10];
      int e = tid & 63, part = tid >> 6;
      float a = 0.f;
      for (int i = 0; i < 256; i++) { int k = part * 256 + i; a += pe[k] * w1[(size_t)k * 64 + e]; }
      sm[part * 64 + e] = a;
      __syncthreads();
      if (tid < 64) {
        float s = b1[tid];
        for (int q = 0; q < 8; q++) s += sm[q * 64 + tid];
        ((float*)(ws + O_CPE))[ty * 64 + tid] = s;
      }
      __syncthreads();
    } else if (item < 130) {
      float* rope = (float*)(ws + O_ROPE);
      const int base = (item - 98) * 8192;
      for (int e = tid; e < 8192; e += NTHR) {
        const int idx = base + e, t = idx >> 5, ii = idx & 31;
        float sn, cs;
        sincosf((float)t * rope_inv(ii), &sn, &cs);
        *(float2*)(rope + (size_t)idx * 2) = float2{cs, sn};
      }
    } else {
      int ci = item - 130;
      const float* src; int ldsrc, Kvalid, ktiles; bf16_t* dst; int lddst; const float* scale = nullptr;
      int kt, nt, nsrc0, nvalid = 64, ndst0;
      if (ci < 2496) {
        src = p->in[6]; ldsrc = 4976; Kvalid = 2048; ktiles = 32; dst = (bf16_t*)(ws + O_WT_IN); lddst = 2048;
        kt = ci % 32; nt = ci / 32;
        int my = nt * 64;
        ndst0 = my;
        if (my < 1792) nsrc0 = my;
        else if (my < 3840) nsrc0 = my + 48;
        else if (my < 4864) nsrc0 = my + 112;
        else if (my < 4928) nsrc0 = my - 976;
        else { nsrc0 = 1792; nvalid = 48; }
      } else {
        ci -= 2496;
        int mid;
        if (ci < 1024) { mid = 1; }
        else if (ci < 1024 + 192) { mid = 2; ci -= 1024; }
        else if (ci < 1024 + 192 + 256) { mid = 3; ci -= 1216; }
        else if (ci < 1472 + 5120) { ci -= 1472; mid = 4 + ci / 1024; ci %= 1024; }
        else if (ci < 6592 + 128) { ci -= 6592; mid = 9 + ci / 64; ci %= 64; }
        else if (ci < 6720 + 128) { ci -= 6720; mid = 11 + ci / 64; ci %= 64; }
        else if (ci < 6848 + 64) { ci -= 6848; mid = 13 + ci / 32; ci %= 32; }
        else { ci -= 6912; mid = 15 + ci; ci = 0; }
        switch (mid) {
          case 1: src = p->in[7]; ldsrc = 2048; Kvalid = 2048; ktiles = 32; dst = (bf16_t*)(ws + O_WT_OUT); lddst = 2048; break;
          case 2: src = p->in[17]; ldsrc = 1536; Kvalid = 512; ktiles = 8; dst = (bf16_t*)(ws + O_WT_QB); lddst = 512; scale = p->in[16]; break;
          case 3: src = p->in[19]; ldsrc = 2048; Kvalid = 512; ktiles = 8; dst = (bf16_t*)(ws + O_WT_KVB); lddst = 512; scale = p->in[18]; break;
          case 4: src = p->in[21]; ldsrc = 2048; Kvalid = 2048; ktiles = 32; dst = (bf16_t*)(ws + O_WT_R); lddst = 2048; break;
          case 5: src = p->in[22]; ldsrc = 2048; Kvalid = 2048; ktiles = 32; dst = (bf16_t*)(ws + O_WT_K); lddst = 2048; break;
          case 6: src = p->in[23]; ldsrc = 2048; Kvalid = 2048; ktiles = 32; dst = (bf16_t*)(ws + O_WT_V); lddst = 2048; break;
          case 7: src = p->in[24]; ldsrc = 2048; Kvalid = 2048; ktiles = 32; dst = (bf16_t*)(ws + O_WT_Z); lddst = 2048; break;
          case 8: src = p->in[25]; ldsrc = 2048; Kvalid = 2048; ktiles = 32; dst = (bf16_t*)(ws + O_WT_O); lddst = 2048; break;
          case 9: src = p->in[27]; ldsrc = 96; Kvalid = 2048; ktiles = 32; dst = (bf16_t*)(ws + O_WT_W1); lddst = 2048; break;
          case 10: src = p->in[30]; ldsrc = 96; Kvalid = 2048; ktiles = 32; dst = (bf16_t*)(ws + O_WT_A1); lddst = 2048; break;
          case 11: src = p->in[28]; ldsrc = 2048; Kvalid = 96; ktiles = 2; dst = (bf16_t*)(ws + O_WT_W2); lddst = 128; break;
          case 12: src = p->in[31]; ldsrc = 2048; Kvalid = 96; ktiles = 2; dst = (bf16_t*)(ws + O_WT_A2); lddst = 128; break;
          case 13: src = p->in[9]; ldsrc = 64; Kvalid = 2048; ktiles = 32; dst = (bf16_t*)(ws + O_W1T); lddst = 2048; break;
          case 14: src = p->in[13]; ldsrc = 64; Kvalid = 2048; ktiles = 32; dst = (bf16_t*)(ws + O_W1T) + 64 * 2048; lddst = 2048; break;
          case 15: src = p->in[11]; ldsrc = 64; Kvalid = 64; ktiles = 1; dst = (bf16_t*)(ws + O_W2T); lddst = 64; break;
          default: src = p->in[15]; ldsrc = 64; Kvalid = 64; ktiles = 1; dst = (bf16_t*)(ws + O_W2T) + 64 * 64; lddst = 64; break;
        }
        kt = ci % ktiles; nt = ci / ktiles;
        nsrc0 = nt * 64; ndst0 = nt * 64;
        if (mid == 9 || mid == 10) { if (nt == 1) nvalid = 32; }
      }
      const int k0 = kt * 64;
      const int kr = tid >> 4, nc = (tid & 15) * 4;
      float4 v0 = float4{0.f, 0.f, 0.f, 0.f}, v1 = v0;
      float s0 = 1.f, s1 = 1.f;
      if (k0 + kr < Kvalid && nc < nvalid) {
        v0 = *(const float4*)(src + (size_t)(k0 + kr) * ldsrc + nsrc0 + nc);
        if (scale) s0 = scale[k0 + kr];
      }
      if (k0 + kr + 32 < Kvalid && nc < nvalid) {
        v1 = *(const float4*)(src + (size_t)(k0 + kr + 32) * ldsrc + nsrc0 + nc);
        if (scale) s1 = scale[k0 + kr + 32];
      }
      if (have_prev) conv_finish(pv0, pv1, ps0, ps1, pdst, plddst, pndst0, pk0, sm);
      pv0 = v0; pv1 = v1; ps0 = s0; ps1 = s1; pdst = dst; plddst = lddst; pndst0 = ndst0; pk0 = k0;
      have_prev = true;
    }
  }
  if (have_prev) conv_finish(pv0, pv1, ps0, ps1, pdst, plddst, pndst0, pk0, sm);
}

__device__ __forceinline__ void norm_phase(KP p, int layer, const float* __restrict__ xsrc, bf16_t* __restrict__ hdst, float* sm) {
  const int tid = get_tid(), lane = tid & 63, wave = tid >> 6;
  const float* modp = (const float*)(p->ws + O_MODP);
  const float* ada_b = p->in[4];
  const float* g = p->in[2] + layer * 2048;
  for (int col = tid; col < 2048; col += NTHR) {
    float sh = ada_b[layer * 6144 + col], sc = ada_b[layer * 6144 + 2048 + col];
    for (int ks = 0; ks < 8; ks++) {
      sh += modp[(size_t)(ks * 2 + layer) * 6144 + col];
      sc += modp[(size_t)(ks * 2 + layer) * 6144 + 2048 + col];
    }
    sm[col] = g[col] * (1.f + sc);
    sm[2048 + col] = sh;
  }
  if (layer == 0 && blockIdx.x == 0) {
    float* mod = (float*)(p->ws + O_MOD);
    for (int i = tid; i < 12288; i += NTHR) {
      int l = i / 6144, col = i % 6144;
      float v = ada_b[i];
      for (int ks = 0; ks < 8; ks++) v += modp[(size_t)(ks * 2 + l) * 6144 + col];
      mod[i] = v;
    }
  }
  __syncthreads();
  for (int row = blockIdx.x * 8 + wave; row < S_; row += gridDim.x * 8) {
    const float* xr = xsrc + (size_t)row * 2048;
    float4 v[8];
    float ss = 0.f;
#pragma unroll
    for (int j = 0; j < 8; j++) {
      v[j] = *(const float4*)(xr + lane * 4 + 256 * j);
      ss += v[j].x * v[j].x + v[j].y * v[j].y + v[j].z * v[j].z + v[j].w * v[j].w;
    }
    ss = wave_sum(ss);
    float rstd = rsqrtf(ss * (1.f / 2048.f) + 1e-6f);
#pragma unroll
    for (int j = 0; j < 8; j++) {
      int col = lane * 4 + 256 * j;
      float o0 = v[j].x * rstd * sm[col] + sm[2048 + col];
      float o1 = v[j].y * rstd * sm[col + 1] + sm[2048 + col + 1];
      float o2 = v[j].z * rstd * sm[col + 2] + sm[2048 + col + 2];
      float o3 = v[j].w * rstd * sm[col + 3] + sm[2048 + col + 3];
      uint2 o;
      o.x = pack2(o0, o1); o.y = pack2(o2, o3);
      *(uint2*)(hdst + (size_t)row * 2048 + col) = o;
    }
  }
}

__device__ __forceinline__ void norm_shift_phase(KP p, float* sm) {
  const int tid = get_tid(), lane = tid & 63, wave = tid >> 6;
  const int layer = 1;
  char* ws = p->ws;
  const float* modp = (const float*)(ws + O_MODP);
  const float* ada_b = p->in[4];
  const float* g = p->in[2] + layer * 2048;
  const float* mu = p->in[20];
  const float* xsrc = p->out;
  for (int col = tid; col < 2048; col += NTHR) {
    float sh = ada_b[layer * 6144 + col], sc = ada_b[layer * 6144 + 2048 + col];
    for (int ks = 0; ks < 8; ks++) {
      sh += modp[(size_t)(ks * 2 + layer) * 6144 + col];
      sc += modp[(size_t)(ks * 2 + layer) * 6144 + 2048 + col];
    }
    sm[col] = g[col] * (1.f + sc);
    sm[2048 + col] = sh;
  }
  __syncthreads();
  bf16_t* dst0 = (bf16_t*)(ws + O_H1);
  bf16_t* dst1 = (bf16_t*)(ws + O_XW);
  bf16_t* dst2 = (bf16_t*)(ws + O_XK);
  bf16_t* dst3 = (bf16_t*)(ws + O_XV);
  bf16_t* dst4 = (bf16_t*)(ws + O_XA);
  bf16_t* dst5 = (bf16_t*)(ws + O_XZ);
  for (int row = blockIdx.x * 8 + wave; row < S_; row += gridDim.x * 8) {
    const float* xr = xsrc + (size_t)row * 2048;
    float4 v[8], vp[8];
    float ss = 0.f, sp = 0.f;
#pragma unroll
    for (int j = 0; j < 8; j++) {
      v[j] = *(const float4*)(xr + lane * 4 + 256 * j);
      ss += v[j].x * v[j].x + v[j].y * v[j].y + v[j].z * v[j].z + v[j].w * v[j].w;
      if (row > 0) vp[j] = *(const float4*)(xr - 2048 + lane * 4 + 256 * j);
      else vp[j] = float4{0.f, 0.f, 0.f, 0.f};
      sp += vp[j].x * vp[j].x + vp[j].y * vp[j].y + vp[j].z * vp[j].z + vp[j].w * vp[j].w;
    }
    ss = wave_sum(ss);
    sp = wave_sum(sp);
    const float rstd = rsqrtf(ss * (1.f / 2048.f) + 1e-6f);
    const float rstdp = rsqrtf(sp * (1.f / 2048.f) + 1e-6f);
#pragma unroll
    for (int j = 0; j < 8; j++) {
      const int col = lane * 4 + 256 * j;
      float h[4], hp[4];
      h[0] = v[j].x * rstd * sm[col] + sm[2048 + col];
      h[1] = v[j].y * rstd * sm[col + 1] + sm[2048 + col + 1];
      h[2] = v[j].z * rstd * sm[col + 2] + sm[2048 + col + 2];
      h[3] = v[j].w * rstd * sm[col + 3] + sm[2048 + col + 3];
      if (row > 0) {
        hp[0] = vp[j].x * rstdp * sm[col] + sm[2048 + col];
        hp[1] = vp[j].y * rstdp * sm[col + 1] + sm[2048 + col + 1];
        hp[2] = vp[j].z * rstdp * sm[col + 2] + sm[2048 + col + 2];
        hp[3] = vp[j].w * rstdp * sm[col + 3] + sm[2048 + col + 3];
      } else { hp[0] = hp[1] = hp[2] = hp[3] = 0.f; }
      const unsigned ob = ((unsigned)row * 2048u + (unsigned)col) * 2u;
#define MIXOUT(dst_, mi_)                                                              \
      {                                                                                \
        const float4 m4 = *(const float4*)(mu + (mi_) * 2048 + col);                   \
        uint2 u;                                                                       \
        u.x = pack2(h[0] + (hp[0] - h[0]) * m4.x, h[1] + (hp[1] - h[1]) * m4.y);       \
        u.y = pack2(h[2] + (hp[2] - h[2]) * m4.z, h[3] + (hp[3] - h[3]) * m4.w);       \
        *(uint2*)((char*)dst_ + ob) = u;                                               \
      }
      MIXOUT(dst0, 0) MIXOUT(dst1, 1) MIXOUT(dst2, 2) MIXOUT(dst3, 3) MIXOUT(dst4, 4) MIXOUT(dst5, 5)
    }
  }
}

__device__ __forceinline__ float4 silu4(float4 v) { return float4{siluf(v.x), siluf(v.y), siluf(v.z), siluf(v.w)}; }
__device__ __forceinline__ float4 sigm4(float4 v) { return float4{sigmf(v.x), sigmf(v.y), sigmf(v.z), sigmf(v.w)}; }
__device__ __forceinline__ void phase2(KP p, char* smem) {
  char* ws = p->ws;
  const bf16_t* A = (const bf16_t*)(ws + O_H0);
  const bf16_t* Bt = (const bf16_t*)(ws + O_WT_IN);
  const int lane = get_tid() & 63, r = lane & 15, quad = lane >> 4;
  bf16_t* qn = (bf16_t*)(ws + O_QN);
  bf16_t* zn = (bf16_t*)(ws + O_ZN);
  bf16_t* zm = (bf16_t*)(ws + O_ZM);
  bf16_t* qa = (bf16_t*)(ws + O_QA);
  bf16_t* ckv = (bf16_t*)(ws + O_CKV);
  float* kpe = (float*)(ws + O_KPE);
  float* gates = (float*)(ws + O_GATES);
  auto epiD = [&](f32x4(&acc)[4][4], int row0, int col0) {
    if (col0 < 1024 || col0 >= 1792) return;
    const int idx = (col0 - 1024) >> 7;
    if (idx != 3 && idx != 5) return;
#pragma unroll
    for (int nt = 0; nt < 4; nt++) {
      const int cc = col0 + nt * 16 + r - 1024, g = (cc >> 6) & 1, d = cc & 63;
#pragma unroll
      for (int mt = 0; mt < 4; mt++) {
        const int rw = row0 + mt * 16 + quad * 4;
        const f32x4 v = acc[mt][nt];
        bf16_t* dst = (bf16_t*)(ws + (idx == 3 ? O_VST : O_VWT)) + (((size_t)g * 256 + (rw >> 5)) * 64 + d) * 32 + (rw & 31);
        uint2 o; o.x = pack2(v[0], v[1]); o.y = pack2(v[2], v[3]);
        *(uint2*)dst = o;
      }
    }
  };
  auto epiS = [&](const float* Cs, int m0, int n0, int tid) {
    STAGE_LOOP8(row, c8, va, vb)
      const int c = n0 + c8;
      const size_t t = (size_t)(m0 + row);
      if (c < 1024) {
        *(uint4*)(qn + t * 1024 + c) = pack8(va, vb);
      } else if (c < 1792) {
        const int cc = c - 1024, idx = cc >> 7, g = (cc >> 6) & 1, d = cc & 63;
        if (idx != 3 && idx != 5) {
          const size_t off = idx == 0 ? O_KC : idx == 1 ? O_VC : idx == 2 ? O_KS : O_KW;
          *(uint4*)((bf16_t*)(ws + off) + ((size_t)g * S_ + t) * 64 + d) = pack8(va, vb);
        }
      } else if (c < 2816) {
        *(uint4*)(zn + t * 1024 + (c - 1792)) = pack8(silu4(va), silu4(vb));
      } else if (c < 3328) {
        *(uint4*)(qa + t * 512 + (c - 2816)) = pack8(va, vb);
      } else if (c < 3840) {
        *(uint4*)(ckv + t * 512 + (c - 3328)) = pack8(va, vb);
      } else if (c < 4864) {
        *(uint4*)(zm + t * 1024 + (c - 3840)) = pack8(silu4(va), silu4(vb));
      } else if (c < 4928) {
        *(float4*)(kpe + t * 64 + (c - 4864)) = va;
        *(float4*)(kpe + t * 64 + (c - 4864) + 4) = vb;
      } else if (c < 4976) {
        *(float4*)(gates + t * 48 + (c - 4928)) = sigm4(va);
        *(float4*)(gates + t * 48 + (c - 4928) + 4) = sigm4(vb);
      }
    STAGE_END
  };
  auto epiS2 = [&](const float* Cs, int m0, int n0, int tid) {
    if (n0 == 1408 || n0 == 1664) {
      bf16_t* vb_ = (bf16_t*)(ws + (n0 == 1408 ? O_VST : O_VWT));
      for (int e_ = tid; e_ < 128 * 32; e_ += NTHR) {
        const int col = e_ & 127, rg = e_ >> 7;
        float f[8];
#pragma unroll
        for (int j = 0; j < 8; j++) f[j] = Cs[(rg * 8 + j) * 132 + col];
        const int t = m0 + rg * 8, g = col >> 6, d = col & 63;
        uint4 u;
        u.x = pack2(f[0], f[1]); u.y = pack2(f[2], f[3]); u.z = pack2(f[4], f[5]); u.w = pack2(f[6], f[7]);
        *(uint4*)(vb_ + (((size_t)g * 256 + (t >> 5)) * 64 + d) * 32 + (t & 31)) = u;
      }
    } else {
      epiS(Cs, m0, n0, tid);
    }
  };
  auto epiNone = [&](f32x4(&acc)[4][4], int row0, int col0) {};
  (void)epiD;
  const int nbig = 32 * 16, nsmall = 32 * 7;
  for (int t = blockIdx.x; t < nbig + nsmall; t += gridDim.x) {
    if (t < nbig) {
      int pm, pn;
      g8_map(t, 32, 16, pm, pn);
      gemm256_tile(A, 2048, Bt, 2048, 2048, pm * 256, pn * 256, smem, epiS2);
    } else {
      const int u = t - nbig;
      const int mt = u & 31, nt = 32 + (u >> 5);
      gemm_tile<0>(A, 2048, Bt, 2048, 2048, mt * 256, nt * 128, smem, nullptr, epiNone, epiS);
    }
  }
}


__device__ __forceinline__ void phase3(KP p, char* smem) {
  char* ws = p->ws;
  float* rstd_s = (float*)(smem + 136 * 1024);
  const float* rope = (const float*)(ws + O_ROPE);
  auto epiNone = [&](f32x4(&acc)[4][4], int row0, int col0) {};
  const int total = 8 + 192 + 256 + 32;
  for (int item = blockIdx.x; item < total; item += gridDim.x) {
    if (item < 8) {
      int prob = item >> 1, mtile = item & 1;
      int ty = prob >> 1, g = prob & 1;
      const bf16_t* A = (const bf16_t*)(ws + (ty ? O_VC : O_KC)) + (size_t)g * S_ * 64;
      const bf16_t* Bt = (const bf16_t*)(ws + O_W1T);
      bf16_t* hid = (bf16_t*)(ws + O_HID) + (size_t)prob * 512 * 64;
      const float* cpe = (const float*)(ws + O_CPE) + ty * 64;
      auto epi1 = [&](f32x4(&acc)[4][4], int row0, int col0) {
        if ((col0 >> 6) != ty) return;
        const int lane = get_tid() & 63, r = lane & 15, quad = lane >> 4;
#pragma unroll
        for (int nt = 0; nt < 4; nt++) {
          int e = nt * 16 + r;
          float b = cpe[e];
#pragma unroll
          for (int mt = 0; mt < 4; mt++) {
            int rw = row0 + mt * 16 + quad * 4;
#pragma unroll
            for (int i = 0; i < 4; i++) hid[(size_t)(rw + i) * 64 + e] = f2bf(siluf(acc[mt][nt][i] + b));
          }
        }
      };
      gemm_tile<0>(A, 1024, Bt, 2048, 2048, mtile * 256, 0, smem, nullptr, epi1);
      __threadfence();
      __syncthreads();
      bf16_t* kcmp = (bf16_t*)(ws + O_KCMP) + (size_t)g * 512 * 64;
      bf16_t* vcmpT = (bf16_t*)(ws + O_VCMPT) + (size_t)g * 64 * 512;
      auto epi2 = [&](f32x4(&acc)[4][4], int row0, int col0) {
        if ((col0 >> 6) != ty) return;
        const int lane = get_tid() & 63, r = lane & 15, quad = lane >> 4;
#pragma unroll
        for (int nt = 0; nt < 4; nt++) {
          int d = nt * 16 + r;
#pragma unroll
          for (int mt = 0; mt < 4; mt++) {
            int rw = row0 + mt * 16 + quad * 4;
            f32x4 v = acc[mt][nt];
#pragma unroll
            for (int i = 0; i < 4; i++) if (rw + i >= 511) v[i] = 0.f;
            if (ty == 0) {
#pragma unroll
              for (int i = 0; i < 4; i++) kcmp[(size_t)(rw + i) * 64 + d] = f2bf(v[i]);
            } else {
              uint2 o; o.x = pack2(v[0], v[1]); o.y = pack2(v[2], v[3]);
              *(uint2*)(vcmpT + ((size_t)(rw >> 5) * 64 + d) * 32 + (rw & 31)) = o;
            }
          }
        }
      };
      gemm_tile<0>(hid, 64, (const bf16_t*)(ws + O_W2T), 64, 64, mtile * 256, 0, smem, nullptr, epi2);
    } else if (item < 8 + 192 + 256) {
      int it = item - 8;
      bool isq = it < 192;
      if (!isq) it -= 192;
      int mt_, nt_;
      g8_map(it, 32, isq ? 6 : 8, mt_, nt_);
      const bf16_t* A = (const bf16_t*)(ws + (isq ? O_QA : O_CKV));
      __syncthreads();
      {
        const int tid = get_tid();
        int row = tid >> 1, hf = tid & 1;
        const bf16_t* ap = A + (size_t)(mt_ * 256 + row) * 512 + hf * 256;
        float ss = 0.f;
#pragma unroll 4
        for (int j = 0; j < 32; j++) {
          float f[8];
          unpack8(*(const uint4*)(ap + j * 8), f);
#pragma unroll
          for (int q = 0; q < 8; q++) ss += f[q] * f[q];
        }
        ss += __shfl_xor(ss, 1);
        if (hf == 0) rstd_s[row] = rsqrtf(ss * (1.f / 512.f) + 1e-6f);
      }
      __syncthreads();
      if (isq) {
        bf16_t* qm = (bf16_t*)(ws + O_QM);
        auto epiS = [&](const float* Cs, int m0, int n0, int tid) {
          STAGE_LOOP8(row, c8, va, vb)
            const int c = n0 + c8, hd = c / 192, dd = c - hd * 192;
            const int t = m0 + row;
            const float rs = rstd_s[row];
            bf16_t* dst = qm + ((size_t)hd * S_ + t) * 192;
            if (dd < 128) {
              float4 a = va, b = vb;
              a.x *= rs; a.y *= rs; a.z *= rs; a.w *= rs; b.x *= rs; b.y *= rs; b.z *= rs; b.w *= rs;
              *(uint4*)(dst + dd) = pack8(a, b);
            } else if (dd < 160) {
              const int i0 = dd - 128;
              const float4 xa = *(const float4*)(Cs + row * 132 + c8 + 32), xb = *(const float4*)(Cs + row * 132 + c8 + 36);
              const float x1[8] = {va.x * rs, va.y * rs, va.z * rs, va.w * rs, vb.x * rs, vb.y * rs, vb.z * rs, vb.w * rs};
              const float x2[8] = {xa.x * rs, xa.y * rs, xa.z * rs, xa.w * rs, xb.x * rs, xb.y * rs, xb.z * rs, xb.w * rs};
              const float* rp = rope + ((size_t)t * 32 + i0) * 2;
              float o1[8], o2[8];
#pragma unroll
              for (int j = 0; j < 4; j++) {
                const float4 cs = *(const float4*)(rp + 4 * j);
                o1[2 * j] = x1[2 * j] * cs.x - x2[2 * j] * cs.y;
                o2[2 * j] = x1[2 * j] * cs.y + x2[2 * j] * cs.x;
                o1[2 * j + 1] = x1[2 * j + 1] * cs.z - x2[2 * j + 1] * cs.w;
                o2[2 * j + 1] = x1[2 * j + 1] * cs.w + x2[2 * j + 1] * cs.z;
              }
              uint4 u1, u2;
              u1.x = pack2(o1[0], o1[1]); u1.y = pack2(o1[2], o1[3]); u1.z = pack2(o1[4], o1[5]); u1.w = pack2(o1[6], o1[7]);
              u2.x = pack2(o2[0], o2[1]); u2.y = pack2(o2[2], o2[3]); u2.z = pack2(o2[4], o2[5]); u2.w = pack2(o2[6], o2[7]);
              *(uint4*)(dst + 128 + i0) = u1;
              *(uint4*)(dst + 160 + i0) = u2;
            }
          STAGE_END
        };
        gemm256_tile(A, 512, (const bf16_t*)(ws + O_WT_QB), 512, 512, mt_ * 256, nt_ * 256, smem, epiS);
      } else {
        bf16_t* km = (bf16_t*)(ws + O_KM);
        bf16_t* vmT = (bf16_t*)(ws + O_VMT);
        auto epiD = [&](f32x4(&acc)[4][4], int row0, int col0) {
          const int lane = get_tid() & 63, r = lane & 15, quad = lane >> 4;
          int hd = col0 >> 8, dd0 = col0 & 255;
          if (dd0 < 128) return;
          int lrow0 = row0 - mt_ * 256;
#pragma unroll
          for (int nt = 0; nt < 4; nt++)
#pragma unroll
            for (int mt = 0; mt < 4; mt++) {
              int rl = lrow0 + mt * 16 + quad * 4;
              int t = mt_ * 256 + rl;
              f32x4 v = acc[mt][nt];
#pragma unroll
              for (int i = 0; i < 4; i++) v[i] *= rstd_s[rl + i];
              int d = dd0 - 128 + nt * 16 + r;
              uint2 o; o.x = pack2(v[0], v[1]); o.y = pack2(v[2], v[3]);
              *(uint2*)(vmT + ((size_t)hd * 128 + d) * S_ + t) = o;
            }
        };
        auto epiS = [&](const float* Cs, int m0, int n0, int tid) {
          STAGE_LOOP8(row, c8, va, vb)
            const int c = n0 + c8, hd = c >> 8, dd = c & 255;
            if (dd < 128) {
              const float rs = rstd_s[row];
              float4 a = va, b = vb;
              a.x *= rs; a.y *= rs; a.z *= rs; a.w *= rs; b.x *= rs; b.y *= rs; b.z *= rs; b.w *= rs;
              *(uint4*)(km + ((size_t)hd * S_ + m0 + row) * 192 + dd) = pack8(a, b);
            }
          STAGE_END
        };
        (void)epiD;
        auto epiS2 = [&](const float* Cs, int m0, int n0, int tid) {
          if ((n0 & 255) == 128) {
            const int hd = n0 >> 8;
            for (int e_ = tid; e_ < 128 * 32; e_ += NTHR) {
              const int col = e_ & 127, rg = e_ >> 7;
              float f[8];
#pragma unroll
              for (int j = 0; j < 8; j++) f[j] = Cs[(rg * 8 + j) * 132 + col] * rstd_s[rg * 8 + j];
              uint4 u;
              u.x = pack2(f[0], f[1]); u.y = pack2(f[2], f[3]); u.z = pack2(f[4], f[5]); u.w = pack2(f[6], f[7]);
              *(uint4*)(vmT + ((size_t)hd * 128 + col) * S_ + m0 + rg * 8) = u;
            }
          } else {
            epiS(Cs, m0, n0, tid);
          }
        };
        gemm256_tile(A, 512, (const bf16_t*)(ws + O_WT_KVB), 512, 512, mt_ * 256, nt_ * 256, smem, epiS2);
      }
    } else {
      int it = item - (8 + 192 + 256);
      const float* kpe = (const float*)(ws + O_KPE);
      bf16_t* km = (bf16_t*)(ws + O_KM);
      const int tid = get_tid();
      for (int e = tid; e < 256 * 32; e += NTHR) {
        int t = it * 256 + (e >> 5), ii = e & 31;
        float x1 = kpe[(size_t)t * 64 + ii], x2 = kpe[(size_t)t * 64 + 32 + ii];
        const float2 cs = *(const float2*)(rope + ((size_t)t * 32 + ii) * 2);
        bf16_t o1 = f2bf(x1 * cs.x - x2 * cs.y), o2 = f2bf(x1 * cs.y + x2 * cs.x);
#pragma unroll
        for (int hd = 0; hd < 8; hd++) {
          bf16_t* dst = km + ((size_t)hd * S_ + t) * 192 + 128;
          dst[ii] = o1; dst[32 + ii] = o2;
        }
      }
    }
  }
}

template <int DQK, int NCT>
__device__ __forceinline__ void qk_step(const bf16_t* __restrict__ Kb, int ldk, int kb, const bf16x8 (&qf)[DQK / 32][NCT],
                                        f32x4 (&s)[2][NCT], int r, int quad) {
#pragma unroll
  for (int sub = 0; sub < 2; sub++) {
    const bf16_t* kp = Kb + (size_t)(kb + sub * 16 + r) * ldk + quad * 8;
#pragma unroll
    for (int ct = 0; ct < NCT; ct++) s[sub][ct] = f32x4{0.f, 0.f, 0.f, 0.f};
#pragma unroll
    for (int ks = 0; ks < DQK / 32; ks++) {
      bf16x8 kf = *(const bf16x8*)(kp + ks * 32);
#pragma unroll
      for (int ct = 0; ct < NCT; ct++) s[sub][ct] = mfma_bf16(kf, qf[ks][ct], s[sub][ct]);
    }
  }
}

template <int DV, int NCT>
__device__ __forceinline__ void pv_step(const bf16_t* __restrict__ VT, size_t ldv, int kb, const bf16x8 (&pf)[NCT],
                                        f32x4 (&o)[DV / 16][NCT], int r, int quad) {
#pragma unroll
  for (int dt = 0; dt < DV / 16; dt++) {
    const bf16_t* vp = VT + (size_t)(dt * 16 + r) * ldv + kb + quad * 4;
    uint2 lo = *(const uint2*)vp;
    uint2 hi = *(const uint2*)(vp + 16);
    uint4 u = uint4{lo.x, lo.y, hi.x, hi.y};
    bf16x8 vf = *(bf16x8*)&u;
#pragma unroll
    for (int ct = 0; ct < NCT; ct++) o[dt][ct] = mfma_bf16(vf, pf[ct], o[dt][ct]);
  }
}

template <int DV>
__device__ __forceinline__ bf16x8 softmax_step(float (&sc)[8], unsigned vmask, float& m, float& l, f32x4 (&o)[DV / 16][1]) {
  return bf16x8{};
}

__device__ __forceinline__ float quad_max(float v) {
  v = fmaxf(v, __shfl_xor(v, 16));
  v = fmaxf(v, __shfl_xor(v, 32));
  return v;
}
__device__ __forceinline__ float quad_sum(float v) {
  v += __shfl_xor(v, 16);
  v += __shfl_xor(v, 32);
  return v;
}

#define SOFTMAX_UPDATE(DVT, NCTV, ct, sc, vm, mvar, lvar, oarr, pfout)                                   \
  {                                                                                                      \
    float mx_ = -1e30f;                                                                                  \
    _Pragma("unroll") for (int j_ = 0; j_ < 8; j_++) if ((vm >> j_) & 1) mx_ = fmaxf(mx_, sc[j_]);       \
    mx_ = quad_max(mx_);                                                                                 \
    const float mn_ = fmaxf(mvar, mx_);                                                                  \
    if (__ballot(mn_ > mvar) != 0ull) {                                                                  \
      const float al_ = __builtin_amdgcn_exp2f(mvar - mn_);                                              \
      lvar *= al_;                                                                                       \
      _Pragma("unroll") for (int dt_ = 0; dt_ < DVT / 16; dt_++) {                                       \
        oarr[dt_][ct][0] *= al_; oarr[dt_][ct][1] *= al_; oarr[dt_][ct][2] *= al_; oarr[dt_][ct][3] *= al_; \
      }                                                                                                  \
      mvar = mn_;                                                                                        \
    }                                                                                                    \
    float pp_[8];                                                                                        \
    float ls_ = 0.f;                                                                                     \
    _Pragma("unroll") for (int j_ = 0; j_ < 8; j_++) {                                                   \
      pp_[j_] = ((vm >> j_) & 1) ? __builtin_amdgcn_exp2f(sc[j_] - mn_) : 0.f;                           \
      ls_ += pp_[j_];                                                                                    \
    }                                                                                                    \
    lvar += ls_;                                                                                         \
    uint4 u_;                                                                                            \
    u_.x = pack2(pp_[0], pp_[1]); u_.y = pack2(pp_[2], pp_[3]);                                          \
    u_.z = pack2(pp_[4], pp_[5]); u_.w = pack2(pp_[6], pp_[7]);                                          \
    pfout = *(bf16x8*)&u_;                                                                               \
  }

#define SOFTMAX_UPDATE16(DVT, ct, sc, vm, mvar, lvar, oarr, pfa, pfb)                                    \
  {                                                                                                      \
    float mx_ = -1e30f;                                                                                  \
    _Pragma("unroll") for (int j_ = 0; j_ < 16; j_++) if ((vm >> j_) & 1) mx_ = fmaxf(mx_, sc[j_]);      \
    mx_ = quad_max(mx_);                                                                                 \
    const float mn_ = fmaxf(mvar, mx_);                                                                  \
    if (__ballot(mn_ > mvar) != 0ull) {                                                                  \
      const float al_ = __builtin_amdgcn_exp2f(mvar - mn_);                                              \
      lvar *= al_;                                                                                       \
      _Pragma("unroll") for (int dt_ = 0; dt_ < DVT / 16; dt_++) {                                       \
        oarr[dt_][ct][0] *= al_; oarr[dt_][ct][1] *= al_; oarr[dt_][ct][2] *= al_; oarr[dt_][ct][3] *= al_; \
      }                                                                                                  \
      mvar = mn_;                                                                                        \
    }                                                                                                    \
    float pp_[16];                                                                                       \
    float ls_ = 0.f;                                                                                     \
    _Pragma("unroll") for (int j_ = 0; j_ < 16; j_++) {                                                  \
      pp_[j_] = ((vm >> j_) & 1) ? __builtin_amdgcn_exp2f(sc[j_] - mn_) : 0.f;                           \
      ls_ += pp_[j_];                                                                                    \
    }                                                                                                    \
    lvar += ls_;                                                                                         \
    uint4 ua_, ub_;                                                                                      \
    ua_.x = pack2(pp_[0], pp_[1]); ua_.y = pack2(pp_[2], pp_[3]);                                        \
    ua_.z = pack2(pp_[4], pp_[5]); ua_.w = pack2(pp_[6], pp_[7]);                                        \
    ub_.x = pack2(pp_[8], pp_[9]); ub_.y = pack2(pp_[10], pp_[11]);                                      \
    ub_.z = pack2(pp_[12], pp_[13]); ub_.w = pack2(pp_[14], pp_[15]);                                    \
    pfa = *(bf16x8*)&ua_;                                                                                \
    pfb = *(bf16x8*)&ub_;                                                                                \
  }

struct KF { bf16x8 k[2][2]; };
struct VF { bf16x8 v[4]; };
__device__ __forceinline__ void load_kf(KF& f, const bf16_t* __restrict__ Kb, int kb, int r, int quad) {
#pragma unroll
  for (int sub = 0; sub < 2; sub++)
#pragma unroll
    for (int ks = 0; ks < 2; ks++) f.k[sub][ks] = *(const bf16x8*)(Kb + (size_t)(kb + sub * 16 + r) * 64 + ks * 32 + quad * 8);
}
__device__ __forceinline__ void load_vf(VF& f, const bf16_t* __restrict__ VT, size_t ldv, int kb, int r, int quad) {
  (void)ldv;
  const bf16_t* vb = VT + (size_t)(kb >> 5) * 2048 + r * 32 + quad * 4;
#pragma unroll
  for (int dt = 0; dt < 4; dt++) {
    const bf16_t* vp = vb + dt * 512;
    uint2 lo = *(const uint2*)vp;
    uint2 hi = *(const uint2*)(vp + 16);
    uint4 u = uint4{lo.x, lo.y, hi.x, hi.y};
    f.v[dt] = *(bf16x8*)&u;
  }
}
__device__ __forceinline__ void qk_from(const KF& f, const bf16x8 (&qf)[2][2], f32x4 (&s)[2][2]) {
#pragma unroll
  for (int sub = 0; sub < 2; sub++)
#pragma unroll
    for (int ct = 0; ct < 2; ct++) {
      s[sub][ct] = f32x4{0.f, 0.f, 0.f, 0.f};
#pragma unroll
      for (int ks = 0; ks < 2; ks++) s[sub][ct] = mfma_bf16(f.k[sub][ks], qf[ks][ct], s[sub][ct]);
    }
}
__device__ __forceinline__ void pv_from(const VF& f, const bf16x8 (&pf)[2], f32x4 (&o)[4][2]) {
#pragma unroll
  for (int dt = 0; dt < 4; dt++)
#pragma unroll
    for (int ct = 0; ct < 2; ct++) o[dt][ct] = mfma_bf16(f.v[dt], pf[ct], o[dt][ct]);
}

__device__ __forceinline__ void nsa_item(KP p, int g, int tile, float* wsm) {
  char* ws = p->ws;
  const int lane = get_tid() & 63, r = lane & 15, quad = lane >> 4;
  float* impc = wsm;
  float* vals = wsm + 2048;
  const bf16_t* qn = (const bf16_t*)(ws + O_QN);
  const bf16_t* kcmp = (const bf16_t*)(ws + O_KCMP) + (size_t)g * 512 * 64;
  const bf16_t* vcmpT = (const bf16_t*)(ws + O_VCMPT) + (size_t)g * 64 * 512;
  const bf16_t* ksb = (const bf16_t*)(ws + O_KS) + (size_t)g * S_ * 64;
  const bf16_t* kwb = (const bf16_t*)(ws + O_KW) + (size_t)g * S_ * 64;
  const bf16_t* vsT = (const bf16_t*)(ws + O_VST) + (size_t)g * 64 * S_;
  const bf16_t* vwT = (const bf16_t*)(ws + O_VWT) + (size_t)g * 64 * S_;
  const float* gates = (const float*)(ws + O_GATES);
  const int t0 = tile * 4;
  const int head = g * 8 + (r & 7);
  const float slope = exp2f(-0.5f * (float)(head + 1)) * 1.4426950408889634f;
  const float qs2 = 0.125f * 1.4426950408889634f;
  int tok[2];
  bf16x8 qf[2][2];
#pragma unroll
  for (int ct = 0; ct < 2; ct++) {
    tok[ct] = t0 + ct * 2 + (r >> 3);
#pragma unroll
    for (int ks = 0; ks < 2; ks++) qf[ks][ct] = *(const bf16x8*)(qn + (size_t)tok[ct] * 1024 + head * 64 + ks * 32 + quad * 8);
  }
  f32x4 oacc[4][2];
#pragma unroll
  for (int dt = 0; dt < 4; dt++)
#pragma unroll
    for (int ct = 0; ct < 2; ct++) oacc[dt][ct] = f32x4{0.f, 0.f, 0.f, 0.f};
  f32x4 o[4][2];
  float m[2], l[2];
  for (int i = lane; i < 2048; i += 64) impc[i] = 0.f;
  const int tlast = t0 + 3;
  if (tlast >= 31) {
    const int nmax = (tlast - 31) >> 4;
    const int nsteps = (nmax >> 5) + 1;
    const int lastkb = (nsteps - 1) * 32;
    m[0] = m[1] = -1e30f; l[0] = l[1] = 0.f;
    {
      KF kc_, kn_;
      load_kf(kc_, kcmp, 0, r, quad);
      for (int st = 0; st < nsteps; st++) {
        const int kb = st * 32;
        load_kf(kn_, kcmp, min(kb + 32, lastkb), r, quad);
        f32x4 s[2][2];
        qk_from(kc_, qf, s);
#pragma unroll
        for (int ct = 0; ct < 2; ct++) {
          float mx = -1e30f;
          float sc[8];
          unsigned vm = 0;
#pragma unroll
          for (int j = 0; j < 8; j++) {
            int n = kb + (j >> 2) * 16 + quad * 4 + (j & 3);
            int ce = n * 16 + 31;
            sc[j] = s[j >> 2][ct][j & 3] * qs2 - slope * (float)(tok[ct] - ce);
            if (ce <= tok[ct]) { vm |= 1u << j; mx = fmaxf(mx, sc[j]); }
          }
          mx = quad_max(mx);
          float mn = fmaxf(m[ct], mx);
          float al = __builtin_amdgcn_exp2f(m[ct] - mn);
          float ls = 0.f;
#pragma unroll
          for (int j = 0; j < 8; j++) if ((vm >> j) & 1) ls += __builtin_amdgcn_exp2f(sc[j] - mn);
          l[ct] = l[ct] * al + ls;
          m[ct] = mn;
        }
        kc_ = kn_;
      }
    }
    float il[2];
#pragma unroll
    for (int ct = 0; ct < 2; ct++) { float lt = quad_sum(l[ct]); il[ct] = lt > 0.f ? 1.f / lt : 0.f; }
#pragma unroll
    for (int dt = 0; dt < 4; dt++)
#pragma unroll
      for (int ct = 0; ct < 2; ct++) o[dt][ct] = f32x4{0.f, 0.f, 0.f, 0.f};
    {
      KF kc_, kn_;
      VF vc_, vn_;
      load_kf(kc_, kcmp, 0, r, quad);
      load_vf(vc_, vcmpT, 512, 0, r, quad);
      for (int st = 0; st < nsteps; st++) {
        const int kb = st * 32;
        const int nkb = min(kb + 32, lastkb);
        load_kf(kn_, kcmp, nkb, r, quad);
        load_vf(vn_, vcmpT, 512, nkb, r, quad);
        f32x4 s[2][2];
        qk_from(kc_, qf, s);
        bf16x8 pf[2];
#pragma unroll
        for (int ct = 0; ct < 2; ct++) {
          float pp[8];
#pragma unroll
          for (int j = 0; j < 8; j++) {
            int n = kb + (j >> 2) * 16 + quad * 4 + (j & 3);
            int ce = n * 16 + 31;
            float sc = s[j >> 2][ct][j & 3] * qs2 - slope * (float)(tok[ct] - ce);
            pp[j] = (ce <= tok[ct]) ? __builtin_amdgcn_exp2f(sc - m[ct]) * il[ct] : 0.f;
            float hs = pp[j];
            hs += __shfl_xor(hs, 1);
            hs += __shfl_xor(hs, 2);
            hs += __shfl_xor(hs, 4);
            if ((r & 7) == 0) impc[(ct * 2 + (r >> 3)) * 512 + n] = hs;
          }
          uint4 u;
          u.x = pack2(pp[0], pp[1]); u.y = pack2(pp[2], pp[3]); u.z = pack2(pp[4], pp[5]); u.w = pack2(pp[6], pp[7]);
          pf[ct] = *(bf16x8*)&u;
        }
        pv_from(vc_, pf, o);
        kc_ = kn_;
        vc_ = vn_;
      }
    }
#pragma unroll
    for (int ct = 0; ct < 2; ct++) {
      float gt = gates[(size_t)tok[ct] * 48 + head * 3 + 0];
#pragma unroll
      for (int dt = 0; dt < 4; dt++)
#pragma unroll
        for (int i = 0; i < 4; i++) oacc[dt][ct][i] += gt * o[dt][ct][i];
    }
  }
  __builtin_amdgcn_s_waitcnt(0);
  __builtin_amdgcn_wave_barrier();
  unsigned long long mlo[4], mhi[4];
  const int cur = t0 >> 6;
#pragma unroll
  for (int tk = 0; tk < 4; tk++) {
    float va, vb;
    {
      int j = lane;
      float s5 = 0.f;
#pragma unroll
      for (int q = -1; q <= 3; q++) { int n = 4 * j + q; if (n >= 0) s5 += impc[tk * 512 + n]; }
      va = (j > cur) ? -1e30f : ((j == 0 || j == cur || j == cur - 1) ? 1e9f : s5);
      j = lane + 64;
      s5 = 0.f;
#pragma unroll
      for (int q = -1; q <= 3; q++) { int n = 4 * j + q; if (n < 512) s5 += impc[tk * 512 + n]; }
      vb = (j > cur) ? -1e30f : ((j == cur || j == cur - 1) ? 1e9f : s5);
    }
    __builtin_amdgcn_wave_barrier();
    vals[lane] = va;
    vals[lane + 64] = vb;
    __builtin_amdgcn_s_waitcnt(0);
    __builtin_amdgcn_wave_barrier();
    int ra_ = 0, rb_ = 0;
    for (int jj = 0; jj <= cur; jj += 4) {
      const float4 x4 = *(const float4*)(vals + jj);
      const float xs_[4] = {x4.x, x4.y, x4.z, x4.w};
#pragma unroll
      for (int e = 0; e < 4; e++) {
        const float x = xs_[e];
        ra_ += (x > va || (x == va && jj + e < lane)) ? 1 : 0;
        rb_ += (x > vb || (x == vb && jj + e < lane + 64)) ? 1 : 0;
      }
    }
    mlo[tk] = __ballot(ra_ < 16);
    mhi[tk] = __ballot(rb_ < 16);
    __builtin_amdgcn_wave_barrier();
  }
  unsigned long long mylo[2], myhi[2];
#pragma unroll
  for (int ct = 0; ct < 2; ct++) {
    int ti = ct * 2 + (r >> 3);
    mylo[ct] = (ti == 0) ? mlo[0] : (ti == 1) ? mlo[1] : (ti == 2) ? mlo[2] : mlo[3];
    myhi[ct] = (ti == 0) ? mhi[0] : (ti == 1) ? mhi[1] : (ti == 2) ? mhi[2] : mhi[3];
  }
  const unsigned long long ulo = mlo[0] | mlo[1] | mlo[2] | mlo[3];
  const unsigned long long uhi = mhi[0] | mhi[1] | mhi[2] | mhi[3];
  {
    m[0] = m[1] = -1e30f; l[0] = l[1] = 0.f;
#pragma unroll
    for (int dt = 0; dt < 4; dt++)
#pragma unroll
      for (int ct = 0; ct < 2; ct++) o[dt][ct] = f32x4{0.f, 0.f, 0.f, 0.f};
    const unsigned long long vlo = (cur >= 63) ? ~0ull : ((1ull << (cur + 1)) - 1ull);
    const unsigned long long vhi = (cur < 64) ? 0ull : ((cur - 64 >= 63) ? ~0ull : ((1ull << (cur - 63)) - 1ull));
    unsigned long long wlo = ulo & vlo, whi = uhi & vhi;
    while ((wlo | whi) != 0ull) {
      int j;
      if (wlo != 0ull) { j = __builtin_ctzll(wlo); wlo &= wlo - 1ull; }
      else { j = 64 + __builtin_ctzll(whi); whi &= whi - 1ull; }
      const int kb = j * 64;
      KF k0_, k1_;
      VF v0_, v1_;
      load_kf(k0_, ksb, kb, r, quad);
      load_kf(k1_, ksb, kb + 32, r, quad);
      load_vf(v0_, vsT, S_, kb, r, quad);
      load_vf(v1_, vsT, S_, kb + 32, r, quad);
      f32x4 s0[2][2], s1[2][2];
      qk_from(k0_, qf, s0);
      qk_from(k1_, qf, s1);
      bf16x8 pfa[2], pfb[2];
#pragma unroll
      for (int ct = 0; ct < 2; ct++) {
        const unsigned bit = (unsigned)(((j < 64) ? (mylo[ct] >> j) : (myhi[ct] >> (j - 64))) & 1ull);
        float sc[16];
        unsigned vm = 0;
#pragma unroll
        for (int q = 0; q < 8; q++) {
          const int pos = kb + (q >> 2) * 16 + quad * 4 + (q & 3);
          sc[q] = s0[q >> 2][ct][q & 3] * qs2 - slope * (float)(tok[ct] - pos);
          sc[8 + q] = s1[q >> 2][ct][q & 3] * qs2 - slope * (float)(tok[ct] - pos - 32);
          if (bit && pos <= tok[ct]) vm |= 1u << q;
          if (bit && pos + 32 <= tok[ct]) vm |= 1u << (8 + q);
        }
        SOFTMAX_UPDATE16(64, ct, sc, vm, m[ct], l[ct], o, pfa[ct], pfb[ct]);
      }
      pv_from(v0_, pfa, o);
      pv_from(v1_, pfb, o);
    }
#pragma unroll
    for (int ct = 0; ct < 2; ct++) {
      float lt = quad_sum(l[ct]);
      float gt = gates[(size_t)tok[ct] * 48 + head * 3 + 1] * (lt > 0.f ? 1.f / lt : 0.f);
#pragma unroll
      for (int dt = 0; dt < 4; dt++)
#pragma unroll
        for (int i = 0; i < 4; i++) oacc[dt][ct][i] += gt * o[dt][ct][i];
    }
  }
  {
    m[0] = m[1] = -1e30f; l[0] = l[1] = 0.f;
#pragma unroll
    for (int dt = 0; dt < 4; dt++)
#pragma unroll
      for (int ct = 0; ct < 2; ct++) o[dt][ct] = f32x4{0.f, 0.f, 0.f, 0.f};
    int start = t0 - 511;
    if (start < 0) start = 0;
    start &= ~31;
    const int lastkb = tlast & ~31;
    KF kc_, kn_;
    VF vc_, vn_;
    load_kf(kc_, kwb, start, r, quad);
    load_vf(vc_, vwT, S_, start, r, quad);
    for (int kb = start; kb <= lastkb; kb += 32) {
      const int nkb = min(kb + 32, lastkb);
      load_kf(kn_, kwb, nkb, r, quad);
      load_vf(vn_, vwT, S_, nkb, r, quad);
      f32x4 s[2][2];
      qk_from(kc_, qf, s);
      bf16x8 pf[2];
#pragma unroll
      for (int ct = 0; ct < 2; ct++) {
        float sc[8];
        unsigned vm = 0;
#pragma unroll
        for (int q = 0; q < 8; q++) {
          int pos = kb + (q >> 2) * 16 + quad * 4 + (q & 3);
          int d = tok[ct] - pos;
          sc[q] = s[q >> 2][ct][q & 3] * qs2 - slope * (float)d;
          if (d >= 0 && d < 512) vm |= 1u << q;
        }
        SOFTMAX_UPDATE(64, 2, ct, sc, vm, m[ct], l[ct], o, pf[ct]);
      }
      pv_from(vc_, pf, o);
      kc_ = kn_;
      vc_ = vn_;
    }
#pragma unroll
    for (int ct = 0; ct < 2; ct++) {
      float lt = quad_sum(l[ct]);
      float gt = gates[(size_t)tok[ct] * 48 + head * 3 + 2] * (lt > 0.f ? 1.f / lt : 0.f);
#pragma unroll
      for (int dt = 0; dt < 4; dt++)
#pragma unroll
        for (int i = 0; i < 4; i++) oacc[dt][ct][i] += gt * o[dt][ct][i];
    }
  }
  const bf16_t* zn = (const bf16_t*)(ws + O_ZN);
  bf16_t* Y = (bf16_t*)(ws + O_Y);
#pragma unroll
  for (int ct = 0; ct < 2; ct++)
#pragma unroll
    for (int dt = 0; dt < 4; dt++) {
      int d = dt * 16 + quad * 4;
      uint2 zz = *(const uint2*)(zn + (size_t)tok[ct] * 1024 + head * 64 + d);
      float z0 = __uint_as_float(zz.x << 16), z1 = __uint_as_float(zz.x & 0xffff0000u);
      float z2 = __uint_as_float(zz.y << 16), z3 = __uint_as_float(zz.y & 0xffff0000u);
      uint2 ov;
      ov.x = pack2(oacc[dt][ct][0] * z0, oacc[dt][ct][1] * z1);
      ov.y = pack2(oacc[dt][ct][2] * z2, oacc[dt][ct][3] * z3);
      *(uint2*)(Y + (size_t)tok[ct] * 2048 + head * 64 + d) = ov;
    }
  __builtin_amdgcn_wave_barrier();
}

__device__ __forceinline__ void mla_block_item(KP p, int hd, int tile, char* smem) {
  char* ws = p->ws;
  const int tid = get_tid(), lane = tid & 63, wave = tid >> 6, r = lane & 15, quad = lane >> 4;
  const bf16_t* qm = (const bf16_t*)(ws + O_QM) + (size_t)hd * S_ * 192;
  const bf16_t* km = (const bf16_t*)(ws + O_KM) + (size_t)hd * S_ * 192;
  const bf16_t* vmT = (const bf16_t*)(ws + O_VMT) + (size_t)hd * 128 * S_;
  bf16_t* Kbuf = (bf16_t*)smem;
  bf16_t* Vbuf = (bf16_t*)(smem + 51200);
  const int t0 = tile * 256 + wave * 32;
  bf16x8 qf[6][2];
  int tok[2];
#pragma unroll
  for (int ct = 0; ct < 2; ct++) {
    tok[ct] = t0 + ct * 16 + r;
#pragma unroll
    for (int ks = 0; ks < 6; ks++) qf[ks][ct] = *(const bf16x8*)(qm + (size_t)tok[ct] * 192 + ks * 32 + quad * 8);
  }
  f32x4 o[8][2];
#pragma unroll
  for (int dt = 0; dt < 8; dt++)
#pragma unroll
    for (int ct = 0; ct < 2; ct++) o[dt][ct] = f32x4{0.f, 0.f, 0.f, 0.f};
  float m[2] = {-1e30f, -1e30f}, l[2] = {0.f, 0.f};
  const float scale = 0.07216878364870322f * 1.4426950408889634f;
  const int nsteps = 4 * (tile + 1);
  const int kr0 = tid / 24, kc0 = (tid % 24) * 8;
  const int kr1 = (tid + 512) / 24, kc1 = ((tid + 512) % 24) * 8;
  const int kr2 = (tid + 1024) / 24, kc2 = ((tid + 1024) % 24) * 8;
  const int vr0 = tid >> 3, vc0 = (tid & 7) * 8;
  const int vr1 = (tid + 512) >> 3;
  uint4 k0r, k1r, k2r, v0r, v1r;
#define MLA_GLOAD(kb_)                                                   \
  {                                                                      \
    k0r = *(const uint4*)(km + (size_t)((kb_) + kr0) * 192 + kc0);       \
    k1r = *(const uint4*)(km + (size_t)((kb_) + kr1) * 192 + kc1);       \
    k2r = *(const uint4*)(km + (size_t)((kb_) + kr2) * 192 + kc2);       \
    v0r = *(const uint4*)(vmT + (size_t)vr0 * S_ + (kb_) + vc0);         \
    v1r = *(const uint4*)(vmT + (size_t)vr1 * S_ + (kb_) + vc0);         \
  }
#define MLA_LSTORE(bi_)                                                  \
  {                                                                      \
    bf16_t* Kb_ = Kbuf + (bi_) * 64 * 200;                               \
    bf16_t* Vb_ = Vbuf + (bi_) * 128 * 72;                               \
    *(uint4*)(Kb_ + kr0 * 200 + kc0) = k0r;                              \
    *(uint4*)(Kb_ + kr1 * 200 + kc1) = k1r;                              \
    *(uint4*)(Kb_ + kr2 * 200 + kc2) = k2r;                              \
    *(uint4*)(Vb_ + vr0 * 72 + vc0) = v0r;                               \
    *(uint4*)(Vb_ + vr1 * 72 + vc0) = v1r;                               \
  }
  __syncthreads();
  MLA_GLOAD(0);
  MLA_LSTORE(0);
  __syncthreads();
  for (int st = 0; st < nsteps; st++) {
    const int kb = st * 64;
    if (st + 1 < nsteps) MLA_GLOAD(kb + 64);
    if (kb <= t0 + 31) {
      const bf16_t* Kb_ = Kbuf + (st & 1) * 64 * 200;
      const bf16_t* Vb_ = Vbuf + (st & 1) * 128 * 72;
#pragma unroll
      for (int hf = 0; hf < 2; hf++) {
        if (kb + hf * 32 <= t0 + 31) {
          f32x4 s[2][2];
          qk_step<192, 2>(Kb_, 200, hf * 32, qf, s, r, quad);
          bf16x8 pf[2];
          if (kb + hf * 32 + 31 <= t0) {
#pragma unroll
            for (int ct = 0; ct < 2; ct++) {
              float sc[8];
              const unsigned vm = 0xffu;
#pragma unroll
              for (int j = 0; j < 8; j++) sc[j] = s[j >> 2][ct][j & 3] * scale;
              SOFTMAX_UPDATE(128, 2, ct, sc, vm, m[ct], l[ct], o, pf[ct]);
            }
          } else {
#pragma unroll
            for (int ct = 0; ct < 2; ct++) {
              float sc[8];
              unsigned vm = 0;
#pragma unroll
              for (int j = 0; j < 8; j++) {
                int key = kb + hf * 32 + (j >> 2) * 16 + quad * 4 + (j & 3);
                sc[j] = s[j >> 2][ct][j & 3] * scale;
                if (key <= tok[ct]) vm |= 1u << j;
              }
              SOFTMAX_UPDATE(128, 2, ct, sc, vm, m[ct], l[ct], o, pf[ct]);
            }
          }
          pv_step<128, 2>(Vb_, 72, hf * 32, pf, o, r, quad);
        }
      }
    }
    if (st + 1 < nsteps) MLA_LSTORE((st + 1) & 1);
    __syncthreads();
  }
  const bf16_t* zm = (const bf16_t*)(ws + O_ZM);
  bf16_t* Y = (bf16_t*)(ws + O_Y);
#pragma unroll
  for (int ct = 0; ct < 2; ct++) {
    float lt = quad_sum(l[ct]);
    float il = lt > 0.f ? 1.f / lt : 0.f;
#pragma unroll
    for (int dt = 0; dt < 8; dt++) {
      int d = dt * 16 + quad * 4;
      const bf16_t* zp = zm + (size_t)tok[ct] * 1024 + hd * 128 + d;
      uint2 zz = *(const uint2*)zp;
      float z0 = __uint_as_float(zz.x << 16), z1 = __uint_as_float(zz.x & 0xffff0000u);
      float z2 = __uint_as_float(zz.y << 16), z3 = __uint_as_float(zz.y & 0xffff0000u);
      uint2 ov;
      ov.x = pack2(o[dt][ct][0] * il * z0, o[dt][ct][1] * il * z1);
      ov.y = pack2(o[dt][ct][2] * il * z2, o[dt][ct][3] * il * z3);
      *(uint2*)(Y + (size_t)tok[ct] * 2048 + 1024 + hd * 128 + d) = ov;
    }
  }
}

__device__ __forceinline__ void phase4(KP p, char* smem, int cidx) {
  const int lane = get_tid() & 63, wave = get_tid() >> 6;
  unsigned int* ctr = (unsigned int*)(p->ws + O_CTR) + cidx;
  for (int item = blockIdx.x; item < 256; item += gridDim.x) {
    int tile = 31 - (item >> 3), hd = item & 7;
    mla_block_item(p, hd, tile, smem);
  }
  __syncthreads();
  float* wsm = (float*)(smem + (size_t)wave * 8704);
  const int NNSA = 4096;
  for (;;) {
    int item = 0;
    if (lane == 0) item = (int)atomicAdd(ctr, 1u);
    item = __builtin_amdgcn_readfirstlane(item);
    if (item >= NNSA) break;
    int tile = 2047 - (item >> 1), g = item & 1;
    nsa_item(p, g, tile, wsm);
  }
}

__device__ __forceinline__ void outproj_phase(KP p, const bf16_t* A, const bf16_t* Bt, const float* xres, int layer, char* smem) {
  const float* gate = (const float*)(p->ws + O_MOD) + layer * 6144 + 4096;
  float* out = p->out;
  auto epiD = [&](f32x4(&acc)[4][4], int row0, int col0) {};
  auto epiS = [&](const float* Cs, int m0, int n0, int tid) {
    STAGE_LOOP4(row, c4, v)
      const size_t idx = (size_t)(m0 + row) * 2048 + n0 + c4;
      const float4 x = *(const float4*)(xres + idx);
      const float4 g = *(const float4*)(gate + n0 + c4);
      float4 o;
      o.x = x.x + g.x * v.x; o.y = x.y + g.y * v.y; o.z = x.z + g.z * v.z; o.w = x.w + g.w * v.w;
      *(float4*)(out + idx) = o;
    STAGE_END
  };
  for (int t = blockIdx.x; t < 32 * 8; t += gridDim.x) {
    int pm, pn;
    g8_map(t, 32, 8, pm, pn);
    gemm256_tile(A, 2048, Bt, 2048, 2048, pm * 256, pn * 256, smem, epiS);
  }
}


__device__ __forceinline__ void phase7(KP p, char* smem) {
  char* ws = p->ws;
  auto epiD = [&](f32x4(&acc)[4][4], int row0, int col0) {};
  const int total = 1024 + 64;
  for (int item = blockIdx.x; item < total; item += gridDim.x) {
    if (item >= 1024) {
      const int li = item - 1024;
      int which = li >> 5, mt_ = li & 31;
      bf16_t* dst = (bf16_t*)(ws + (which ? O_LA : O_LW));
      auto epiS = [&](const float* Cs, int m0, int n0, int tid) {
        STAGE_LOOP8(row, c8, va, vb)
          float4 a = va, b = vb;
          if (which == 0) {
            a.x = tanhf(a.x); a.y = tanhf(a.y); a.z = tanhf(a.z); a.w = tanhf(a.w);
            b.x = tanhf(b.x); b.y = tanhf(b.y); b.z = tanhf(b.z); b.w = tanhf(b.w);
          }
          *(uint4*)(dst + (size_t)(m0 + row) * 128 + c8) = pack8(a, b);
        STAGE_END
      };
      gemm_tile<0>((const bf16_t*)(ws + (which ? O_XA : O_XW)), 2048, (const bf16_t*)(ws + (which ? O_WT_A1 : O_WT_W1)), 2048, 2048, mt_ * 256, 0, smem,
                   nullptr, epiD, epiS);
    } else {
      const int prob = item >> 8, tt = item & 255;
      int pm, pn;
      g8_map(tt, 32, 8, pm, pn);
      const size_t woff = prob == 0 ? O_WT_R : prob == 1 ? O_WT_K : prob == 2 ? O_WT_V : O_WT_Z;
      bf16_t* dst = (bf16_t*)(ws + (prob == 0 ? O_R : prob == 1 ? O_K : prob == 2 ? O_V : O_ZS));
      auto epiS = [&](const float* Cs, int m0, int n0, int tid) {
        STAGE_LOOP8(row, c8, va, vb)
          float4 a = va, b = vb;
          if (prob == 3) {
            a.x = siluf(a.x); a.y = siluf(a.y); a.z = siluf(a.z); a.w = siluf(a.w);
            b.x = siluf(b.x); b.y = siluf(b.y); b.z = siluf(b.z); b.w = siluf(b.w);
          }
          *(uint4*)(dst + (size_t)(m0 + row) * 2048 + n0 + c8) = pack8(a, b);
        STAGE_END
      };
      const size_t aoff = prob == 0 ? O_H1 : prob == 1 ? O_XK : prob == 2 ? O_XV : O_XZ;
      gemm256_tile((const bf16_t*)(ws + aoff), 2048, (const bf16_t*)(ws + woff), 2048, 2048, pm * 256, pn * 256, smem, epiS);
    }
  }
}

__device__ __forceinline__ float logdecay_of(float v) {
  return -0.6065306597126334f / (1.f + __expf(-v));
}
__device__ __forceinline__ void phase8(KP p, char* smem) {
  char* ws = p->ws;
  auto epiD = [&](f32x4(&acc)[4][4], int row0, int col0) {};
  for (int item = blockIdx.x; item < 2 * 512; item += gridDim.x) {
    int which = item >> 9, tt = item & 511;
    int mt_ = tt & 31, nt_ = tt >> 5;
    const float* bias = p->in[which ? 29 : 26];
    float* logw = (float*)(ws + O_LOGW);
    bf16_t* ab = (bf16_t*)(ws + O_AB);
    auto epiS = [&](const float* Cs, int m0, int n0, int tid) {
      if (which == 0) {
        STAGE_LOOP4(row, c4, v)
          const float4 b = *(const float4*)(bias + n0 + c4);
          float4 o;
          o.x = logdecay_of(v.x + b.x); o.y = logdecay_of(v.y + b.y); o.z = logdecay_of(v.z + b.z); o.w = logdecay_of(v.w + b.w);
          *(float4*)(logw + (size_t)(m0 + row) * 2048 + n0 + c4) = o;
        STAGE_END
      } else {
        STAGE_LOOP8(row, c8, va, vb)
          const float4 b0 = *(const float4*)(bias + n0 + c8), b1 = *(const float4*)(bias + n0 + c8 + 4);
          float4 a, b;
          a.x = sigmf(va.x + b0.x); a.y = sigmf(va.y + b0.y); a.z = sigmf(va.z + b0.z); a.w = sigmf(va.w + b0.w);
          b.x = sigmf(vb.x + b1.x); b.y = sigmf(vb.y + b1.y); b.z = sigmf(vb.z + b1.z); b.w = sigmf(vb.w + b1.w);
          *(uint4*)(ab + (size_t)(m0 + row) * 2048 + n0 + c8) = pack8(a, b);
        STAGE_END
      }
    };
    gemm_tile<0>((const bf16_t*)(ws + (which ? O_LA : O_LW)), 128, (const bf16_t*)(ws + (which ? O_WT_A2 : O_WT_W2)), 128, 128,
                 mt_ * 256, nt_ * 128, smem, nullptr, epiD, epiS);
  }
}

__device__ __forceinline__ f32x4 mmt(const float* A, int ars, int acs, const float* B, int brs, int bcs, int nks, f32x4 acc,
                                     int lane) {
  const int r = lane & 15, q = lane >> 4;
  const float* ap = A + r * ars + q * acs;
  const float* bp = B + q * brs + r * bcs;
#pragma unroll 4
  for (int ks = 0; ks < nks; ks++) {
    acc = __builtin_amdgcn_mfma_f32_16x16x4f32(ap[4 * ks * acs], bp[4 * ks * brs], acc, 0, 0, 0);
  }
  return acc;
}

__device__ __forceinline__ void phase9(KP p, int half, float* sm) {
  char* ws = p->ws;
  constexpr int LS = 65;
  constexpr int US = 64 * LS;
  float* U0 = sm;
  float* U1 = sm + 1 * US;
  float* U2 = sm + 2 * US;
  float* U3 = sm + 3 * US;
  float* U4 = sm + 4 * US;
  float* U5 = sm + 5 * US;
  float* U6 = sm + 6 * US;
  float* U7 = sm + 7 * US;
  float* U8 = sm + 8 * US;
  float* gC = sm + 9 * US;
  const int tid = get_tid(), lane = tid & 63, wave = tid >> 6, r = lane & 15, quad = lane >> 4;
  const bf16_t* Rb = (const bf16_t*)(ws + O_R);
  const bf16_t* Kb = (const bf16_t*)(ws + O_K);
  const bf16_t* Vb = (const bf16_t*)(ws + O_V);
  const bf16_t* Ab = (const bf16_t*)(ws + O_AB);
  const float* LW = (const float*)(ws + O_LOGW);
  float* bon = (float*)(ws + O_BON);
  float* CHP = (float*)(ws + O_CHP);
  float* CHQ = (float*)(ws + O_CHQ);
  bf16_t* CHG = (bf16_t*)(ws + O_CHG);
  bf16_t* CHY = (bf16_t*)(ws + O_CHY);
  const float* k_k = p->in[32];
  const float* k_a = p->in[33];
  const float* r_k = p->in[34];
  uint4 nR, nK, nV, nA;
  float4 nL0, nL1;
#define P9_PREFETCH(slot_)                                                        \
  {                                                                               \
    const int hl_ = (slot_) >> 7, c_ = (slot_) & 127;                             \
    const size_t gi_ = (size_t)(c_ * 64 + (tid >> 3)) * 2048 + (half * 16 + hl_) * 64 + (tid & 7) * 8; \
    nR = *(const uint4*)(Rb + gi_); nK = *(const uint4*)(Kb + gi_);               \
    nV = *(const uint4*)(Vb + gi_); nA = *(const uint4*)(Ab + gi_);               \
    nL0 = *(const float4*)(LW + gi_); nL1 = *(const float4*)(LW + gi_ + 4);       \
  }
  if ((int)blockIdx.x < 2048) P9_PREFETCH((int)blockIdx.x);
  for (int slot = blockIdx.x; slot < 2048; slot += gridDim.x) {
    const int hl = slot >> 7, c = slot & 127;
    const int hd = half * 16 + hl;
    {
      const int i = tid >> 3, kg = (tid & 7) * 8;
      const int t = c * 64 + i, ch = hd * 64 + kg;
      float rr[8], kk_[8], vv[8], aa[8], lw[8];
      unpack8(nR, rr);
      unpack8(nK, kk_);
      unpack8(nV, vv);
      unpack8(nA, aa);
      {
        float4 l0 = nL0, l1 = nL1;
        { const int ns_ = slot + (int)gridDim.x; P9_PREFETCH(ns_ < 2048 ? ns_ : slot); }
        lw[0] = l0.x; lw[1] = l0.y; lw[2] = l0.z; lw[3] = l0.w; lw[4] = l1.x; lw[5] = l1.y; lw[6] = l1.z; lw[7] = l1.w;
      }
      float kn[8], k2[8];
      float ss = 0.f, bs = 0.f;
#pragma unroll
      for (int j = 0; j < 8; j++) {
        kn[j] = kk_[j] * k_k[ch + j];
        ss += kn[j] * kn[j];
        k2[j] = kk_[j] * (1.f + (aa[j] - 1.f) * k_a[ch + j]);
        bs += rr[j] * k2[j] * r_k[ch + j];
      }
      ss += __shfl_xor(ss, 1); ss += __shfl_xor(ss, 2); ss += __shfl_xor(ss, 4);
      bs += __shfl_xor(bs, 1); bs += __shfl_xor(bs, 2); bs += __shfl_xor(bs, 4);
      const float inrm = 1.f / fmaxf(sqrtf(ss), 1e-12f);
      if ((tid & 7) == 0) bon[(size_t)t * 32 + hd] = bs;
#pragma unroll
      for (int j = 0; j < 8; j++) U5[i * LS + kg + j] = lw[j];
      __syncthreads();
      if (tid < 64) {
        float xs[64];
#pragma unroll
        for (int ii = 0; ii < 64; ii++) xs[ii] = U5[ii * LS + tid];
        float run = 0.f;
#pragma unroll
        for (int ii = 0; ii < 64; ii++) { run += xs[ii]; U5[ii * LS + tid] = run; }
        gC[tid] = __expf(run);
      }
      __syncthreads();
#pragma unroll
      for (int j = 0; j < 8; j++) {
        float L = U5[i * LS + kg + j];
        float Lp = L - lw[j];
        float eL = __expf(L), eLp = __expf(Lp), enL = __expf(-L);
        float kkn = kn[j] * inrm;
        int o = i * LS + kg + j;
        U3[o] = -kkn * eLp;
        U4[o] = rr[j] * eL;
        U0[o] = k2[j] * enL;
        U1[o] = kkn * aa[j] * enL;
        U2[o] = vv[j];
      }
    }
    __syncthreads();
    f32x4 ginit[2];
    {
      const int mI = wave >> 1, hf = wave & 1;
      const float* As_ = (mI < 2) ? U3 : U4;
      const float* Bs_ = (mI & 1) ? U1 : U0;
      float* dst = U5 + mI * US;
#pragma unroll
      for (int pass = 0; pass < 2; pass++) {
        const int it = (pass == 0) ? (hf ? 1 : 0) : (hf ? 2 : 3);
        f32x4 acc4[4];
#pragma unroll
        for (int jt = 0; jt < 4; jt++) acc4[jt] = f32x4{0.f, 0.f, 0.f, 0.f};
        const float* ap = As_ + (it * 16 + r) * LS + quad;
        const float* bp = Bs_ + r * LS + quad;
#pragma unroll 4
        for (int ks = 0; ks < 16; ks++) {
          const float av = ap[4 * ks];
#pragma unroll
          for (int jt = 0; jt < 4; jt++)
            if (jt <= it) acc4[jt] = __builtin_amdgcn_mfma_f32_16x16x4f32(av, bp[jt * 16 * LS + 4 * ks], acc4[jt], 0, 0, 0);
        }
#pragma unroll
        for (int jt = 0; jt < 4; jt++) {
#pragma unroll
          for (int v = 0; v < 4; v++) {
            int i = it * 16 + quad * 4 + v, j = jt * 16 + r;
            bool keep = (mI < 2) ? (j < i) : (j <= i);
            dst[i * LS + j] = keep ? acc4[jt][v] : 0.f;
          }
        }
      }
      const int it = wave >> 1;
#pragma unroll
      for (int x = 0; x < 2; x++) {
        int jt = (wave & 1) * 2 + x;
#pragma unroll
        for (int v = 0; v < 4; v++) ginit[x][v] = U4[(it * 16 + quad * 4 + v) * LS + jt * 16 + r];
      }
    }
    __syncthreads();
    {
      const int it = wave >> 1, jt0 = (wave & 1) * 2;
      f32x4 xa0 = f32x4{0.f, 0.f, 0.f, 0.f}, xa1 = f32x4{0.f, 0.f, 0.f, 0.f};
      const float* ap = U5 + (it * 16 + r) * LS + quad;
      const float* bp = U2 + quad * LS + jt0 * 16 + r;
#pragma unroll 4
      for (int ks = 0; ks < 16; ks++) {
        const float av = ap[4 * ks];
        xa0 = __builtin_amdgcn_mfma_f32_16x16x4f32(av, bp[4 * ks * LS], xa0, 0, 0, 0);
        xa1 = __builtin_amdgcn_mfma_f32_16x16x4f32(av, bp[4 * ks * LS + 16], xa1, 0, 0, 0);
      }
      __syncthreads();
#pragma unroll
      for (int v = 0; v < 4; v++) {
        U5[(it * 16 + quad * 4 + v) * LS + jt0 * 16 + r] = xa0[v];
        U5[(it * 16 + quad * 4 + v) * LS + jt0 * 16 + 16 + r] = xa1[v];
      }
    }
    __syncthreads();
    {
      float* Rb_ = (wave < 4) ? (U3 + wave * 16) : (U5 + (wave - 4) * 16);
#pragma unroll 1
      for (int blk = 0; blk < 4; blk++) {
        f32x4 sv;
#pragma unroll
        for (int v = 0; v < 4; v++) sv[v] = Rb_[(16 * blk + quad * 4 + v) * LS + r];
        {
          const float* ap = U6 + (16 * blk + r) * LS + quad;
          const float* bp = Rb_ + quad * LS + r;
          for (int ks = 0; ks < 4 * blk; ks++)
            sv = __builtin_amdgcn_mfma_f32_16x16x4f32(ap[4 * ks], bp[4 * ks * LS], sv, 0, 0, 0);
        }
        float nd[4][16];
#pragma unroll
        for (int v = 0; v < 4; v++)
#pragma unroll
          for (int i = 0; i < 16; i++) nd[v][i] = U6[(16 * blk + quad * 4 + v) * LS + 16 * blk + i];
#pragma unroll
        for (int i = 0; i < 15; i++) {
          const float ui = __shfl(sv[i & 3], (i >> 2) * 16 + r);
#pragma unroll
          for (int v = 0; v < 4; v++) sv[v] += nd[v][i] * ui;
        }
#pragma unroll
        for (int v = 0; v < 4; v++) Rb_[(16 * blk + quad * 4 + v) * LS + r] = sv[v];
        __builtin_amdgcn_s_waitcnt(0);
        __builtin_amdgcn_wave_barrier();
      }
    }
    __syncthreads();
    {
      const int it = wave >> 1, jt0 = (wave & 1) * 2;
      const size_t sbase = (size_t)slot * 4096;
      f32x4 g_[2], y1[2], y2[2], p_[2], q1[2], q2[2];
#pragma unroll
      for (int x = 0; x < 2; x++) {
        g_[x] = ginit[x];
        y1[x] = y2[x] = p_[x] = q1[x] = q2[x] = f32x4{0.f, 0.f, 0.f, 0.f};
      }
      const float* a_rb = U8 + (it * 16 + r) * LS + quad;
      const float* a_rk = U7 + (it * 16 + r) * LS + quad;
      const float* a_bt = U1 + quad * LS + it * 16 + r;
      const float* a_kt = U0 + quad * LS + it * 16 + r;
      const float* b_w1 = U3 + quad * LS + jt0 * 16 + r;
      const float* b_v = U2 + quad * LS + jt0 * 16 + r;
      const float* b_w2 = U5 + quad * LS + jt0 * 16 + r;
#pragma unroll 2
      for (int ks = 0; ks < 16; ks++) {
        const float arb = a_rb[4 * ks], ark = a_rk[4 * ks], abt = a_bt[4 * ks * LS], akt = a_kt[4 * ks * LS];
#pragma unroll
        for (int x = 0; x < 2; x++) {
          const float w1 = b_w1[4 * ks * LS + 16 * x], vv_ = b_v[4 * ks * LS + 16 * x], w2 = b_w2[4 * ks * LS + 16 * x];
          g_[x] = __builtin_amdgcn_mfma_f32_16x16x4f32(arb, w1, g_[x], 0, 0, 0);
          y1[x] = __builtin_amdgcn_mfma_f32_16x16x4f32(ark, vv_, y1[x], 0, 0, 0);
          y2[x] = __builtin_amdgcn_mfma_f32_16x16x4f32(arb, w2, y2[x], 0, 0, 0);
          p_[x] = __builtin_amdgcn_mfma_f32_16x16x4f32(abt, w1, p_[x], 0, 0, 0);
          q1[x] = __builtin_amdgcn_mfma_f32_16x16x4f32(akt, vv_, q1[x], 0, 0, 0);
          q2[x] = __builtin_amdgcn_mfma_f32_16x16x4f32(abt, w2, q2[x], 0, 0, 0);
        }
      }
#pragma unroll
      for (int x = 0; x < 2; x++) {
#pragma unroll
        for (int v = 0; v < 4; v++) {
          int row = it * 16 + quad * 4 + v, colx = (jt0 + x) * 16 + r;
          size_t o = sbase + row * 64 + colx;
          CHG[o] = f2bf(g_[x][v]);
          CHY[o] = f2bf(y1[x][v] + y2[x][v]);
          float gc = gC[row];
          CHP[o] = gc * (p_[x][v] + (row == colx ? 1.f : 0.f));
          CHQ[o] = gc * (q1[x][v] + q2[x][v]);
        }
      }
    }
    __syncthreads();
  }
}

__device__ __forceinline__ void phase10(KP p, int half, float* sm) {
  char* ws = p->ws;
  if (blockIdx.x >= 64) return;
  const int bidx = blockIdx.x;
  const int hl = bidx >> 2, vs = bidx & 3;
  const int tid = get_tid(), lane = tid & 63, wave = tid >> 6, r = lane & 15, q = lane >> 4;
  const float* CHP = (const float*)(ws + O_CHP);
  const float* CHQ = (const float*)(ws + O_CHQ);
  float* S0 = (float*)(ws + O_S0);
  float* Sb = sm;
  const size_t hbase = (size_t)(hl * 128) * 4096;
  if (wave < 4) {
    const float* Pb = CHP + hbase + (16 * wave + r) * 64 + 16 * q;
    const float* Qb = CHQ + hbase + (16 * wave + 4 * q) * 64 + vs * 16 + r;
    float4 A0, B0, C0, D0, A1, B1, C1, D1, A2, B2, C2, D2, A3, B3, C3, D3;
    f32x4 Q0, Q1, Q2, Q3;
#define PF_S(k_, c_)                                                         \
  {                                                                          \
    __builtin_amdgcn_sched_barrier(0);                                       \
    const size_t so_ = (size_t)min((c_), 127) * 4096;                        \
    A##k_ = *(const float4*)(Pb + so_);                                      \
    B##k_ = *(const float4*)(Pb + so_ + 4);                                  \
    C##k_ = *(const float4*)(Pb + so_ + 8);                                  \
    D##k_ = *(const float4*)(Pb + so_ + 12);                                 \
    Q##k_[0] = Qb[so_]; Q##k_[1] = Qb[so_ + 64]; Q##k_[2] = Qb[so_ + 128]; Q##k_[3] = Qb[so_ + 192]; \
    __builtin_amdgcn_sched_barrier(0);                                       \
  }
    f32x4 st = f32x4{0.f, 0.f, 0.f, 0.f};
#define STEP_S(k_, c_)                                                                         \
  {                                                                                            \
    float* sbuf = Sb + ((c_) & 1) * 16 * 68;                                                   \
    *(float4*)(sbuf + r * 68 + 16 * wave + 4 * q) = float4{st[0], st[1], st[2], st[3]};        \
    float a[16] = {A##k_.x, A##k_.y, A##k_.z, A##k_.w, B##k_.x, B##k_.y, B##k_.z, B##k_.w,      \
                   C##k_.x, C##k_.y, C##k_.z, C##k_.w, D##k_.x, D##k_.y, D##k_.z, D##k_.w};     \
    f32x4 acc = Q##k_;                                                                         \
    asm volatile("s_waitcnt lgkmcnt(0)\n\ts_barrier" ::: "memory");                            \
    f32x4 acc2 = f32x4{0.f, 0.f, 0.f, 0.f};                                                    \
    {                                                                                          \
      const float4 s0_ = *(const float4*)(sbuf + r * 68 + 16 * q), s1_ = *(const float4*)(sbuf + r * 68 + 16 * q + 4);  \
      const float4 s2_ = *(const float4*)(sbuf + r * 68 + 16 * q + 8), s3_ = *(const float4*)(sbuf + r * 68 + 16 * q + 12); \
      const float sv_[16] = {s0_.x, s0_.y, s0_.z, s0_.w, s1_.x, s1_.y, s1_.z, s1_.w, s2_.x, s2_.y, s2_.z, s2_.w, s3_.x, s3_.y, s3_.z, s3_.w}; \
      _Pragma("unroll") for (int ks = 0; ks < 16; ks += 2) {                                   \
        acc = __builtin_amdgcn_mfma_f32_16x16x4f32(a[ks], sv_[ks], acc, 0, 0, 0);              \
        acc2 = __builtin_amdgcn_mfma_f32_16x16x4f32(a[ks + 1], sv_[ks + 1], acc2, 0, 0, 0);    \
      }                                                                                        \
    }                                                                                          \
    PF_S(k_, (c_) + 4)                                                                         \
    _Pragma("unroll") for (int v = 0; v < 4; v++) acc[v] += acc2[v];                           \
    st = acc;                                                                                  \
  }
    PF_S(0, 0) PF_S(1, 1) PF_S(2, 2) PF_S(3, 3)
    for (int c = 0; c < 128; c += 4) {
      STEP_S(0, c) STEP_S(1, c + 1) STEP_S(2, c + 2) STEP_S(3, c + 3)
    }
  } else {
    const int w4 = wave - 4;
    for (int c = 0; c < 128; c++) {
      const float* sbuf = Sb + (c & 1) * 16 * 68;
      asm volatile("s_waitcnt lgkmcnt(0)\n\ts_barrier" ::: "memory");
      float* dst = S0 + hbase + (size_t)c * 4096 + vs * 16;
      const float4 sv4 = *(const float4*)(sbuf + r * 68 + 16 * w4 + 4 * q);
      const int k0_ = 16 * w4 + 4 * q;
      dst[(k0_ + 0) * 64 + r] = sv4.x; dst[(k0_ + 1) * 64 + r] = sv4.y; dst[(k0_ + 2) * 64 + r] = sv4.z; dst[(k0_ + 3) * 64 + r] = sv4.w;
    }
  }
}

__device__ __forceinline__ void phase10b(KP p, int half, float* sm) {
  char* ws = p->ws;
  constexpr int LS = 65;
  float* S0s = sm;
  float* Ys = sm + 64 * LS;
  const int tid = get_tid(), lane = tid & 63, wave = tid >> 6, r = lane & 15, quad = lane >> 4;
  const float* S0 = (const float*)(ws + O_S0);
  const bf16_t* CHG = (const bf16_t*)(ws + O_CHG);
  const bf16_t* CHY = (const bf16_t*)(ws + O_CHY);
  const bf16_t* Vb = (const bf16_t*)(ws + O_V);
  const bf16_t* Zs = (const bf16_t*)(ws + O_ZS);
  const float* bon = (const float*)(ws + O_BON);
  const float* lg = p->in[35];
  const float* lb = p->in[36];
  bf16_t* YR = (bf16_t*)(ws + O_YR);
  for (int slot = blockIdx.x; slot < 2048; slot += gridDim.x) {
    const int hl = slot >> 7, c = slot & 127, hd = half * 16 + hl;
    const size_t sbase = (size_t)slot * 4096;
    __syncthreads();
    for (int e = tid; e < 1024; e += NTHR) {
      const int k = e >> 4, v4 = (e & 15) * 4;
      const float4 f = *(const float4*)(S0 + sbase + k * 64 + v4);
      S0s[k * LS + v4] = f.x; S0s[k * LS + v4 + 1] = f.y; S0s[k * LS + v4 + 2] = f.z; S0s[k * LS + v4 + 3] = f.w;
    }
    const int it = wave >> 1, vt0 = (wave & 1) * 2;
    float a[16];
    {
      const bf16_t* G = CHG + sbase + (16 * it + r) * 64 + 16 * quad;
      unpack8(*(const uint4*)G, a);
      unpack8(*(const uint4*)(G + 8), a + 8);
    }
    f32x4 acc0, acc1;
#pragma unroll
    for (int v = 0; v < 4; v++) {
      acc0[v] = bf2f(CHY[sbase + (16 * it + 4 * quad + v) * 64 + vt0 * 16 + r]);
      acc1[v] = bf2f(CHY[sbase + (16 * it + 4 * quad + v) * 64 + vt0 * 16 + 16 + r]);
    }
    __syncthreads();
#pragma unroll
    for (int ks = 0; ks < 16; ks++) {
      acc0 = __builtin_amdgcn_mfma_f32_16x16x4f32(a[ks], S0s[(16 * quad + ks) * LS + vt0 * 16 + r], acc0, 0, 0, 0);
      acc1 = __builtin_amdgcn_mfma_f32_16x16x4f32(a[ks], S0s[(16 * quad + ks) * LS + vt0 * 16 + 16 + r], acc1, 0, 0, 0);
    }
#pragma unroll
    for (int v = 0; v < 4; v++) {
      Ys[(16 * it + 4 * quad + v) * LS + vt0 * 16 + r] = acc0[v];
      Ys[(16 * it + 4 * quad + v) * LS + vt0 * 16 + 16 + r] = acc1[v];
    }
    __syncthreads();
    {
      const int i = tid >> 3, vg = (tid & 7) * 8;
      const int t = c * 64 + i, ch = hd * 64 + vg;
      float y[8];
      float s = 0.f;
#pragma unroll
      for (int j = 0; j < 8; j++) { y[j] = Ys[i * LS + vg + j]; s += y[j]; }
      s += __shfl_xor(s, 1); s += __shfl_xor(s, 2); s += __shfl_xor(s, 4);
      const float mean = s * (1.f / 64.f);
      float vr = 0.f;
#pragma unroll
      for (int j = 0; j < 8; j++) { float d = y[j] - mean; vr += d * d; }
      vr += __shfl_xor(vr, 1); vr += __shfl_xor(vr, 2); vr += __shfl_xor(vr, 4);
      const float rstd = rsqrtf(vr * (1.f / 64.f) + 64e-5f);
      const float bo = bon[(size_t)t * 32 + hd];
      const size_t gi = (size_t)t * 2048 + ch;
      float vv[8], zz[8];
      unpack8(*(const uint4*)(Vb + gi), vv);
      unpack8(*(const uint4*)(Zs + gi), zz);
      float o[8];
#pragma unroll
      for (int j = 0; j < 8; j++) o[j] = ((y[j] - mean) * rstd * lg[ch + j] + lb[ch + j] + bo * vv[j]) * zz[j];
      uint4 u;
      u.x = pack2(o[0], o[1]); u.y = pack2(o[2], o[3]); u.z = pack2(o[4], o[5]); u.w = pack2(o[6], o[7]);
      *(uint4*)(YR + gi) = u;
    }
  }
}

__device__ __forceinline__ void phase11(KP p) {
  char* ws = p->ws;
  const int lane = get_tid() & 63, wave = get_tid() >> 6;
  const bf16_t* yraw = (const bf16_t*)(ws + O_YRAW);
  const bf16_t* Vb = (const bf16_t*)(ws + O_V);
  const bf16_t* Zs = (const bf16_t*)(ws + O_ZS);
  const float* bon = (const float*)(ws + O_BON);
  const float* lg = p->in[35];
  const float* lb = p->in[36];
  bf16_t* YR = (bf16_t*)(ws + O_YR);
  for (int t = blockIdx.x * 8 + wave; t < S_; t += gridDim.x * 8) {
    const size_t base = (size_t)t * 2048 + lane * 32;
    float y[32];
#pragma unroll
    for (int x = 0; x < 4; x++) unpack8(*(const uint4*)(yraw + base + 8 * x), y + 8 * x);
    float s = 0.f;
#pragma unroll
    for (int x = 0; x < 32; x++) s += y[x];
    s += __shfl_xor(s, 1);
    float mean = s * (1.f / 64.f);
    float vr = 0.f;
#pragma unroll
    for (int x = 0; x < 32; x++) { float d = y[x] - mean; vr += d * d; }
    vr += __shfl_xor(vr, 1);
    float rstd = rsqrtf(vr * (1.f / 64.f) + 64e-5f);
    float bo = bon[(size_t)t * 32 + (lane >> 1)];
#pragma unroll
    for (int x = 0; x < 4; x++) {
      float vv[8], zz[8];
      unpack8(*(const uint4*)(Vb + base + 8 * x), vv);
      unpack8(*(const uint4*)(Zs + base + 8 * x), zz);
      float o[8];
#pragma unroll
      for (int j = 0; j < 8; j++) {
        int ch = lane * 32 + 8 * x + j;
        o[j] = ((y[8 * x + j] - mean) * rstd * lg[ch] + lb[ch] + bo * vv[j]) * zz[j];
      }
      uint4 u;
      u.x = pack2(o[0], o[1]); u.y = pack2(o[2], o[3]); u.z = pack2(o[4], o[5]); u.w = pack2(o[6], o[7]);
      *(uint4*)(YR + base + 8 * x) = u;
    }
  }
}

__device__ __forceinline__ void phase13(KP p) {
  const int lane = get_tid() & 63, wave = get_tid() >> 6;
  const float* g = p->in[5];
  for (int row = blockIdx.x * 8 + wave; row < S_; row += gridDim.x * 8) {
    float* xr = p->out + (size_t)row * 2048;
    float4 v[8];
    float ss = 0.f;
#pragma unroll
    for (int j = 0; j < 8; j++) {
      v[j] = *(const float4*)(xr + lane * 4 + 256 * j);
      ss += v[j].x * v[j].x + v[j].y * v[j].y + v[j].z * v[j].z + v[j].w * v[j].w;
    }
    ss = wave_sum(ss);
    float rstd = rsqrtf(ss * (1.f / 2048.f) + 1e-6f);
#pragma unroll
    for (int j = 0; j < 8; j++) {
      int col = lane * 4 + 256 * j;
      float4 gg = *(const float4*)(g + col);
      float4 o;
      o.x = v[j].x * rstd * gg.x; o.y = v[j].y * rstd * gg.y; o.z = v[j].z * rstd * gg.z; o.w = v[j].w * rstd * gg.w;
      *(float4*)(xr + col) = o;
    }
  }
}

#include <vector>

#define XB_TMO      128
#define XB_XCNT(j)  (256  + 64 * (j))
#define XB_XSUB(j)  (1280 + 64 * (j))
#define XB_XGEN(j)  (2304 + 64 * (j))
#define XB_TOP      3328
#define XB_TOPGEN   3392
#define XCD_BAR_WORDS 3456
#define XB_SPIN_CAP (1u << 18)
#define LAS __attribute__((address_space(3)))

__device__ __forceinline__ unsigned xb_ld(unsigned* p)              { return __hip_atomic_load(p, __ATOMIC_RELAXED, __HIP_MEMORY_SCOPE_AGENT); }
__device__ __forceinline__ unsigned xb_add(unsigned* p, unsigned v) { return __hip_atomic_fetch_add(p, v, __ATOMIC_RELAXED, __HIP_MEMORY_SCOPE_AGENT); }
__device__ __forceinline__ unsigned xb_xcc_id() { return (unsigned)__builtin_amdgcn_s_getreg((3 << 11) | 20) & 0xFu; }
#define XB_SPIN(cond, bar) do { unsigned _sp = 0; while (cond) { __builtin_amdgcn_s_sleep(1); \
    if ((++_sp & 255u) == 0u) { if (xb_ld(&(bar)[XB_TMO])) break; if (_sp > XB_SPIN_CAP) { atomicAdd(&(bar)[XB_TMO], 1u); break; } } } } while (0)

struct XcdBarrier {
    unsigned* bar; unsigned x;
    volatile LAS unsigned* st;
};

__device__ __forceinline__ XcdBarrier xcd_barrier_post(unsigned* bar, volatile LAS unsigned* st) {
    XcdBarrier b; b.bar = bar; b.x = xb_xcc_id(); b.st = st;
    if (threadIdx.x == 0) (void)xb_add(&bar[XB_XCNT(b.x)], 1u);
    return b;
}
__device__ __forceinline__ void xcd_barrier_complete(unsigned* bar, unsigned x, unsigned& nloc, unsigned& nx) {
    const unsigned G = gridDim.x * gridDim.y * gridDim.z;
    unsigned sum, cnt, mine, sp = 0u;
    for (;;) {
        sum = 0u; cnt = 0u; mine = 0u;
#pragma unroll
        for (unsigned j = 0; j < 16; ++j) { const unsigned c = xb_ld(&bar[XB_XCNT(j)]); sum += c; cnt += (c > 0u) ? 1u : 0u; mine = (j == x) ? c : mine; }
        if (sum == G) break;
        __builtin_amdgcn_s_sleep(1);
        if ((++sp & 255u) == 0u) { if (xb_ld(&bar[XB_TMO])) break; if (sp > XB_SPIN_CAP) { atomicAdd(&bar[XB_TMO], 1u); break; } }
    }
    nloc = mine > 0u ? mine : 1u; nx = cnt > 0u ? cnt : 1u;
}

__device__ __forceinline__ void xcd_barrier(const XcdBarrier& b) {
    asm volatile("s_waitcnt vmcnt(0)" ::: "memory");
    __syncthreads();
    if (threadIdx.x == 0) {
        unsigned* bar = b.bar;
        __builtin_amdgcn_s_waitcnt(0);
        unsigned nloc = b.st[0], nx = b.st[1];
        if (nloc == 0u) { xcd_barrier_complete(bar, b.x, nloc, nx); b.st[0] = nloc; b.st[1] = nx; }
        const unsigned old = xb_add(&bar[XB_XSUB(b.x)], 1u);
        const unsigned gen = old / nloc;
        if (old + 1u == (gen + 1u) * nloc) {
            __builtin_amdgcn_fence(__ATOMIC_RELEASE, "agent");
            asm volatile("s_waitcnt vmcnt(0)" ::: "memory");
            const unsigned og = xb_add(&bar[XB_TOP], 1u);
            const unsigned tg = og / nx;
            if (og + 1u == (tg + 1u) * nx) xb_add(&bar[XB_TOPGEN], 1u);
            else XB_SPIN(xb_ld(&bar[XB_TOPGEN]) == tg, bar);
            __builtin_amdgcn_fence(__ATOMIC_ACQUIRE, "agent");
            xb_add(&bar[XB_XGEN(b.x)], 1u);
            asm volatile("s_waitcnt vmcnt(0)" ::: "memory");
        } else {
            XB_SPIN(xb_ld(&bar[XB_XGEN(b.x)]) == gen, bar);
            __builtin_amdgcn_fence(__ATOMIC_ACQUIRE, "agent");
            asm volatile("s_waitcnt vmcnt(0)" ::: "memory");
        }
    }
    __syncthreads();
}

__global__ void __launch_bounds__(NTHR) fwd_megakernel(Params p_unused) {
  extern __shared__ __attribute__((aligned(16))) char smem[];
  cg::grid_group grid = cg::this_grid();
  float* smf = (float*)smem;
  KP p = (KP)__builtin_amdgcn_kernarg_segment_ptr();
#define LAUNDER() asm volatile("" : "+s"(p))
  {
    volatile LAS unsigned* st0 = (volatile LAS unsigned*)(smem + 150528);
    if (threadIdx.x == 0) { st0[0] = 0u; st0[1] = 0u; st0[2] = 0u; st0[3] = 0u; }
    __syncthreads();
    (void)xcd_barrier_post((unsigned*)(p->ws + O_BAR), st0);
  }
#define GRID_BARRIER()                                                       \
  {                                                                          \
    XcdBarrier xb_;                                                          \
    xb_.bar = (unsigned*)(p->ws + O_BAR);                                    \
    xb_.x = xb_xcc_id();                                                     \
    xb_.st = (volatile LAS unsigned*)(smem + 150528);                        \
    xcd_barrier(xb_);                                                        \
  }
  phase0(p, smf);
  if (p->out == nullptr) grid.sync();
  GRID_BARRIER();
  LAUNDER();
  norm_phase(p, 0, p->in[0], (bf16_t*)(p->ws + O_H0), smf);
  GRID_BARRIER();
  LAUNDER();
  phase2(p, smem);
  GRID_BARRIER();
  LAUNDER();
  phase3(p, smem);
  GRID_BARRIER();
  LAUNDER();
  phase4(p, smem, 0);
  GRID_BARRIER();
  LAUNDER();
  outproj_phase(p, (const bf16_t*)(p->ws + O_Y), (const bf16_t*)(p->ws + O_WT_OUT), p->in[0], 0, smem);
  GRID_BARRIER();
  LAUNDER();
#if PROBE == 1
  phase2(p, smem);
  GRID_BARRIER();
  LAUNDER();
  phase3(p, smem);
  GRID_BARRIER();
  LAUNDER();
  phase4(p, smem, 1);
  GRID_BARRIER();
  LAUNDER();
  outproj_phase(p, (const bf16_t*)(p->ws + O_Y), (const bf16_t*)(p->ws + O_WT_OUT), p->in[0], 0, smem);
  GRID_BARRIER();
  LAUNDER();
#endif
#if PROBE == 2
  phase4(p, smem, 1);
  GRID_BARRIER();
  LAUNDER();
#endif
  norm_shift_phase(p, smf);
  GRID_BARRIER();
  LAUNDER();
  phase7(p, smem);
  GRID_BARRIER();
  LAUNDER();
  phase8(p, smem);
  GRID_BARRIER();
  LAUNDER();
  for (int half = 0; half < 2; half++) {
    phase9(p, half, smf);
    GRID_BARRIER();
    LAUNDER();
    phase10(p, half, smf);
    GRID_BARRIER();
    LAUNDER();
    phase10b(p, half, smf);
    GRID_BARRIER();
    LAUNDER();
  }
  outproj_phase(p, (const bf16_t*)(p->ws + O_YR), (const bf16_t*)(p->ws + O_WT_O), p->out, 1, smem);
  GRID_BARRIER();
  LAUNDER();
  phase13(p);
}

extern "C" void kernel_launch(void* const* d_in, const int* in_sizes, int n_in, void* d_out, int out_size, void* d_ws,
                              size_t ws_size, hipStream_t stream) {
  static int grid_blocks = 0;
  if (!grid_blocks) {
    int dev = 0, cus = 0, per_cu = 0;
    hipGetDevice(&dev);
    hipDeviceGetAttribute(&cus, hipDeviceAttributeMultiprocessorCount, dev);
    hipFuncSetAttribute((const void*)fwd_megakernel, hipFuncAttributeMaxDynamicSharedMemorySize, LDS_BYTES);
    hipOccupancyMaxActiveBlocksPerMultiprocessor(&per_cu, (const void*)fwd_megakernel, NTHR, LDS_BYTES);
    if (per_cu < 1) per_cu = 1;
    grid_blocks = cus * per_cu;
    if (ws_size < WS_NEED) fprintf(stderr, "workspace too small: %zu < %zu\n", ws_size, (size_t)WS_NEED);
  }
  Params hp{};
  for (int i = 0; i < 37; i++) hp.in[i] = (const float*)d_in[i];
  hp.out = (float*)d_out;
  hp.ws = (char*)d_ws;
  (void)hipMemsetAsync((char*)d_ws + O_BAR, 0, XCD_BAR_WORDS * sizeof(unsigned), stream);
  void* args[] = {&hp};
  hipError_t e = hipLaunchCooperativeKernel((const void*)fwd_megakernel, dim3(grid_blocks), dim3(NTHR), args, LDS_BYTES, stream);
  if (e != hipSuccess) fprintf(stderr, "cooperative launch failed: %s (grid %d)\n", hipGetErrorString(e), grid_blocks);
}
```

```cpp
#include <hip/hip_runtime.h>
#include <hip/hip_cooperative_groups.h>
#include <stdint.h>
#include <stdio.h>
namespace cg = cooperative_groups;

typedef unsigned short bf16_t;
using bf16x8 = __attribute__((ext_vector_type(8))) short;
using f32x4 = __attribute__((ext_vector_type(4))) float;

#ifndef PROBE
#define PROBE 0
#endif
#define S_ 8192
#define D_ 2048
#define NTHR 512

struct Params {
  const float* in[37];
  float* out;
  char* ws;
};
typedef const __attribute__((address_space(4))) Params* KP;

constexpr size_t MBy = 1u << 20;
constexpr size_t O_MODP = 0;
constexpr size_t O_MOD = 393216;
constexpr size_t O_CTR = 442368;
constexpr size_t O_CPE = 442624;
constexpr size_t O_W2T = 443392;
constexpr size_t O_HID = 459776;
constexpr size_t O_KCMP = 721920;
constexpr size_t O_VCMPT = 852992;
constexpr size_t O_BON = 984064;
constexpr size_t O_BAR = 2032640;
constexpr size_t O_WT_IN = 2 * MBy;
constexpr size_t O_WT_OUT = O_WT_IN + 20447232;
constexpr size_t O_WT_QB = O_WT_OUT + 8388608;
constexpr size_t O_WT_KVB = O_WT_QB + 1572864;
constexpr size_t O_W1T = O_WT_KVB + 2097152;
constexpr size_t O_WT_R = 34 * MBy;
constexpr size_t O_WT_K = 42 * MBy;
constexpr size_t O_WT_V = 50 * MBy;
constexpr size_t O_WT_Z = 58 * MBy;
constexpr size_t O_WT_O = 66 * MBy;
constexpr size_t O_WT_W1 = 74 * MBy;
constexpr size_t O_WT_A1 = O_WT_W1 + 524288;
constexpr size_t O_WT_W2 = O_WT_A1 + 524288;
constexpr size_t O_WT_A2 = O_WT_W2 + 524288;
constexpr size_t O_H0 = 76 * MBy;
constexpr size_t O_QN = 108 * MBy;
constexpr size_t O_KC = 124 * MBy;
constexpr size_t O_VC = O_KC + 2 * MBy + 65536;
constexpr size_t O_KS = O_VC + 2 * MBy + 65536;
constexpr size_t O_KW = O_KS + 2 * MBy;
constexpr size_t O_VST = O_KW + 2 * MBy;
constexpr size_t O_VWT = O_VST + 2 * MBy;
constexpr size_t O_ZN = 137 * MBy;
constexpr size_t O_ZM = 153 * MBy;
constexpr size_t O_QA = 169 * MBy;
constexpr size_t O_CKV = 177 * MBy;
constexpr size_t O_KPE = 185 * MBy;
constexpr size_t O_GATES = 187 * MBy;
constexpr size_t O_QM = 189 * MBy;
constexpr size_t O_KM = 213 * MBy;
constexpr size_t O_VMT = 237 * MBy;
constexpr size_t O_Y = 253 * MBy;
constexpr size_t O_ROPE = 285 * MBy;
constexpr size_t O_H1 = 76 * MBy;
constexpr size_t O_XK = 204 * MBy;
constexpr size_t O_XV = 236 * MBy;
constexpr size_t O_XZ = 268 * MBy;
constexpr size_t O_XW = 336 * MBy;
constexpr size_t O_XA = 2 * MBy;
constexpr size_t O_R = 108 * MBy;
constexpr size_t O_K = 140 * MBy;
constexpr size_t O_V = 172 * MBy;
constexpr size_t O_AB = 204 * MBy;
constexpr size_t O_LOGW = 236 * MBy;
constexpr size_t O_ZS = 300 * MBy;
constexpr size_t O_LW = 332 * MBy;
constexpr size_t O_LA = 334 * MBy;
constexpr size_t O_YRAW = 336 * MBy;
constexpr size_t O_S0 = 336 * MBy;
constexpr size_t O_CHP = 2 * MBy;
constexpr size_t O_CHQ = 34 * MBy;
constexpr size_t O_CHG = 76 * MBy;
constexpr size_t O_CHY = 92 * MBy;
constexpr size_t O_YR = 108 * MBy;
constexpr size_t WS_NEED = 368 * MBy;

constexpr int LDS_BYTES = 9 * 64 * 65 * 4 + 1024;

__device__ __forceinline__ int get_tid() { int t = threadIdx.x; asm volatile("" : "+v"(t)); return t; }
__device__ __forceinline__ float bf2f(bf16_t b) { return __uint_as_float(((uint32_t)b) << 16); }
typedef float float2_t __attribute__((ext_vector_type(2)));
typedef __bf16 bf16x2v __attribute__((ext_vector_type(2)));
__device__ __forceinline__ uint32_t pack2(float a, float b) {
  float2_t f = {a, b};
  bf16x2v h = __builtin_convertvector(f, bf16x2v);
  return *(uint32_t*)&h;
}
__device__ __forceinline__ bf16_t f2bf(float f) { return (bf16_t)(pack2(f, 0.f) & 0xffffu); }
__device__ __forceinline__ float siluf(float x) { return x / (1.f + __expf(-x)); }
__device__ __forceinline__ float sigmf(float x) { return 1.f / (1.f + __expf(-x)); }
__device__ __forceinline__ void unpack8(uint4 v, float* f) {
  f[0] = __uint_as_float(v.x << 16); f[1] = __uint_as_float(v.x & 0xffff0000u);
  f[2] = __uint_as_float(v.y << 16); f[3] = __uint_as_float(v.y & 0xffff0000u);
  f[4] = __uint_as_float(v.z << 16); f[5] = __uint_as_float(v.z & 0xffff0000u);
  f[6] = __uint_as_float(v.w << 16); f[7] = __uint_as_float(v.w & 0xffff0000u);
}
__device__ __forceinline__ f32x4 mfma_bf16(bf16x8 a, bf16x8 b, f32x4 c) {
  return __builtin_amdgcn_mfma_f32_16x16x32_bf16(a, b, c, 0, 0, 0);
}
__device__ __forceinline__ float4 ld_nt4(const float* p) {
  const f32x4 v = __builtin_nontemporal_load((const f32x4*)p);
  return float4{v[0], v[1], v[2], v[3]};
}
__device__ __forceinline__ float wave_sum(float v) {
#pragma unroll
  for (int o = 32; o > 0; o >>= 1) v += __shfl_xor(v, o);
  return v;
}

template <int AMODE, class Epi, class EpiS = int>
__device__ __forceinline__ void gemm_tile(const bf16_t* __restrict__ A, int lda, const bf16_t* __restrict__ Bt, int ldb,
                                          int K, int m0, int n0, char* smem, const float* __restrict__ mu, Epi epi, EpiS epiS = 0) {
  bf16_t* As = (bf16_t*)smem;
  const int tid = get_tid(), lane = tid & 63, wave = tid >> 6;
  const int wm = wave >> 1, wn = wave & 1, r = lane & 15, quad = lane >> 4;
  f32x4 acc[4][4];
#pragma unroll
  for (int i = 0; i < 4; i++)
#pragma unroll
    for (int j = 0; j < 4; j++) acc[i][j] = f32x4{0.f, 0.f, 0.f, 0.f};
  const int lrow = tid >> 3, lkc = (tid & 7) * 8;
  const int lsw = ((tid & 7) ^ (lrow & 7)) * 8;
  const int rsw0 = ((quad) ^ (r & 7)) * 8, rsw1 = ((4 + quad) ^ (r & 7)) * 8;
  uint4 xa0, xa1, xa2, xa3, xp0, xp1, xp2, xp3, xb0, xb1;
  const bf16_t* abase = A + (size_t)(m0 + lrow) * lda + lkc;
  const bf16_t* bbase = Bt + (size_t)(n0 + lrow) * ldb + lkc;
  const bool row0zero = (AMODE == 1) && (m0 + lrow == 0);
#define GL1(dst_, dstp_, i_, k0_)                                                     \
  {                                                                                   \
    const bf16_t* ap_ = abase + (size_t)(64 * (i_)) * lda + (k0_);                    \
    dst_ = *(const uint4*)ap_;                                                        \
    if (AMODE == 1) {                                                                 \
      if ((i_) == 0 && row0zero) dstp_ = uint4{0, 0, 0, 0};                           \
      else dstp_ = *(const uint4*)(ap_ - lda);                                        \
    }                                                                                 \
  }
#define GLOADS(...) GLOADS_(__VA_ARGS__)
#define GLOADS_(a0, a1, a2, a3, p0, p1, p2, p3, b0, b1, k0_)                           \
  {                                                                                   \
    __builtin_amdgcn_sched_barrier(0);                                                \
    GL1(a0, p0, 0, k0_) GL1(a1, p1, 1, k0_) GL1(a2, p2, 2, k0_) GL1(a3, p3, 3, k0_)   \
    b0 = *(const uint4*)(bbase + (k0_));                                              \
    b1 = *(const uint4*)(bbase + (size_t)64 * ldb + (k0_));                           \
    __builtin_amdgcn_sched_barrier(0);                                                \
  }
#define GS1(src_, srcp_, i_, As_, k0_)                                                                    \
  {                                                                                                       \
    uint4 v = src_;                                                                                       \
    if (AMODE == 1) {                                                                                     \
      float h[8], hp[8];                                                                                  \
      unpack8(src_, h);                                                                                   \
      unpack8(srcp_, hp);                                                                                 \
      const float4 m0v = *(const float4*)(mu + (k0_) + lkc);                                              \
      const float4 m1v = *(const float4*)(mu + (k0_) + lkc + 4);                                          \
      float o0 = h[0] + (hp[0] - h[0]) * m0v.x, o1 = h[1] + (hp[1] - h[1]) * m0v.y;                       \
      float o2 = h[2] + (hp[2] - h[2]) * m0v.z, o3 = h[3] + (hp[3] - h[3]) * m0v.w;                       \
      float o4 = h[4] + (hp[4] - h[4]) * m1v.x, o5 = h[5] + (hp[5] - h[5]) * m1v.y;                       \
      float o6 = h[6] + (hp[6] - h[6]) * m1v.z, o7 = h[7] + (hp[7] - h[7]) * m1v.w;                       \
      v.x = pack2(o0, o1); v.y = pack2(o2, o3); v.z = pack2(o4, o5); v.w = pack2(o6, o7);                 \
    }                                                                                                     \
    *(uint4*)(As_ + (lrow + 64 * (i_)) * 64 + lsw) = v;                                                   \
  }
#define GSTORES(...) GSTORES_(__VA_ARGS__)
#define GSTORES_(a0, a1, a2, a3, p0, p1, p2, p3, b0, b1, bi_, k0_)                      \
  {                                                                                   \
    bf16_t* As_ = As + (bi_) * (384 * 64);                                            \
    bf16_t* Bs_ = As_ + 256 * 64;                                                     \
    GS1(a0, p0, 0, As_, k0_) GS1(a1, p1, 1, As_, k0_) GS1(a2, p2, 2, As_, k0_) GS1(a3, p3, 3, As_, k0_) \
    *(uint4*)(Bs_ + lrow * 64 + lsw) = b0;                                            \
    *(uint4*)(Bs_ + (lrow + 64) * 64 + lsw) = b1;                                     \
  }
#define SET0 xa0, xa1, xa2, xa3, xp0, xp1, xp2, xp3, xb0, xb1
#define SET1 ya0, ya1, ya2, ya3, yp0, yp1, yp2, yp3, yb0, yb1
#define GCOMPUTE(bi_)                                                                                          \
  {                                                                                                            \
    const bf16_t* Ac = As + (bi_) * (384 * 64) + (wm * 64 + r) * 64;                                           \
    const bf16_t* Bc = As + (bi_) * (384 * 64) + 256 * 64 + (wn * 64 + r) * 64;                                \
    bf16x8 af0[4], bf0[4], af1[4], bf1[4];                                                                     \
    _Pragma("unroll") for (int mt = 0; mt < 4; mt++) af0[mt] = *(const bf16x8*)(Ac + mt * 1024 + rsw0);        \
    _Pragma("unroll") for (int nt = 0; nt < 4; nt++) bf0[nt] = *(const bf16x8*)(Bc + nt * 1024 + rsw0);        \
    _Pragma("unroll") for (int mt = 0; mt < 4; mt++) af1[mt] = *(const bf16x8*)(Ac + mt * 1024 + rsw1);        \
    _Pragma("unroll") for (int nt = 0; nt < 4; nt++) bf1[nt] = *(const bf16x8*)(Bc + nt * 1024 + rsw1);        \
    _Pragma("unroll") for (int mt = 0; mt < 4; mt++)                                                           \
      _Pragma("unroll") for (int nt = 0; nt < 4; nt++) acc[mt][nt] = mfma_bf16(af0[mt], bf0[nt], acc[mt][nt]); \
    _Pragma("unroll") for (int mt = 0; mt < 4; mt++)                                                           \
      _Pragma("unroll") for (int nt = 0; nt < 4; nt++) acc[mt][nt] = mfma_bf16(af1[mt], bf1[nt], acc[mt][nt]); \
  }
  const int nk = K >> 6;
  const int lastk = (nk - 1) * 64;
  GLOADS(SET0, 0);
  GSTORES(SET0, 0, 0);
  { const int kk1 = min(64, lastk); GLOADS(SET0, kk1); }
  __syncthreads();
  for (int it = 0; it < nk; it += 2) {
    if (it + 1 < nk) {
      const int ka = (it + 1) * 64, kb2 = min((it + 2) * 64, lastk);
      GSTORES(SET0, 1, ka);
      GLOADS(SET0, kb2);
    }
    GCOMPUTE(0);
    __syncthreads();
    if (it + 1 < nk) {
      const int ka = min((it + 2) * 64, lastk), kb2 = min((it + 3) * 64, lastk);
      GSTORES(SET0, 0, ka);
      GLOADS(SET0, kb2);
      GCOMPUTE(1);
      __syncthreads();
    }
  }
  epi(acc, m0 + wm * 64, n0 + wn * 64);
  if constexpr (!__is_same(EpiS, int)) {
    float* Cs = (float*)smem;
#pragma unroll
    for (int mt = 0; mt < 4; mt++)
#pragma unroll
      for (int nt = 0; nt < 4; nt++)
#pragma unroll
        for (int i = 0; i < 4; i++) Cs[(wm * 64 + mt * 16 + quad * 4 + i) * 132 + wn * 64 + nt * 16 + r] = acc[mt][nt][i];
    __syncthreads();
    epiS(Cs, m0, n0, tid);
    __syncthreads();
  }
}
#define STAGE_LOOP8(row, c8, va, vb)                        \
  for (int e_ = tid; e_ < 256 * 16; e_ += NTHR) {           \
    const int row = e_ >> 4, c8 = (e_ & 15) * 8;            \
    const float4 va = *(const float4*)(Cs + row * 132 + c8); \
    const float4 vb = *(const float4*)(Cs + row * 132 + c8 + 4);
#define STAGE_LOOP4(row, c4, va)                            \
  for (int e_ = tid; e_ < 256 * 32; e_ += NTHR) {           \
    const int row = e_ >> 5, c4 = (e_ & 31) * 4;            \
    const float4 va = *(const float4*)(Cs + row * 132 + c4);
#define STAGE_END }
__device__ __forceinline__ uint4 pack8(float4 a, float4 b) {
  uint4 u;
  u.x = pack2(a.x, a.y); u.y = pack2(a.z, a.w); u.z = pack2(b.x, b.y); u.w = pack2(b.z, b.w);
  return u;
}

__device__ __forceinline__ int g8_lds_byte(int r, int c) {
  int st = (r >> 4) * 2 + (c >> 5), rr = r & 15, cc = c & 31, ob = rr * 64 + cc * 2;
  return st * 1024 + (ob ^ (((ob >> 9) & 1) << 5));
}
__device__ __forceinline__ void g8_stage_rc(int b, int& R, int& C) {
  int st = b / 1024, sb = b % 1024, swz = sb ^ (((sb >> 9) & 1) << 5);
  R = (st >> 1) * 16 + swz / 64;
  C = (st & 1) * 32 + (swz % 64) / 2;
}
template <class EpiS>
__device__ __forceinline__ void gemm256_tile(const bf16_t* __restrict__ A, int lda, const bf16_t* __restrict__ Bt, int ldb, int K,
                                             int brow, int bcol, char* smem, EpiS epiS) {
  constexpr int G8_HT = 128 * 64;
  bf16_t* shm = (bf16_t*)smem;
  typedef __attribute__((address_space(1))) const void* gptr_t;
  typedef __attribute__((address_space(3))) void* lptr_t;
  const int tid = get_tid();
  const int wid = tid >> 6, lane = tid & 63, wr = wid >> 2, wc = wid & 3, fr = lane & 15, fq = lane >> 4;
  unsigned oa0, oa1, ob0, ob1;
  {
    int sr0, sc0, sr1, sc1;
    g8_stage_rc(tid * 16, sr0, sc0);
    g8_stage_rc(tid * 16 + 8192, sr1, sc1);
    oa0 = (unsigned)(sr0 * lda + sc0); oa1 = (unsigned)(sr1 * lda + sc1);
    ob0 = (unsigned)(sr0 * ldb + sc0); ob1 = (unsigned)(sr1 * ldb + sc1);
  }
#define G8_SA(b, h) (shm + ((b) * 2 + (h)) * G8_HT)
#define G8_SB(b, h) (shm + (4 + (b) * 2 + (h)) * G8_HT)
#define G8_STAGE(P, BASE, LD, br, kt, O0, O1)                                                                      \
  do {                                                                                                             \
    const bf16_t* g_ = (BASE) + (size_t)(br) * (LD) + (size_t)(kt) * 64;                                           \
    __builtin_amdgcn_global_load_lds((gptr_t)(g_ + O0), (lptr_t)((char*)(P) + tid * 16), 16, 0, 0);               \
    __builtin_amdgcn_global_load_lds((gptr_t)(g_ + O1), (lptr_t)((char*)(P) + tid * 16 + 8192), 16, 0, 0);        \
  } while (0)
#define G8_LDA(dst, b, h)                                                                                          \
  _Pragma("unroll") for (int m = 0; m < 4; ++m) _Pragma("unroll") for (int k = 0; k < 2; ++k)                      \
    dst[m][k] = *reinterpret_cast<const bf16x8*>((char*)G8_SA(b, h) + g8_lds_byte(wr * 64 + m * 16 + fr, k * 32 + fq * 8))
#define G8_LDB(dst, b, h)                                                                                          \
  _Pragma("unroll") for (int n = 0; n < 2; ++n) _Pragma("unroll") for (int k = 0; k < 2; ++k)                      \
    dst[n][k] = *reinterpret_cast<const bf16x8*>((char*)G8_SB(b, h) + g8_lds_byte(wc * 32 + n * 16 + fr, k * 32 + fq * 8))
#define G8_MMA(ai, bj, At_, Bt_)                                                                                   \
  do {                                                                                                             \
    __builtin_amdgcn_s_setprio(1);                                                                                 \
    _Pragma("unroll") for (int m = 0; m < 4; ++m) _Pragma("unroll") for (int n = 0; n < 2; ++n)                    \
      _Pragma("unroll") for (int k = 0; k < 2; ++k)                                                                \
        acc[ai][bj][m][n] = __builtin_amdgcn_mfma_f32_16x16x32_bf16(At_[m][k], Bt_[n][k], acc[ai][bj][m][n], 0, 0, 0); \
    __builtin_amdgcn_s_setprio(0);                                                                                 \
  } while (0)
#define G8_WAIT_V(n) asm volatile("s_waitcnt vmcnt(" #n ")" ::: "memory")
#define G8_WAIT_L(n) asm volatile("s_waitcnt lgkmcnt(" #n ")" ::: "memory")
#define G8_BAR __builtin_amdgcn_s_barrier()
#define G8_SCHED __builtin_amdgcn_sched_barrier(0)
  f32x4 acc[2][2][4][2];
#pragma unroll
  for (int a_ = 0; a_ < 2; a_++)
#pragma unroll
    for (int b_ = 0; b_ < 2; b_++)
#pragma unroll
      for (int m = 0; m < 4; m++)
#pragma unroll
        for (int n = 0; n < 2; n++) acc[a_][b_][m][n] = f32x4{0.f, 0.f, 0.f, 0.f};
  bf16x8 At[4][2], B0[2][2], B1[2][2];
  const int nt = K / 64;
  __syncthreads();
  G8_STAGE(G8_SB(0, 0), Bt, ldb, bcol, 0, ob0, ob1); G8_STAGE(G8_SA(0, 0), A, lda, brow, 0, oa0, oa1);
  G8_STAGE(G8_SB(0, 1), Bt, ldb, bcol + 128, 0, ob0, ob1); G8_STAGE(G8_SA(0, 1), A, lda, brow + 128, 0, oa0, oa1);
  if (wr == 1) G8_BAR;
  G8_WAIT_V(4); G8_BAR;
  G8_STAGE(G8_SB(1, 0), Bt, ldb, bcol, 1, ob0, ob1); G8_STAGE(G8_SA(1, 0), A, lda, brow, 1, oa0, oa1); G8_STAGE(G8_SB(1, 1), Bt, ldb, bcol + 128, 1, ob0, ob1);
  G8_WAIT_V(6); G8_BAR;
  for (int t = 0; t < nt - 2; t += 2) {
    G8_LDB(B0, 0, 0); G8_SCHED; G8_LDA(At, 0, 0); G8_STAGE(G8_SA(1, 1), A, lda, brow + 128, t + 1, oa0, oa1);
    G8_WAIT_L(8); G8_BAR; G8_WAIT_L(0); G8_MMA(0, 0, At, B0); G8_BAR; G8_SCHED;
    G8_LDB(B1, 0, 1); G8_STAGE(G8_SB(0, 0), Bt, ldb, bcol, t + 2, ob0, ob1);
    G8_BAR; G8_WAIT_L(0); G8_MMA(0, 1, At, B1); G8_BAR;
    G8_LDA(At, 0, 1); G8_STAGE(G8_SA(0, 0), A, lda, brow, t + 2, oa0, oa1);
    G8_BAR; G8_WAIT_L(0); G8_MMA(1, 0, At, B0); G8_BAR; G8_SCHED;
    G8_STAGE(G8_SB(0, 1), Bt, ldb, bcol + 128, t + 2, ob0, ob1);
    G8_WAIT_V(6); G8_BAR; G8_MMA(1, 1, At, B1); G8_BAR;
    G8_LDB(B0, 1, 0); G8_SCHED; G8_LDA(At, 1, 0); G8_STAGE(G8_SA(0, 1), A, lda, brow + 128, t + 2, oa0, oa1);
    G8_WAIT_L(8); G8_BAR; G8_WAIT_L(0); G8_MMA(0, 0, At, B0); G8_BAR; G8_SCHED;
    G8_LDB(B1, 1, 1); G8_STAGE(G8_SB(1, 0), Bt, ldb, bcol, t + 3, ob0, ob1);
    G8_BAR; G8_WAIT_L(0); G8_MMA(0, 1, At, B1); G8_BAR;
    G8_LDA(At, 1, 1); G8_STAGE(G8_SA(1, 0), A, lda, brow, t + 3, oa0, oa1);
    G8_BAR; G8_WAIT_L(0); G8_MMA(1, 0, At, B0); G8_BAR; G8_SCHED;
    G8_STAGE(G8_SB(1, 1), Bt, ldb, bcol + 128, t + 3, ob0, ob1);
    G8_WAIT_V(6); G8_BAR; G8_MMA(1, 1, At, B1); G8_BAR;
  }
  { G8_LDB(B0, 0, 0); G8_LDA(At, 0, 0); G8_STAGE(G8_SA(1, 1), A, lda, brow + 128, nt - 1, oa0, oa1);
    G8_BAR; G8_WAIT_L(0); G8_MMA(0, 0, At, B0); G8_BAR;
    G8_LDB(B1, 0, 1); G8_BAR; G8_WAIT_L(0); G8_MMA(0, 1, At, B1); G8_BAR;
    G8_LDA(At, 0, 1); G8_WAIT_V(4); G8_BAR; G8_WAIT_L(0); G8_MMA(1, 0, At, B0); G8_MMA(1, 1, At, B1); G8_BAR; }
  { G8_LDB(B0, 1, 0); G8_LDA(At, 1, 0); G8_WAIT_V(2); G8_BAR; G8_WAIT_L(0); G8_MMA(0, 0, At, B0); G8_BAR;
    G8_LDB(B1, 1, 1); G8_WAIT_V(0); G8_BAR; G8_WAIT_L(0); G8_MMA(0, 1, At, B1); G8_BAR;
    G8_LDA(At, 1, 1); G8_BAR; G8_WAIT_L(0); G8_MMA(1, 0, At, B0); G8_MMA(1, 1, At, B1); G8_BAR; }
  if (wr == 0) G8_BAR;
  float* Cs = (float*)smem;
#pragma unroll
  for (int bj = 0; bj < 2; bj++) {
    __syncthreads();
#pragma unroll
    for (int ai = 0; ai < 2; ai++)
#pragma unroll
      for (int m = 0; m < 4; m++)
#pragma unroll
        for (int n = 0; n < 2; n++)
#pragma unroll
          for (int j = 0; j < 4; j++)
            Cs[(ai * 128 + wr * 64 + m * 16 + fq * 4 + j) * 132 + wc * 32 + n * 16 + fr] = acc[ai][bj][m][n][j];
    __syncthreads();
    epiS(Cs, brow, bcol + bj * 128, tid);
  }
  __syncthreads();
}
__device__ __forceinline__ void g8_map(int wgid, int nM, int nN, int& pm, int& pn) {
  const int nwg = nM * nN;
  { int q = nwg / 8, r = nwg % 8, xcd = wgid % 8, off = wgid / 8;
    wgid = (xcd < r ? xcd * (q + 1) : r * (q + 1) + (xcd - r) * q) + off; }
  const int nig = 8 * nN, gid = wgid / nig, fm = gid * 8, gsz = min(nM - fm, 8);
  pm = fm + ((wgid % nig) % gsz);
  pn = (wgid % nig) / gsz;
}

__device__ __forceinline__ float rope_inv(int i) { return exp2f(-(float)i * (13.287712379549449f / 32.f)); }
__device__ __forceinline__ void conv_finish(float4 v0, float4 v1, float s0, float s1, bf16_t* __restrict__ dst, int lddst, int ndst0, int k0,
                                            float* sm) {
  const int tid = get_tid();
  const int kr = tid >> 4, nc = (tid & 15) * 4;
  sm[kr * 65 + nc + 0] = v0.x * s0; sm[kr * 65 + nc + 1] = v0.y * s0; sm[kr * 65 + nc + 2] = v0.z * s0; sm[kr * 65 + nc + 3] = v0.w * s0;
  sm[(kr + 32) * 65 + nc + 0] = v1.x * s1; sm[(kr + 32) * 65 + nc + 1] = v1.y * s1; sm[(kr + 32) * 65 + nc + 2] = v1.z * s1; sm[(kr + 32) * 65 + nc + 3] = v1.w * s1;
  __syncthreads();
  {
    int n = tid >> 3, kc = (tid & 7) * 8;
    float o[8];
#pragma unroll
    for (int j = 0; j < 8; j++) o[j] = sm[(kc + j) * 65 + n];
    uint4 v;
    v.x = pack2(o[0], o[1]); v.y = pack2(o[2], o[3]); v.z = pack2(o[4], o[5]); v.w = pack2(o[6], o[7]);
    *(uint4*)(dst + (size_t)(ndst0 + n) * lddst + k0 + kc) = v;
  }
  __syncthreads();
}

__device__ __forceinline__ void phase0(KP p, float* sm) {
  const int tid = get_tid();
  char* ws = p->ws;
  if (blockIdx.x == 0 && tid < 16) ((unsigned int*)(ws + O_CTR))[tid] = 0u;
  const int NCONV = 9410;
  bool have_prev = false;
  float4 pv0 = float4{0.f, 0.f, 0.f, 0.f}, pv1 = pv0;
  float ps0 = 1.f, ps1 = 1.f;
  bf16_t* pdst = nullptr;
  int plddst = 0, pndst0 = 0, pk0 = 0;
  const int total = 130 + NCONV;
  for (int item = blockIdx.x; item < total; item += gridDim.x) {
    if (item < 96) {
      int l = item / 48, rem = item % 48, cb = rem / 8, ks = rem % 8;
      int c4 = (tid & 255) * 4, rh = tid >> 8;
      const float* W = p->in[3] + (size_t)l * 2048 * 6144 + cb * 1024 + c4;
      const float* c = p->in[1];
      float4 a = float4{0.f, 0.f, 0.f, 0.f};
      int rbase = ks * 256 + rh * 128;
#pragma unroll 4
      for (int i = 0; i < 128; i++) {
        int row = rbase + i;
        float sc = siluf(c[row]);
        float4 w = ld_nt4(W + (size_t)row * 6144);
        a.x += sc * w.x; a.y += sc * w.y; a.z += sc * w.z; a.w += sc * w.w;
      }
      if (rh == 1) { sm[c4] = a.x; sm[c4 + 1] = a.y; sm[c4 + 2] = a.z; sm[c4 + 3] = a.w; }
      __syncthreads();
      if (rh == 0) {
        a.x += sm[c4]; a.y += sm[c4 + 1]; a.z += sm[c4 + 2]; a.w += sm[c4 + 3];
        float* dst = (float*)(ws + O_MODP) + (size_t)(ks * 2 + l) * 6144 + cb * 1024 + c4;
        *(float4*)dst = a;
      }
      __syncthreads();
    } else if (item < 98) {
      int ty = item - 96;
      const float* pe = p->in[ty ? 12 : 8];
      const float* w1 = p->in[ty ? 13 : 9];
      const float* b1 = p->in[ty ? 14 : 10];
      int e = tid & 63, part = tid >> 6;
      float a = 0.f;
      for (int i = 0; i < 256; i++) { int k = part * 256 + i; a += pe[k] * w1[(size_t)k * 64 + e]; }
      sm[part * 64 + e] = a;
      __syncthreads();
      if (tid < 64) {
        float s = b1[tid];
        for (int q = 0; q < 8; q++) s += sm[q * 64 + tid];
        ((float*)(ws + O_CPE))[ty * 64 + tid] = s;
      }
      __syncthreads();
    } else if (item < 130) {
      float* rope = (float*)(ws + O_ROPE);
      const int base = (item - 98) * 8192;
      for (int e = tid; e < 8192; e += NTHR) {
        const int idx = base + e, t = idx >> 5, ii = idx & 31;
        float sn, cs;
        sincosf((float)t * rope_inv(ii), &sn, &cs);
        *(float2*)(rope + (size_t)idx * 2) = float2{cs, sn};
      }
    } else {
      int ci = item - 130;
      const float* src; int ldsrc, Kvalid, ktiles; bf16_t* dst; int lddst; const float* scale = nullptr;
      int kt, nt, nsrc0, nvalid = 64, ndst0;
      if (ci < 2496) {
        src = p->in[6]; ldsrc = 4976; Kvalid = 2048; ktiles = 32; dst = (bf16_t*)(ws + O_WT_IN); lddst = 2048;
        kt = ci % 32; nt = ci / 32;
        int my = nt * 64;
        ndst0 = my;
        if (my < 1792) nsrc0 = my;
        else if (my < 3840) nsrc0 = my + 48;
        else if (my < 4864) nsrc0 = my + 112;
        else if (my < 4928) nsrc0 = my - 976;
        else { nsrc0 = 1792; nvalid = 48; }
      } else {
        ci -= 2496;
        int mid;
        if (ci < 1024) { mid = 1; }
        else if (ci < 1024 + 192) { mid = 2; ci -= 1024; }
        else if (ci < 1024 + 192 + 256) { mid = 3; ci -= 1216; }
        else if (ci < 1472 + 5120) { ci -= 1472; mid = 4 + ci / 1024; ci %= 1024; }
        else if (ci < 6592 + 128) { ci -= 6592; mid = 9 + ci / 64; ci %= 64; }
        else if (ci < 6720 + 128) { ci -= 6720; mid = 11 + ci / 64; ci %= 64; }
        else if (ci < 6848 + 64) { ci -= 6848; mid = 13 + ci / 32; ci %= 32; }
        else { ci -= 6912; mid = 15 + ci; ci = 0; }
        switch (mid) {
          case 1: src = p->in[7]; ldsrc = 2048; Kvalid = 2048; ktiles = 32; dst = (bf16_t*)(ws + O_WT_OUT); lddst = 2048; break;
          case 2: src = p->in[17]; ldsrc = 1536; Kvalid = 512; ktiles = 8; dst = (bf16_t*)(ws + O_WT_QB); lddst = 512; scale = p->in[16]; break;
          case 3: src = p->in[19]; ldsrc = 2048; Kvalid = 512; ktiles = 8; dst = (bf16_t*)(ws + O_WT_KVB); lddst = 512; scale = p->in[18]; break;
          case 4: src = p->in[21]; ldsrc = 2048; Kvalid = 2048; ktiles = 32; dst = (bf16_t*)(ws + O_WT_R); lddst = 2048; break;
          case 5: src = p->in[22]; ldsrc = 2048; Kvalid = 2048; ktiles = 32; dst = (bf16_t*)(ws + O_WT_K); lddst = 2048; break;
          case 6: src = p->in[23]; ldsrc = 2048; Kvalid = 2048; ktiles = 32; dst = (bf16_t*)(ws + O_WT_V); lddst = 2048; break;
          case 7: src = p->in[24]; ldsrc = 2048; Kvalid = 2048; ktiles = 32; dst = (bf16_t*)(ws + O_WT_Z); lddst = 2048; break;
          case 8: src = p->in[25]; ldsrc = 2048; Kvalid = 2048; ktiles = 32; dst = (bf16_t*)(ws + O_WT_O); lddst = 2048; break;
          case 9: src = p->in[27]; ldsrc = 96; Kvalid = 2048; ktiles = 32; dst = (bf16_t*)(ws + O_WT_W1); lddst = 2048; break;
          case 10: src = p->in[30]; ldsrc = 96; Kvalid = 2048; ktiles = 32; dst = (bf16_t*)(ws + O_WT_A1); lddst = 2048; break;
          case 11: src = p->in[28]; ldsrc = 2048; Kvalid = 96; ktiles = 2; dst = (bf16_t*)(ws + O_WT_W2); lddst = 128; break;
          case 12: src = p->in[31]; ldsrc = 2048; Kvalid = 96; ktiles = 2; dst = (bf16_t*)(ws + O_WT_A2); lddst = 128; break;
          case 13: src = p->in[9]; ldsrc = 64; Kvalid = 2048; ktiles = 32; dst = (bf16_t*)(ws + O_W1T); lddst = 2048; break;
          case 14: src = p->in[13]; ldsrc = 64; Kvalid = 2048; ktiles = 32; dst = (bf16_t*)(ws + O_W1T) + 64 * 2048; lddst = 2048; break;
          case 15: src = p->in[11]; ldsrc = 64; Kvalid = 64; ktiles = 1; dst = (bf16_t*)(ws + O_W2T); lddst = 64; break;
          default: src = p->in[15]; ldsrc = 64; Kvalid = 64; ktiles = 1; dst = (bf16_t*)(ws + O_W2T) + 64 * 64; lddst = 64; break;
        }
        kt = ci % ktiles; nt = ci / ktiles;
        nsrc0 = nt * 64; ndst0 = nt * 64;
        if (mid == 9 || mid == 10) { if (nt == 1) nvalid = 32; }
      }
      const int k0 = kt * 64;
      const int kr = tid >> 4, nc = (tid & 15) * 4;
      float4 v0 = float4{0.f, 0.f, 0.f, 0.f}, v1 = v0;
      float s0 = 1.f, s1 = 1.f;
      if (k0 + kr < Kvalid && nc < nvalid) {
        v0 = ld_nt4(src + (size_t)(k0 + kr) * ldsrc + nsrc0 + nc);
        if (scale) s0 = scale[k0 + kr];
      }
      if (k0 + kr + 32 < Kvalid && nc < nvalid) {
        v1 = ld_nt4(src + (size_t)(k0 + kr + 32) * ldsrc + nsrc0 + nc);
        if (scale) s1 = scale[k0 + kr + 32];
      }
      if (have_prev) conv_finish(pv0, pv1, ps0, ps1, pdst, plddst, pndst0, pk0, sm);
      pv0 = v0; pv1 = v1; ps0 = s0; ps1 = s1; pdst = dst; plddst = lddst; pndst0 = ndst0; pk0 = k0;
      have_prev = true;
    }
  }
  if (have_prev) conv_finish(pv0, pv1, ps0, ps1, pdst, plddst, pndst0, pk0, sm);
}

__device__ __forceinline__ void norm_phase(KP p, int layer, const float* __restrict__ xsrc, bf16_t* __restrict__ hdst, float* sm) {
  const int tid = get_tid(), lane = tid & 63, wave = tid >> 6;
  const float* modp = (const float*)(p->ws + O_MODP);
  const float* ada_b = p->in[4];
  const float* g = p->in[2] + layer * 2048;
  for (int col = tid; col < 2048; col += NTHR) {
    float sh = ada_b[layer * 6144 + col], sc = ada_b[layer * 6144 + 2048 + col];
    for (int ks = 0; ks < 8; ks++) {
      sh += modp[(size_t)(ks * 2 + layer) * 6144 + col];
      sc += modp[(size_t)(ks * 2 + layer) * 6144 + 2048 + col];
    }
    sm[col] = g[col] * (1.f + sc);
    sm[2048 + col] = sh;
  }
  if (layer == 0 && blockIdx.x == 0) {
    float* mod = (float*)(p->ws + O_MOD);
    for (int i = tid; i < 12288; i += NTHR) {
      int l = i / 6144, col = i % 6144;
      float v = ada_b[i];
      for (int ks = 0; ks < 8; ks++) v += modp[(size_t)(ks * 2 + l) * 6144 + col];
      mod[i] = v;
    }
  }
  __syncthreads();
  for (int row = blockIdx.x * 8 + wave; row < S_; row += gridDim.x * 8) {
    const float* xr = xsrc + (size_t)row * 2048;
    float4 v[8];
    float ss = 0.f;
#pragma unroll
    for (int j = 0; j < 8; j++) {
      v[j] = *(const float4*)(xr + lane * 4 + 256 * j);
      ss += v[j].x * v[j].x + v[j].y * v[j].y + v[j].z * v[j].z + v[j].w * v[j].w;
    }
    ss = wave_sum(ss);
    float rstd = rsqrtf(ss * (1.f / 2048.f) + 1e-6f);
#pragma unroll
    for (int j = 0; j < 8; j++) {
      int col = lane * 4 + 256 * j;
      float o0 = v[j].x * rstd * sm[col] + sm[2048 + col];
      float o1 = v[j].y * rstd * sm[col + 1] + sm[2048 + col + 1];
      float o2 = v[j].z * rstd * sm[col + 2] + sm[2048 + col + 2];
      float o3 = v[j].w * rstd * sm[col + 3] + sm[2048 + col + 3];
      uint2 o;
      o.x = pack2(o0, o1); o.y = pack2(o2, o3);
      *(uint2*)(hdst + (size_t)row * 2048 + col) = o;
    }
  }
}

__device__ __forceinline__ void norm_shift_phase(KP p, float* sm) {
  const int tid = get_tid(), lane = tid & 63, wave = tid >> 6;
  const int layer = 1;
  char* ws = p->ws;
  const float* modp = (const float*)(ws + O_MODP);
  const float* ada_b = p->in[4];
  const float* g = p->in[2] + layer * 2048;
  const float* mu = p->in[20];
  const float* xsrc = p->out;
  for (int col = tid; col < 2048; col += NTHR) {
    float sh = ada_b[layer * 6144 + col], sc = ada_b[layer * 6144 + 2048 + col];
    for (int ks = 0; ks < 8; ks++) {
      sh += modp[(size_t)(ks * 2 + layer) * 6144 + col];
      sc += modp[(size_t)(ks * 2 + layer) * 6144 + 2048 + col];
    }
    sm[col] = g[col] * (1.f + sc);
    sm[2048 + col] = sh;
  }
  __syncthreads();
  bf16_t* dst0 = (bf16_t*)(ws + O_H1);
  bf16_t* dst1 = (bf16_t*)(ws + O_XW);
  bf16_t* dst2 = (bf16_t*)(ws + O_XK);
  bf16_t* dst3 = (bf16_t*)(ws + O_XV);
  bf16_t* dst4 = (bf16_t*)(ws + O_XA);
  bf16_t* dst5 = (bf16_t*)(ws + O_XZ);
  for (int row = blockIdx.x * 8 + wave; row < S_; row += gridDim.x * 8) {
    const float* xr = xsrc + (size_t)row * 2048;
    float4 v[8], vp[8];
    float ss = 0.f, sp = 0.f;
#pragma unroll
    for (int j = 0; j < 8; j++) {
      v[j] = *(const float4*)(xr + lane * 4 + 256 * j);
      ss += v[j].x * v[j].x + v[j].y * v[j].y + v[j].z * v[j].z + v[j].w * v[j].w;
      if (row > 0) vp[j] = *(const float4*)(xr - 2048 + lane * 4 + 256 * j);
      else vp[j] = float4{0.f, 0.f, 0.f, 0.f};
      sp += vp[j].x * vp[j].x + vp[j].y * vp[j].y + vp[j].z * vp[j].z + vp[j].w * vp[j].w;
    }
    ss = wave_sum(ss);
    sp = wave_sum(sp);
    const float rstd = rsqrtf(ss * (1.f / 2048.f) + 1e-6f);
    const float rstdp = rsqrtf(sp * (1.f / 2048.f) + 1e-6f);
#pragma unroll
    for (int j = 0; j < 8; j++) {
      const int col = lane * 4 + 256 * j;
      float h[4], hp[4];
      h[0] = v[j].x * rstd * sm[col] + sm[2048 + col];
      h[1] = v[j].y * rstd * sm[col + 1] + sm[2048 + col + 1];
      h[2] = v[j].z * rstd * sm[col + 2] + sm[2048 + col + 2];
      h[3] = v[j].w * rstd * sm[col + 3] + sm[2048 + col + 3];
      if (row > 0) {
        hp[0] = vp[j].x * rstdp * sm[col] + sm[2048 + col];
        hp[1] = vp[j].y * rstdp * sm[col + 1] + sm[2048 + col + 1];
        hp[2] = vp[j].z * rstdp * sm[col + 2] + sm[2048 + col + 2];
        hp[3] = vp[j].w * rstdp * sm[col + 3] + sm[2048 + col + 3];
      } else { hp[0] = hp[1] = hp[2] = hp[3] = 0.f; }
      const unsigned ob = ((unsigned)row * 2048u + (unsigned)col) * 2u;
#define MIXOUT(dst_, mi_)                                                              \
      {                                                                                \
        const float4 m4 = *(const float4*)(mu + (mi_) * 2048 + col);                   \
        uint2 u;                                                                       \
        u.x = pack2(h[0] + (hp[0] - h[0]) * m4.x, h[1] + (hp[1] - h[1]) * m4.y);       \
        u.y = pack2(h[2] + (hp[2] - h[2]) * m4.z, h[3] + (hp[3] - h[3]) * m4.w);       \
        *(uint2*)((char*)dst_ + ob) = u;                                               \
      }
      MIXOUT(dst0, 0) MIXOUT(dst1, 1) MIXOUT(dst2, 2) MIXOUT(dst3, 3) MIXOUT(dst4, 4) MIXOUT(dst5, 5)
    }
  }
}

__device__ __forceinline__ float4 silu4(float4 v) { return float4{siluf(v.x), siluf(v.y), siluf(v.z), siluf(v.w)}; }
__device__ __forceinline__ float4 sigm4(float4 v) { return float4{sigmf(v.x), sigmf(v.y), sigmf(v.z), sigmf(v.w)}; }
__device__ __forceinline__ void phase2(KP p, char* smem) {
  char* ws = p->ws;
  const bf16_t* A = (const bf16_t*)(ws + O_H0);
  const bf16_t* Bt = (const bf16_t*)(ws + O_WT_IN);
  const int lane = get_tid() & 63, r = lane & 15, quad = lane >> 4;
  bf16_t* qn = (bf16_t*)(ws + O_QN);
  bf16_t* zn = (bf16_t*)(ws + O_ZN);
  bf16_t* zm = (bf16_t*)(ws + O_ZM);
  bf16_t* qa = (bf16_t*)(ws + O_QA);
  bf16_t* ckv = (bf16_t*)(ws + O_CKV);
  float* kpe = (float*)(ws + O_KPE);
  float* gates = (float*)(ws + O_GATES);
  auto epiD = [&](f32x4(&acc)[4][4], int row0, int col0) {
    if (col0 < 1024 || col0 >= 1792) return;
    const int idx = (col0 - 1024) >> 7;
    if (idx != 3 && idx != 5) return;
#pragma unroll
    for (int nt = 0; nt < 4; nt++) {
      const int cc = col0 + nt * 16 + r - 1024, g = (cc >> 6) & 1, d = cc & 63;
#pragma unroll
      for (int mt = 0; mt < 4; mt++) {
        const int rw = row0 + mt * 16 + quad * 4;
        const f32x4 v = acc[mt][nt];
        bf16_t* dst = (bf16_t*)(ws + (idx == 3 ? O_VST : O_VWT)) + (((size_t)g * 256 + (rw >> 5)) * 64 + d) * 32 + (rw & 31);
        uint2 o; o.x = pack2(v[0], v[1]); o.y = pack2(v[2], v[3]);
        *(uint2*)dst = o;
      }
    }
  };
  auto epiS = [&](const float* Cs, int m0, int n0, int tid) {
    STAGE_LOOP8(row, c8, va, vb)
      const int c = n0 + c8;
      const size_t t = (size_t)(m0 + row);
      if (c < 1024) {
        *(uint4*)(qn + t * 1024 + c) = pack8(va, vb);
      } else if (c < 1792) {
        const int cc = c - 1024, idx = cc >> 7, g = (cc >> 6) & 1, d = cc & 63;
        if (idx != 3 && idx != 5) {
          const size_t off = idx == 0 ? O_KC : idx == 1 ? O_VC : idx == 2 ? O_KS : O_KW;
          *(uint4*)((bf16_t*)(ws + off) + ((size_t)g * S_ + t) * 64 + d) = pack8(va, vb);
        }
      } else if (c < 2816) {
        *(uint4*)(zn + t * 1024 + (c - 1792)) = pack8(silu4(va), silu4(vb));
      } else if (c < 3328) {
        *(uint4*)(qa + t * 512 + (c - 2816)) = pack8(va, vb);
      } else if (c < 3840) {
        *(uint4*)(ckv + t * 512 + (c - 3328)) = pack8(va, vb);
      } else if (c < 4864) {
        *(uint4*)(zm + t * 1024 + (c - 3840)) = pack8(silu4(va), silu4(vb));
      } else if (c < 4928) {
        *(float4*)(kpe + t * 64 + (c - 4864)) = va;
        *(float4*)(kpe + t * 64 + (c - 4864) + 4) = vb;
      } else if (c < 4976) {
        *(float4*)(gates + t * 48 + (c - 4928)) = sigm4(va);
        *(float4*)(gates + t * 48 + (c - 4928) + 4) = sigm4(vb);
      }
    STAGE_END
  };
  auto epiS2 = [&](const float* Cs, int m0, int n0, int tid) {
    if (n0 == 1408 || n0 == 1664) {
      bf16_t* vb_ = (bf16_t*)(ws + (n0 == 1408 ? O_VST : O_VWT));
      for (int e_ = tid; e_ < 128 * 32; e_ += NTHR) {
        const int col = e_ & 127, rg = e_ >> 7;
        float f[8];
#pragma unroll
        for (int j = 0; j < 8; j++) f[j] = Cs[(rg * 8 + j) * 132 + col];
        const int t = m0 + rg * 8, g = col >> 6, d = col & 63;
        uint4 u;
        u.x = pack2(f[0], f[1]); u.y = pack2(f[2], f[3]); u.z = pack2(f[4], f[5]); u.w = pack2(f[6], f[7]);
        *(uint4*)(vb_ + (((size_t)g * 256 + (t >> 5)) * 64 + d) * 32 + (t & 31)) = u;
      }
    } else {
      epiS(Cs, m0, n0, tid);
    }
  };
  auto epiNone = [&](f32x4(&acc)[4][4], int row0, int col0) {};
  (void)epiD;
  const int nbig = 32 * 16, nsmall = 32 * 7;
  for (int t = blockIdx.x; t < nbig + nsmall; t += gridDim.x) {
    if (t < nbig) {
      int pm, pn;
      g8_map(t, 32, 16, pm, pn);
      gemm256_tile(A, 2048, Bt, 2048, 2048, pm * 256, pn * 256, smem, epiS2);
    } else {
      const int u = t - nbig;
      const int mt = u & 31, nt = 32 + (u >> 5);
      gemm_tile<0>(A, 2048, Bt, 2048, 2048, mt * 256, nt * 128, smem, nullptr, epiNone, epiS);
    }
  }
}


__device__ __forceinline__ void phase3(KP p, char* smem) {
  char* ws = p->ws;
  float* rstd_s = (float*)(smem + 136 * 1024);
  const float* rope = (const float*)(ws + O_ROPE);
  auto epiNone = [&](f32x4(&acc)[4][4], int row0, int col0) {};
  const int total = 8 + 192 + 256 + 32;
  for (int item = blockIdx.x; item < total; item += gridDim.x) {
    if (item < 8) {
      int prob = item >> 1, mtile = item & 1;
      int ty = prob >> 1, g = prob & 1;
      const bf16_t* A = (const bf16_t*)(ws + (ty ? O_VC : O_KC)) + (size_t)g * S_ * 64;
      const bf16_t* Bt = (const bf16_t*)(ws + O_W1T);
      bf16_t* hid = (bf16_t*)(ws + O_HID) + (size_t)prob * 512 * 64;
      const float* cpe = (const float*)(ws + O_CPE) + ty * 64;
      auto epi1 = [&](f32x4(&acc)[4][4], int row0, int col0) {
        if ((col0 >> 6) != ty) return;
        const int lane = get_tid() & 63, r = lane & 15, quad = lane >> 4;
#pragma unroll
        for (int nt = 0; nt < 4; nt++) {
          int e = nt * 16 + r;
          float b = cpe[e];
#pragma unroll
          for (int mt = 0; mt < 4; mt++) {
            int rw = row0 + mt * 16 + quad * 4;
#pragma unroll
            for (int i = 0; i < 4; i++) hid[(size_t)(rw + i) * 64 + e] = f2bf(siluf(acc[mt][nt][i] + b));
          }
        }
      };
      gemm_tile<0>(A, 1024, Bt, 2048, 2048, mtile * 256, 0, smem, nullptr, epi1);
      __threadfence();
      __syncthreads();
      bf16_t* kcmp = (bf16_t*)(ws + O_KCMP) + (size_t)g * 512 * 64;
      bf16_t* vcmpT = (bf16_t*)(ws + O_VCMPT) + (size_t)g * 64 * 512;
      auto epi2 = [&](f32x4(&acc)[4][4], int row0, int col0) {
        if ((col0 >> 6) != ty) return;
        const int lane = get_tid() & 63, r = lane & 15, quad = lane >> 4;
#pragma unroll
        for (int nt = 0; nt < 4; nt++) {
          int d = nt * 16 + r;
#pragma unroll
          for (int mt = 0; mt < 4; mt++) {
            int rw = row0 + mt * 16 + quad * 4;
            f32x4 v = acc[mt][nt];
#pragma unroll
            for (int i = 0; i < 4; i++) if (rw + i >= 511) v[i] = 0.f;
            if (ty == 0) {
#pragma unroll
              for (int i = 0; i < 4; i++) kcmp[(size_t)(rw + i) * 64 + d] = f2bf(v[i]);
            } else {
              uint2 o; o.x = pack2(v[0], v[1]); o.y = pack2(v[2], v[3]);
              *(uint2*)(vcmpT + ((size_t)(rw >> 5) * 64 + d) * 32 + (rw & 31)) = o;
            }
          }
        }
      };
      gemm_tile<0>(hid, 64, (const bf16_t*)(ws + O_W2T), 64, 64, mtile * 256, 0, smem, nullptr, epi2);
    } else if (item < 8 + 192 + 256) {
      int it = item - 8;
      bool isq = it < 192;
      if (!isq) it -= 192;
      int mt_, nt_;
      g8_map(it, 32, isq ? 6 : 8, mt_, nt_);
      const bf16_t* A = (const bf16_t*)(ws + (isq ? O_QA : O_CKV));
      __syncthreads();
      {
        const int tid = get_tid();
        int row = tid >> 1, hf = tid & 1;
        const bf16_t* ap = A + (size_t)(mt_ * 256 + row) * 512 + hf * 256;
        float ss = 0.f;
#pragma unroll 4
        for (int j = 0; j < 32; j++) {
          float f[8];
          unpack8(*(const uint4*)(ap + j * 8), f);
#pragma unroll
          for (int q = 0; q < 8; q++) ss += f[q] * f[q];
        }
        ss += __shfl_xor(ss, 1);
        if (hf == 0) rstd_s[row] = rsqrtf(ss * (1.f / 512.f) + 1e-6f);
      }
      __syncthreads();
      if (isq) {
        bf16_t* qm = (bf16_t*)(ws + O_QM);
        auto epiS = [&](const float* Cs, int m0, int n0, int tid) {
          STAGE_LOOP8(row, c8, va, vb)
            const int c = n0 + c8, hd = c / 192, dd = c - hd * 192;
            const int t = m0 + row;
            const float rs = rstd_s[row];
            bf16_t* dst = qm + ((size_t)hd * S_ + t) * 192;
            if (dd < 128) {
              float4 a = va, b = vb;
              a.x *= rs; a.y *= rs; a.z *= rs; a.w *= rs; b.x *= rs; b.y *= rs; b.z *= rs; b.w *= rs;
              *(uint4*)(dst + dd) = pack8(a, b);
            } else if (dd < 160) {
              const int i0 = dd - 128;
              const float4 xa = *(const float4*)(Cs + row * 132 + c8 + 32), xb = *(const float4*)(Cs + row * 132 + c8 + 36);
              const float x1[8] = {va.x * rs, va.y * rs, va.z * rs, va.w * rs, vb.x * rs, vb.y * rs, vb.z * rs, vb.w * rs};
              const float x2[8] = {xa.x * rs, xa.y * rs, xa.z * rs, xa.w * rs, xb.x * rs, xb.y * rs, xb.z * rs, xb.w * rs};
              const float* rp = rope + ((size_t)t * 32 + i0) * 2;
              float o1[8], o2[8];
#pragma unroll
              for (int j = 0; j < 4; j++) {
                const float4 cs = *(const float4*)(rp + 4 * j);
                o1[2 * j] = x1[2 * j] * cs.x - x2[2 * j] * cs.y;
                o2[2 * j] = x1[2 * j] * cs.y + x2[2 * j] * cs.x;
                o1[2 * j + 1] = x1[2 * j + 1] * cs.z - x2[2 * j + 1] * cs.w;
                o2[2 * j + 1] = x1[2 * j + 1] * cs.w + x2[2 * j + 1] * cs.z;
              }
              uint4 u1, u2;
              u1.x = pack2(o1[0], o1[1]); u1.y = pack2(o1[2], o1[3]); u1.z = pack2(o1[4], o1[5]); u1.w = pack2(o1[6], o1[7]);
              u2.x = pack2(o2[0], o2[1]); u2.y = pack2(o2[2], o2[3]); u2.z = pack2(o2[4], o2[5]); u2.w = pack2(o2[6], o2[7]);
              *(uint4*)(dst + 128 + i0) = u1;
              *(uint4*)(dst + 160 + i0) = u2;
            }
          STAGE_END
        };
        gemm256_tile(A, 512, (const bf16_t*)(ws + O_WT_QB), 512, 512, mt_ * 256, nt_ * 256, smem, epiS);
      } else {
        bf16_t* km = (bf16_t*)(ws + O_KM);
        bf16_t* vmT = (bf16_t*)(ws + O_VMT);
        auto epiD = [&](f32x4(&acc)[4][4], int row0, int col0) {
          const int lane = get_tid() & 63, r = lane & 15, quad = lane >> 4;
          int hd = col0 >> 8, dd0 = col0 & 255;
          if (dd0 < 128) return;
          int lrow0 = row0 - mt_ * 256;
#pragma unroll
          for (int nt = 0; nt < 4; nt++)
#pragma unroll
            for (int mt = 0; mt < 4; mt++) {
              int rl = lrow0 + mt * 16 + quad * 4;
              int t = mt_ * 256 + rl;
              f32x4 v = acc[mt][nt];
#pragma unroll
              for (int i = 0; i < 4; i++) v[i] *= rstd_s[rl + i];
              int d = dd0 - 128 + nt * 16 + r;
              uint2 o; o.x = pack2(v[0], v[1]); o.y = pack2(v[2], v[3]);
              *(uint2*)(vmT + ((size_t)hd * 128 + d) * S_ + t) = o;
            }
        };
        auto epiS = [&](const float* Cs, int m0, int n0, int tid) {
          STAGE_LOOP8(row, c8, va, vb)
            const int c = n0 + c8, hd = c >> 8, dd = c & 255;
            if (dd < 128) {
              const float rs = rstd_s[row];
              float4 a = va, b = vb;
              a.x *= rs; a.y *= rs; a.z *= rs; a.w *= rs; b.x *= rs; b.y *= rs; b.z *= rs; b.w *= rs;
              *(uint4*)(km + ((size_t)hd * S_ + m0 + row) * 192 + dd) = pack8(a, b);
            }
          STAGE_END
        };
        (void)epiD;
        auto epiS2 = [&](const float* Cs, int m0, int n0, int tid) {
          if ((n0 & 255) == 128) {
            const int hd = n0 >> 8;
            for (int e_ = tid; e_ < 128 * 32; e_ += NTHR) {
              const int col = e_ & 127, rg = e_ >> 7;
              float f[8];
#pragma unroll
              for (int j = 0; j < 8; j++) f[j] = Cs[(rg * 8 + j) * 132 + col] * rstd_s[rg * 8 + j];
              uint4 u;
              u.x = pack2(f[0], f[1]); u.y = pack2(f[2], f[3]); u.z = pack2(f[4], f[5]); u.w = pack2(f[6], f[7]);
              *(uint4*)(vmT + ((size_t)hd * 128 + col) * S_ + m0 + rg * 8) = u;
            }
          } else {
            epiS(Cs, m0, n0, tid);
          }
        };
        gemm256_tile(A, 512, (const bf16_t*)(ws + O_WT_KVB), 512, 512, mt_ * 256, nt_ * 256, smem, epiS2);
      }
    } else {
      int it = item - (8 + 192 + 256);
      const float* kpe = (const float*)(ws + O_KPE);
      bf16_t* km = (bf16_t*)(ws + O_KM);
      const int tid = get_tid();
      for (int e = tid; e < 256 * 32; e += NTHR) {
        int t = it * 256 + (e >> 5), ii = e & 31;
        float x1 = kpe[(size_t)t * 64 + ii], x2 = kpe[(size_t)t * 64 + 32 + ii];
        const float2 cs = *(const float2*)(rope + ((size_t)t * 32 + ii) * 2);
        bf16_t o1 = f2bf(x1 * cs.x - x2 * cs.y), o2 = f2bf(x1 * cs.y + x2 * cs.x);
#pragma unroll
        for (int hd = 0; hd < 8; hd++) {
          bf16_t* dst = km + ((size_t)hd * S_ + t) * 192 + 128;
          dst[ii] = o1; dst[32 + ii] = o2;
        }
      }
    }
  }
}

template <int DQK, int NCT>
__device__ __forceinline__ void qk_step(const bf16_t* __restrict__ Kb, int ldk, int kb, const bf16x8 (&qf)[DQK / 32][NCT],
                                        f32x4 (&s)[2][NCT], int r, int quad) {
#pragma unroll
  for (int sub = 0; sub < 2; sub++) {
    const bf16_t* kp = Kb + (size_t)(kb + sub * 16 + r) * ldk + quad * 8;
#pragma unroll
    for (int ct = 0; ct < NCT; ct++) s[sub][ct] = f32x4{0.f, 0.f, 0.f, 0.f};
#pragma unroll
    for (int ks = 0; ks < DQK / 32; ks++) {
      bf16x8 kf = *(const bf16x8*)(kp + ks * 32);
#pragma unroll
      for (int ct = 0; ct < NCT; ct++) s[sub][ct] = mfma_bf16(kf, qf[ks][ct], s[sub][ct]);
    }
  }
}

template <int DV, int NCT>
__device__ __forceinline__ void pv_step(const bf16_t* __restrict__ VT, size_t ldv, int kb, const bf16x8 (&pf)[NCT],
                                        f32x4 (&o)[DV / 16][NCT], int r, int quad) {
#pragma unroll
  for (int dt = 0; dt < DV / 16; dt++) {
    const bf16_t* vp = VT + (size_t)(dt * 16 + r) * ldv + kb + quad * 4;
    uint2 lo = *(const uint2*)vp;
    uint2 hi = *(const uint2*)(vp + 16);
    uint4 u = uint4{lo.x, lo.y, hi.x, hi.y};
    bf16x8 vf = *(bf16x8*)&u;
#pragma unroll
    for (int ct = 0; ct < NCT; ct++) o[dt][ct] = mfma_bf16(vf, pf[ct], o[dt][ct]);
  }
}

template <int DV>
__device__ __forceinline__ bf16x8 softmax_step(float (&sc)[8], unsigned vmask, float& m, float& l, f32x4 (&o)[DV / 16][1]) {
  return bf16x8{};
}

__device__ __forceinline__ float quad_max(float v) {
  v = fmaxf(v, __shfl_xor(v, 16));
  v = fmaxf(v, __shfl_xor(v, 32));
  return v;
}
__device__ __forceinline__ float quad_sum(float v) {
  v += __shfl_xor(v, 16);
  v += __shfl_xor(v, 32);
  return v;
}

#define SOFTMAX_UPDATE(DVT, NCTV, ct, sc, vm, mvar, lvar, oarr, pfout)                                   \
  {                                                                                                      \
    float mx_ = -1e30f;                                                                                  \
    _Pragma("unroll") for (int j_ = 0; j_ < 8; j_++) if ((vm >> j_) & 1) mx_ = fmaxf(mx_, sc[j_]);       \
    mx_ = quad_max(mx_);                                                                                 \
    const float mn_ = fmaxf(mvar, mx_);                                                                  \
    if (__ballot(mn_ > mvar) != 0ull) {                                                                  \
      const float al_ = __builtin_amdgcn_exp2f(mvar - mn_);                                              \
      lvar *= al_;                                                                                       \
      _Pragma("unroll") for (int dt_ = 0; dt_ < DVT / 16; dt_++) {                                       \
        oarr[dt_][ct][0] *= al_; oarr[dt_][ct][1] *= al_; oarr[dt_][ct][2] *= al_; oarr[dt_][ct][3] *= al_; \
      }                                                                                                  \
      mvar = mn_;                                                                                        \
    }                                                                                                    \
    float pp_[8];                                                                                        \
    float ls_ = 0.f;                                                                                     \
    _Pragma("unroll") for (int j_ = 0; j_ < 8; j_++) {                                                   \
      pp_[j_] = ((vm >> j_) & 1) ? __builtin_amdgcn_exp2f(sc[j_] - mn_) : 0.f;                           \
      ls_ += pp_[j_];                                                                                    \
    }                                                                                                    \
    lvar += ls_;                                                                                         \
    uint4 u_;                                                                                            \
    u_.x = pack2(pp_[0], pp_[1]); u_.y = pack2(pp_[2], pp_[3]);                                          \
    u_.z = pack2(pp_[4], pp_[5]); u_.w = pack2(pp_[6], pp_[7]);                                          \
    pfout = *(bf16x8*)&u_;                                                                               \
  }

#define SOFTMAX_UPDATE16(DVT, ct, sc, vm, mvar, lvar, oarr, pfa, pfb)                                    \
  {                                                                                                      \
    float mx_ = -1e30f;                                                                                  \
    _Pragma("unroll") for (int j_ = 0; j_ < 16; j_++) if ((vm >> j_) & 1) mx_ = fmaxf(mx_, sc[j_]);      \
    mx_ = quad_max(mx_);                                                                                 \
    const float mn_ = fmaxf(mvar, mx_);                                                                  \
    if (__ballot(mn_ > mvar) != 0ull) {                                                                  \
      const float al_ = __builtin_amdgcn_exp2f(mvar - mn_);                                              \
      lvar *= al_;                                                                                       \
      _Pragma("unroll") for (int dt_ = 0; dt_ < DVT / 16; dt_++) {                                       \
        oarr[dt_][ct][0] *= al_; oarr[dt_][ct][1] *= al_; oarr[dt_][ct][2] *= al_; oarr[dt_][ct][3] *= al_; \
      }                                                                                                  \
      mvar = mn_;                                                                                        \
    }                                                                                                    \
    float pp_[16];                                                                                       \
    float ls_ = 0.f;                                                                                     \
    _Pragma("unroll") for (int j_ = 0; j_ < 16; j_++) {                                                  \
      pp_[j_] = ((vm >> j_) & 1) ? __builtin_amdgcn_exp2f(sc[j_] - mn_) : 0.f;                           \
      ls_ += pp_[j_];                                                                                    \
    }                                                                                                    \
    lvar += ls_;                                                                                         \
    uint4 ua_, ub_;                                                                                      \
    ua_.x = pack2(pp_[0], pp_[1]); ua_.y = pack2(pp_[2], pp_[3]);                                        \
    ua_.z = pack2(pp_[4], pp_[5]); ua_.w = pack2(pp_[6], pp_[7]);                                        \
    ub_.x = pack2(pp_[8], pp_[9]); ub_.y = pack2(pp_[10], pp_[11]);                                      \
    ub_.z = pack2(pp_[12], pp_[13]); ub_.w = pack2(pp_[14], pp_[15]);                                    \
    pfa = *(bf16x8*)&ua_;                                                                                \
    pfb = *(bf16x8*)&ub_;                                                                                \
  }

struct KF { bf16x8 k[2][2]; };
struct VF { bf16x8 v[4]; };
__device__ __forceinline__ void load_kf(KF& f, const bf16_t* __restrict__ Kb, int kb, int r, int quad) {
#pragma unroll
  for (int sub = 0; sub < 2; sub++)
#pragma unroll
    for (int ks = 0; ks < 2; ks++) f.k[sub][ks] = *(const bf16x8*)(Kb + (size_t)(kb + sub * 16 + r) * 64 + ks * 32 + quad * 8);
}
__device__ __forceinline__ void load_vf(VF& f, const bf16_t* __restrict__ VT, size_t ldv, int kb, int r, int quad) {
  (void)ldv;
  const bf16_t* vb = VT + (size_t)(kb >> 5) * 2048 + r * 32 + quad * 4;
#pragma unroll
  for (int dt = 0; dt < 4; dt++) {
    const bf16_t* vp = vb + dt * 512;
    uint2 lo = *(const uint2*)vp;
    uint2 hi = *(const uint2*)(vp + 16);
    uint4 u = uint4{lo.x, lo.y, hi.x, hi.y};
    f.v[dt] = *(bf16x8*)&u;
  }
}
__device__ __forceinline__ void qk_from(const KF& f, const bf16x8 (&qf)[2][2], f32x4 (&s)[2][2]) {
#pragma unroll
  for (int sub = 0; sub < 2; sub++)
#pragma unroll
    for (int ct = 0; ct < 2; ct++) {
      s[sub][ct] = f32x4{0.f, 0.f, 0.f, 0.f};
#pragma unroll
      for (int ks = 0; ks < 2; ks++) s[sub][ct] = mfma_bf16(f.k[sub][ks], qf[ks][ct], s[sub][ct]);
    }
}
__device__ __forceinline__ void pv_from(const VF& f, const bf16x8 (&pf)[2], f32x4 (&o)[4][2]) {
#pragma unroll
  for (int dt = 0; dt < 4; dt++)
#pragma unroll
    for (int ct = 0; ct < 2; ct++) o[dt][ct] = mfma_bf16(f.v[dt], pf[ct], o[dt][ct]);
}

__device__ __forceinline__ void nsa_item(KP p, int g, int tile, float* wsm) {
  char* ws = p->ws;
  const int lane = get_tid() & 63, r = lane & 15, quad = lane >> 4;
  float* impc = wsm;
  float* vals = wsm + 2048;
  const bf16_t* qn = (const bf16_t*)(ws + O_QN);
  const bf16_t* kcmp = (const bf16_t*)(ws + O_KCMP) + (size_t)g * 512 * 64;
  const bf16_t* vcmpT = (const bf16_t*)(ws + O_VCMPT) + (size_t)g * 64 * 512;
  const bf16_t* ksb = (const bf16_t*)(ws + O_KS) + (size_t)g * S_ * 64;
  const bf16_t* kwb = (const bf16_t*)(ws + O_KW) + (size_t)g * S_ * 64;
  const bf16_t* vsT = (const bf16_t*)(ws + O_VST) + (size_t)g * 64 * S_;
  const bf16_t* vwT = (const bf16_t*)(ws + O_VWT) + (size_t)g * 64 * S_;
  const float* gates = (const float*)(ws + O_GATES);
  const int t0 = tile * 4;
  const int head = g * 8 + (r & 7);
  const float slope = exp2f(-0.5f * (float)(head + 1)) * 1.4426950408889634f;
  const float qs2 = 0.125f * 1.4426950408889634f;
  int tok[2];
  bf16x8 qf[2][2];
#pragma unroll
  for (int ct = 0; ct < 2; ct++) {
    tok[ct] = t0 + ct * 2 + (r >> 3);
#pragma unroll
    for (int ks = 0; ks < 2; ks++) qf[ks][ct] = *(const bf16x8*)(qn + (size_t)tok[ct] * 1024 + head * 64 + ks * 32 + quad * 8);
  }
  f32x4 oacc[4][2];
#pragma unroll
  for (int dt = 0; dt < 4; dt++)
#pragma unroll
    for (int ct = 0; ct < 2; ct++) oacc[dt][ct] = f32x4{0.f, 0.f, 0.f, 0.f};
  f32x4 o[4][2];
  float m[2], l[2];
  for (int i = lane; i < 2048; i += 64) impc[i] = 0.f;
  const int tlast = t0 + 3;
  if (tlast >= 31) {
    const int nmax = (tlast - 31) >> 4;
    const int nsteps = (nmax >> 5) + 1;
    const int lastkb = (nsteps - 1) * 32;
    m[0] = m[1] = -1e30f; l[0] = l[1] = 0.f;
    {
      KF kc_, kn_;
      load_kf(kc_, kcmp, 0, r, quad);
      for (int st = 0; st < nsteps; st++) {
        const int kb = st * 32;
        load_kf(kn_, kcmp, min(kb + 32, lastkb), r, quad);
        f32x4 s[2][2];
        qk_from(kc_, qf, s);
#pragma unroll
        for (int ct = 0; ct < 2; ct++) {
          float mx = -1e30f;
          float sc[8];
          unsigned vm = 0;
#pragma unroll
          for (int j = 0; j < 8; j++) {
            int n = kb + (j >> 2) * 16 + quad * 4 + (j & 3);
            int ce = n * 16 + 31;
            sc[j] = s[j >> 2][ct][j & 3] * qs2 - slope * (float)(tok[ct] - ce);
            if (ce <= tok[ct]) { vm |= 1u << j; mx = fmaxf(mx, sc[j]); }
          }
          mx = quad_max(mx);
          float mn = fmaxf(m[ct], mx);
          float al = __builtin_amdgcn_exp2f(m[ct] - mn);
          float ls = 0.f;
#pragma unroll
          for (int j = 0; j < 8; j++) if ((vm >> j) & 1) ls += __builtin_amdgcn_exp2f(sc[j] - mn);
          l[ct] = l[ct] * al + ls;
          m[ct] = mn;
        }
        kc_ = kn_;
      }
    }
    float il[2];
#pragma unroll
    for (int ct = 0; ct < 2; ct++) { float lt = quad_sum(l[ct]); il[ct] = lt > 0.f ? 1.f / lt : 0.f; }
#pragma unroll
    for (int dt = 0; dt < 4; dt++)
#pragma unroll
      for (int ct = 0; ct < 2; ct++) o[dt][ct] = f32x4{0.f, 0.f, 0.f, 0.f};
    {
      KF kc_, kn_;
      VF vc_, vn_;
      load_kf(kc_, kcmp, 0, r, quad);
      load_vf(vc_, vcmpT, 512, 0, r, quad);
      for (int st = 0; st < nsteps; st++) {
        const int kb = st * 32;
        const int nkb = min(kb + 32, lastkb);
        load_kf(kn_, kcmp, nkb, r, quad);
        load_vf(vn_, vcmpT, 512, nkb, r, quad);
        f32x4 s[2][2];
        qk_from(kc_, qf, s);
        bf16x8 pf[2];
#pragma unroll
        for (int ct = 0; ct < 2; ct++) {
          float pp[8];
#pragma unroll
          for (int j = 0; j < 8; j++) {
            int n = kb + (j >> 2) * 16 + quad * 4 + (j & 3);
            int ce = n * 16 + 31;
            float sc = s[j >> 2][ct][j & 3] * qs2 - slope * (float)(tok[ct] - ce);
            pp[j] = (ce <= tok[ct]) ? __builtin_amdgcn_exp2f(sc - m[ct]) * il[ct] : 0.f;
            float hs = pp[j];
            hs += __shfl_xor(hs, 1);
            hs += __shfl_xor(hs, 2);
            hs += __shfl_xor(hs, 4);
            if ((r & 7) == 0) impc[(ct * 2 + (r >> 3)) * 512 + n] = hs;
          }
          uint4 u;
          u.x = pack2(pp[0], pp[1]); u.y = pack2(pp[2], pp[3]); u.z = pack2(pp[4], pp[5]); u.w = pack2(pp[6], pp[7]);
          pf[ct] = *(bf16x8*)&u;
        }
        pv_from(vc_, pf, o);
        kc_ = kn_;
        vc_ = vn_;
      }
    }
#pragma unroll
    for (int ct = 0; ct < 2; ct++) {
      float gt = gates[(size_t)tok[ct] * 48 + head * 3 + 0];
#pragma unroll
      for (int dt = 0; dt < 4; dt++)
#pragma unroll
        for (int i = 0; i < 4; i++) oacc[dt][ct][i] += gt * o[dt][ct][i];
    }
  }
  __builtin_amdgcn_s_waitcnt(0);
  __builtin_amdgcn_wave_barrier();
  unsigned long long mlo[4], mhi[4];
  const int cur = t0 >> 6;
#pragma unroll
  for (int tk = 0; tk < 4; tk++) {
    float va, vb;
    {
      int j = lane;
      float s5 = 0.f;
#pragma unroll
      for (int q = -1; q <= 3; q++) { int n = 4 * j + q; if (n >= 0) s5 += impc[tk * 512 + n]; }
      va = (j > cur) ? -1e30f : ((j == 0 || j == cur || j == cur - 1) ? 1e9f : s5);
      j = lane + 64;
      s5 = 0.f;
#pragma unroll
      for (int q = -1; q <= 3; q++) { int n = 4 * j + q; if (n < 512) s5 += impc[tk * 512 + n]; }
      vb = (j > cur) ? -1e30f : ((j == cur || j == cur - 1) ? 1e9f : s5);
    }
    __builtin_amdgcn_wave_barrier();
    vals[lane] = va;
    vals[lane + 64] = vb;
    __builtin_amdgcn_s_waitcnt(0);
    __builtin_amdgcn_wave_barrier();
    int ra_ = 0, rb_ = 0;
    for (int jj = 0; jj <= cur; jj += 4) {
      const float4 x4 = *(const float4*)(vals + jj);
      const float xs_[4] = {x4.x, x4.y, x4.z, x4.w};
#pragma unroll
      for (int e = 0; e < 4; e++) {
        const float x = xs_[e];
        ra_ += (x > va || (x == va && jj + e < lane)) ? 1 : 0;
        rb_ += (x > vb || (x == vb && jj + e < lane + 64)) ? 1 : 0;
      }
    }
    mlo[tk] = __ballot(ra_ < 16);
    mhi[tk] = __ballot(rb_ < 16);
    __builtin_amdgcn_wave_barrier();
  }
  unsigned long long mylo[2], myhi[2];
#pragma unroll
  for (int ct = 0; ct < 2; ct++) {
    int ti = ct * 2 + (r >> 3);
    mylo[ct] = (ti == 0) ? mlo[0] : (ti == 1) ? mlo[1] : (ti == 2) ? mlo[2] : mlo[3];
    myhi[ct] = (ti == 0) ? mhi[0] : (ti == 1) ? mhi[1] : (ti == 2) ? mhi[2] : mhi[3];
  }
  const unsigned long long ulo = mlo[0] | mlo[1] | mlo[2] | mlo[3];
  const unsigned long long uhi = mhi[0] | mhi[1] | mhi[2] | mhi[3];
  {
    m[0] = m[1] = -1e30f; l[0] = l[1] = 0.f;
#pragma unroll
    for (int dt = 0; dt < 4; dt++)
#pragma unroll
      for (int ct = 0; ct < 2; ct++) o[dt][ct] = f32x4{0.f, 0.f, 0.f, 0.f};
    const unsigned long long vlo = (cur >= 63) ? ~0ull : ((1ull << (cur + 1)) - 1ull);
    const unsigned long long vhi = (cur < 64) ? 0ull : ((cur - 64 >= 63) ? ~0ull : ((1ull << (cur - 63)) - 1ull));
    unsigned long long wlo = ulo & vlo, whi = uhi & vhi;
    while ((wlo | whi) != 0ull) {
      int j;
      if (wlo != 0ull) { j = __builtin_ctzll(wlo); wlo &= wlo - 1ull; }
      else { j = 64 + __builtin_ctzll(whi); whi &= whi - 1ull; }
      const int kb = j * 64;
      KF k0_, k1_;
      VF v0_, v1_;
      load_kf(k0_, ksb, kb, r, quad);
      load_kf(k1_, ksb, kb + 32, r, quad);
      load_vf(v0_, vsT, S_, kb, r, quad);
      load_vf(v1_, vsT, S_, kb + 32, r, quad);
      f32x4 s0[2][2], s1[2][2];
      qk_from(k0_, qf, s0);
      qk_from(k1_, qf, s1);
      bf16x8 pfa[2], pfb[2];
#pragma unroll
      for (int ct = 0; ct < 2; ct++) {
        const unsigned bit = (unsigned)(((j < 64) ? (mylo[ct] >> j) : (myhi[ct] >> (j - 64))) & 1ull);
        float sc[16];
        unsigned vm = 0;
#pragma unroll
        for (int q = 0; q < 8; q++) {
          const int pos = kb + (q >> 2) * 16 + quad * 4 + (q & 3);
          sc[q] = s0[q >> 2][ct][q & 3] * qs2 - slope * (float)(tok[ct] - pos);
          sc[8 + q] = s1[q >> 2][ct][q & 3] * qs2 - slope * (float)(tok[ct] - pos - 32);
          if (bit && pos <= tok[ct]) vm |= 1u << q;
          if (bit && pos + 32 <= tok[ct]) vm |= 1u << (8 + q);
        }
        SOFTMAX_UPDATE16(64, ct, sc, vm, m[ct], l[ct], o, pfa[ct], pfb[ct]);
      }
      pv_from(v0_, pfa, o);
      pv_from(v1_, pfb, o);
    }
#pragma unroll
    for (int ct = 0; ct < 2; ct++) {
      float lt = quad_sum(l[ct]);
      float gt = gates[(size_t)tok[ct] * 48 + head * 3 + 1] * (lt > 0.f ? 1.f / lt : 0.f);
#pragma unroll
      for (int dt = 0; dt < 4; dt++)
#pragma unroll
        for (int i = 0; i < 4; i++) oacc[dt][ct][i] += gt * o[dt][ct][i];
    }
  }
  {
    m[0] = m[1] = -1e30f; l[0] = l[1] = 0.f;
#pragma unroll
    for (int dt = 0; dt < 4; dt++)
#pragma unroll
      for (int ct = 0; ct < 2; ct++) o[dt][ct] = f32x4{0.f, 0.f, 0.f, 0.f};
    int start = t0 - 511;
    if (start < 0) start = 0;
    start &= ~31;
    const int lastkb = tlast & ~31;
    KF kc_, kn_;
    VF vc_, vn_;
    load_kf(kc_, kwb, start, r, quad);
    load_vf(vc_, vwT, S_, start, r, quad);
    for (int kb = start; kb <= lastkb; kb += 32) {
      const int nkb = min(kb + 32, lastkb);
      load_kf(kn_, kwb, nkb, r, quad);
      load_vf(vn_, vwT, S_, nkb, r, quad);
      f32x4 s[2][2];
      qk_from(kc_, qf, s);
      bf16x8 pf[2];
#pragma unroll
      for (int ct = 0; ct < 2; ct++) {
        float sc[8];
        unsigned vm = 0;
#pragma unroll
        for (int q = 0; q < 8; q++) {
          int pos = kb + (q >> 2) * 16 + quad * 4 + (q & 3);
          int d = tok[ct] - pos;
          sc[q] = s[q >> 2][ct][q & 3] * qs2 - slope * (float)d;
          if (d >= 0 && d < 512) vm |= 1u << q;
        }
        SOFTMAX_UPDATE(64, 2, ct, sc, vm, m[ct], l[ct], o, pf[ct]);
      }
      pv_from(vc_, pf, o);
      kc_ = kn_;
      vc_ = vn_;
    }
#pragma unroll
    for (int ct = 0; ct < 2; ct++) {
      float lt = quad_sum(l[ct]);
      float gt = gates[(size_t)tok[ct] * 48 + head * 3 + 2] * (lt > 0.f ? 1.f / lt : 0.f);
#pragma unroll
      for (int dt = 0; dt < 4; dt++)
#pragma unroll
        for (int i = 0; i < 4; i++) oacc[dt][ct][i] += gt * o[dt][ct][i];
    }
  }
  const bf16_t* zn = (const bf16_t*)(ws + O_ZN);
  bf16_t* Y = (bf16_t*)(ws + O_Y);
#pragma unroll
  for (int ct = 0; ct < 2; ct++)
#pragma unroll
    for (int dt = 0; dt < 4; dt++) {
      int d = dt * 16 + quad * 4;
      uint2 zz = *(const uint2*)(zn + (size_t)tok[ct] * 1024 + head * 64 + d);
      float z0 = __uint_as_float(zz.x << 16), z1 = __uint_as_float(zz.x & 0xffff0000u);
      float z2 = __uint_as_float(zz.y << 16), z3 = __uint_as_float(zz.y & 0xffff0000u);
      uint2 ov;
      ov.x = pack2(oacc[dt][ct][0] * z0, oacc[dt][ct][1] * z1);
      ov.y = pack2(oacc[dt][ct][2] * z2, oacc[dt][ct][3] * z3);
      *(uint2*)(Y + (size_t)tok[ct] * 2048 + head * 64 + d) = ov;
    }
  __builtin_amdgcn_wave_barrier();
}

__device__ __forceinline__ void mla_block_item(KP p, int hd, int tile, char* smem) {
  char* ws = p->ws;
  const int tid = get_tid(), lane = tid & 63, wave = tid >> 6, r = lane & 15, quad = lane >> 4;
  const bf16_t* qm = (const bf16_t*)(ws + O_QM) + (size_t)hd * S_ * 192;
  const bf16_t* km = (const bf16_t*)(ws + O_KM) + (size_t)hd * S_ * 192;
  const bf16_t* vmT = (const bf16_t*)(ws + O_VMT) + (size_t)hd * 128 * S_;
  bf16_t* Kbuf = (bf16_t*)smem;
  bf16_t* Vbuf = (bf16_t*)(smem + 51200);
  const int t0 = tile * 256 + wave * 32;
  bf16x8 qf[6][2];
  int tok[2];
#pragma unroll
  for (int ct = 0; ct < 2; ct++) {
    tok[ct] = t0 + ct * 16 + r;
#pragma unroll
    for (int ks = 0; ks < 6; ks++) qf[ks][ct] = *(const bf16x8*)(qm + (size_t)tok[ct] * 192 + ks * 32 + quad * 8);
  }
  f32x4 o[8][2];
#pragma unroll
  for (int dt = 0; dt < 8; dt++)
#pragma unroll
    for (int ct = 0; ct < 2; ct++) o[dt][ct] = f32x4{0.f, 0.f, 0.f, 0.f};
  float m[2] = {-1e30f, -1e30f}, l[2] = {0.f, 0.f};
  const float scale = 0.07216878364870322f * 1.4426950408889634f;
  const int nsteps = 4 * (tile + 1);
  const int kr0 = tid / 24, kc0 = (tid % 24) * 8;
  const int kr1 = (tid + 512) / 24, kc1 = ((tid + 512) % 24) * 8;
  const int kr2 = (tid + 1024) / 24, kc2 = ((tid + 1024) % 24) * 8;
  const int vr0 = tid >> 3, vc0 = (tid & 7) * 8;
  const int vr1 = (tid + 512) >> 3;
  uint4 k0r, k1r, k2r, v0r, v1r;
#define MLA_GLOAD(kb_)                                                   \
  {                                                                      \
    k0r = *(const uint4*)(km + (size_t)((kb_) + kr0) * 192 + kc0);       \
    k1r = *(const uint4*)(km + (size_t)((kb_) + kr1) * 192 + kc1);       \
    k2r = *(const uint4*)(km + (size_t)((kb_) + kr2) * 192 + kc2);       \
    v0r = *(const uint4*)(vmT + (size_t)vr0 * S_ + (kb_) + vc0);         \
    v1r = *(const uint4*)(vmT + (size_t)vr1 * S_ + (kb_) + vc0);         \
  }
#define MLA_LSTORE(bi_)                                                  \
  {                                                                      \
    bf16_t* Kb_ = Kbuf + (bi_) * 64 * 200;                               \
    bf16_t* Vb_ = Vbuf + (bi_) * 128 * 72;                               \
    *(uint4*)(Kb_ + kr0 * 200 + kc0) = k0r;                              \
    *(uint4*)(Kb_ + kr1 * 200 + kc1) = k1r;                              \
    *(uint4*)(Kb_ + kr2 * 200 + kc2) = k2r;                              \
    *(uint4*)(Vb_ + vr0 * 72 + vc0) = v0r;                               \
    *(uint4*)(Vb_ + vr1 * 72 + vc0) = v1r;                               \
  }
  __syncthreads();
  MLA_GLOAD(0);
  MLA_LSTORE(0);
  __syncthreads();
  for (int st = 0; st < nsteps; st++) {
    const int kb = st * 64;
    if (st + 1 < nsteps) MLA_GLOAD(kb + 64);
    if (kb <= t0 + 31) {
      const bf16_t* Kb_ = Kbuf + (st & 1) * 64 * 200;
      const bf16_t* Vb_ = Vbuf + (st & 1) * 128 * 72;
#pragma unroll
      for (int hf = 0; hf < 2; hf++) {
        if (kb + hf * 32 <= t0 + 31) {
          f32x4 s[2][2];
          qk_step<192, 2>(Kb_, 200, hf * 32, qf, s, r, quad);
          bf16x8 pf[2];
          if (kb + hf * 32 + 31 <= t0) {
#pragma unroll
            for (int ct = 0; ct < 2; ct++) {
              float sc[8];
              const unsigned vm = 0xffu;
#pragma unroll
              for (int j = 0; j < 8; j++) sc[j] = s[j >> 2][ct][j & 3] * scale;
              SOFTMAX_UPDATE(128, 2, ct, sc, vm, m[ct], l[ct], o, pf[ct]);
            }
          } else {
#pragma unroll
            for (int ct = 0; ct < 2; ct++) {
              float sc[8];
              unsigned vm = 0;
#pragma unroll
              for (int j = 0; j < 8; j++) {
                int key = kb + hf * 32 + (j >> 2) * 16 + quad * 4 + (j & 3);
                sc[j] = s[j >> 2][ct][j & 3] * scale;
                if (key <= tok[ct]) vm |= 1u << j;
              }
              SOFTMAX_UPDATE(128, 2, ct, sc, vm, m[ct], l[ct], o, pf[ct]);
            }
          }
          pv_step<128, 2>(Vb_, 72, hf * 32, pf, o, r, quad);
        }
      }
    }
    if (st + 1 < nsteps) MLA_LSTORE((st + 1) & 1);
    __syncthreads();
  }
  const bf16_t* zm = (const bf16_t*)(ws + O_ZM);
  bf16_t* Y = (bf16_t*)(ws + O_Y);
#pragma unroll
  for (int ct = 0; ct < 2; ct++) {
    float lt = quad_sum(l[ct]);
    float il = lt > 0.f ? 1.f / lt : 0.f;
#pragma unroll
    for (int dt = 0; dt < 8; dt++) {
      int d = dt * 16 + quad * 4;
      const bf16_t* zp = zm + (size_t)tok[ct] * 1024 + hd * 128 + d;
      uint2 zz = *(const uint2*)zp;
      float z0 = __uint_as_float(zz.x << 16), z1 = __uint_as_float(zz.x & 0xffff0000u);
      float z2 = __uint_as_float(zz.y << 16), z3 = __uint_as_float(zz.y & 0xffff0000u);
      uint2 ov;
      ov.x = pack2(o[dt][ct][0] * il * z0, o[dt][ct][1] * il * z1);
      ov.y = pack2(o[dt][ct][2] * il * z2, o[dt][ct][3] * il * z3);
      *(uint2*)(Y + (size_t)tok[ct] * 2048 + 1024 + hd * 128 + d) = ov;
    }
  }
}

__device__ __forceinline__ void phase4(KP p, char* smem, int cidx) {
  const int lane = get_tid() & 63, wave = get_tid() >> 6;
  unsigned int* ctr = (unsigned int*)(p->ws + O_CTR) + cidx;
  for (int item = blockIdx.x; item < 256; item += gridDim.x) {
    int tile = 31 - (item >> 3), hd = item & 7;
    mla_block_item(p, hd, tile, smem);
  }
  __syncthreads();
  float* wsm = (float*)(smem + (size_t)wave * 8704);
  const int NNSA = 4096;
  for (;;) {
    int item = 0;
    if (lane == 0) item = (int)atomicAdd(ctr, 1u);
    item = __builtin_amdgcn_readfirstlane(item);
    if (item >= NNSA) break;
    int tile = 2047 - (item >> 1), g = item & 1;
    nsa_item(p, g, tile, wsm);
  }
}

__device__ __forceinline__ void outproj_phase(KP p, const bf16_t* A, const bf16_t* Bt, const float* xres, int layer, char* smem) {
  const float* gate = (const float*)(p->ws + O_MOD) + layer * 6144 + 4096;
  float* out = p->out;
  auto epiD = [&](f32x4(&acc)[4][4], int row0, int col0) {};
  auto epiS = [&](const float* Cs, int m0, int n0, int tid) {
    STAGE_LOOP4(row, c4, v)
      const size_t idx = (size_t)(m0 + row) * 2048 + n0 + c4;
      const float4 x = *(const float4*)(xres + idx);
      const float4 g = *(const float4*)(gate + n0 + c4);
      float4 o;
      o.x = x.x + g.x * v.x; o.y = x.y + g.y * v.y; o.z = x.z + g.z * v.z; o.w = x.w + g.w * v.w;
      *(float4*)(out + idx) = o;
    STAGE_END
  };
  for (int t = blockIdx.x; t < 32 * 8; t += gridDim.x) {
    int pm, pn;
    g8_map(t, 32, 8, pm, pn);
    gemm256_tile(A, 2048, Bt, 2048, 2048, pm * 256, pn * 256, smem, epiS);
  }
}


__device__ __forceinline__ void phase7(KP p, char* smem) {
  char* ws = p->ws;
  auto epiD = [&](f32x4(&acc)[4][4], int row0, int col0) {};
  const int total = 1024 + 64;
  for (int item = blockIdx.x; item < total; item += gridDim.x) {
    if (item >= 1024) {
      const int li = item - 1024;
      int which = li >> 5, mt_ = li & 31;
      bf16_t* dst = (bf16_t*)(ws + (which ? O_LA : O_LW));
      auto epiS = [&](const float* Cs, int m0, int n0, int tid) {
        STAGE_LOOP8(row, c8, va, vb)
          float4 a = va, b = vb;
          if (which == 0) {
            a.x = tanhf(a.x); a.y = tanhf(a.y); a.z = tanhf(a.z); a.w = tanhf(a.w);
            b.x = tanhf(b.x); b.y = tanhf(b.y); b.z = tanhf(b.z); b.w = tanhf(b.w);
          }
          *(uint4*)(dst + (size_t)(m0 + row) * 128 + c8) = pack8(a, b);
        STAGE_END
      };
      gemm_tile<0>((const bf16_t*)(ws + (which ? O_XA : O_XW)), 2048, (const bf16_t*)(ws + (which ? O_WT_A1 : O_WT_W1)), 2048, 2048, mt_ * 256, 0, smem,
                   nullptr, epiD, epiS);
    } else {
      const int prob = item >> 8, tt = item & 255;
      int pm, pn;
      g8_map(tt, 32, 8, pm, pn);
      const size_t woff = prob == 0 ? O_WT_R : prob == 1 ? O_WT_K : prob == 2 ? O_WT_V : O_WT_Z;
      bf16_t* dst = (bf16_t*)(ws + (prob == 0 ? O_R : prob == 1 ? O_K : prob == 2 ? O_V : O_ZS));
      auto epiS = [&](const float* Cs, int m0, int n0, int tid) {
        STAGE_LOOP8(row, c8, va, vb)
          float4 a = va, b = vb;
          if (prob == 3) {
            a.x = siluf(a.x); a.y = siluf(a.y); a.z = siluf(a.z); a.w = siluf(a.w);
            b.x = siluf(b.x); b.y = siluf(b.y); b.z = siluf(b.z); b.w = siluf(b.w);
          }
          *(uint4*)(dst + (size_t)(m0 + row) * 2048 + n0 + c8) = pack8(a, b);
        STAGE_END
      };
      const size_t aoff = prob == 0 ? O_H1 : prob == 1 ? O_XK : prob == 2 ? O_XV : O_XZ;
      gemm256_tile((const bf16_t*)(ws + aoff), 2048, (const bf16_t*)(ws + woff), 2048, 2048, pm * 256, pn * 256, smem, epiS);
    }
  }
}

__device__ __forceinline__ float logdecay_of(float v) {
  return -0.6065306597126334f / (1.f + __expf(-v));
}
__device__ __forceinline__ void phase8(KP p, char* smem) {
  char* ws = p->ws;
  auto epiD = [&](f32x4(&acc)[4][4], int row0, int col0) {};
  for (int item = blockIdx.x; item < 2 * 512; item += gridDim.x) {
    int which = item >> 9, tt = item & 511;
    int mt_ = tt & 31, nt_ = tt >> 5;
    const float* bias = p->in[which ? 29 : 26];
    float* logw = (float*)(ws + O_LOGW);
    bf16_t* ab = (bf16_t*)(ws + O_AB);
    auto epiS = [&](const float* Cs, int m0, int n0, int tid) {
      if (which == 0) {
        STAGE_LOOP4(row, c4, v)
          const float4 b = *(const float4*)(bias + n0 + c4);
          float4 o;
          o.x = logdecay_of(v.x + b.x); o.y = logdecay_of(v.y + b.y); o.z = logdecay_of(v.z + b.z); o.w = logdecay_of(v.w + b.w);
          *(float4*)(logw + (size_t)(m0 + row) * 2048 + n0 + c4) = o;
        STAGE_END
      } else {
        STAGE_LOOP8(row, c8, va, vb)
          const float4 b0 = *(const float4*)(bias + n0 + c8), b1 = *(const float4*)(bias + n0 + c8 + 4);
          float4 a, b;
          a.x = sigmf(va.x + b0.x); a.y = sigmf(va.y + b0.y); a.z = sigmf(va.z + b0.z); a.w = sigmf(va.w + b0.w);
          b.x = sigmf(vb.x + b1.x); b.y = sigmf(vb.y + b1.y); b.z = sigmf(vb.z + b1.z); b.w = sigmf(vb.w + b1.w);
          *(uint4*)(ab + (size_t)(m0 + row) * 2048 + n0 + c8) = pack8(a, b);
        STAGE_END
      }
    };
    gemm_tile<0>((const bf16_t*)(ws + (which ? O_LA : O_LW)), 128, (const bf16_t*)(ws + (which ? O_WT_A2 : O_WT_W2)), 128, 128,
                 mt_ * 256, nt_ * 128, smem, nullptr, epiD, epiS);
  }
}

__device__ __forceinline__ f32x4 mmt(const float* A, int ars, int acs, const float* B, int brs, int bcs, int nks, f32x4 acc,
                                     int lane) {
  const int r = lane & 15, q = lane >> 4;
  const float* ap = A + r * ars + q * acs;
  const float* bp = B + q * brs + r * bcs;
#pragma unroll 4
  for (int ks = 0; ks < nks; ks++) {
    acc = __builtin_amdgcn_mfma_f32_16x16x4f32(ap[4 * ks * acs], bp[4 * ks * brs], acc, 0, 0, 0);
  }
  return acc;
}

__device__ __forceinline__ void phase9(KP p, int half, float* sm) {
  char* ws = p->ws;
  constexpr int LS = 65;
  constexpr int US = 64 * LS;
  float* U0 = sm;
  float* U1 = sm + 1 * US;
  float* U2 = sm + 2 * US;
  float* U3 = sm + 3 * US;
  float* U4 = sm + 4 * US;
  float* U5 = sm + 5 * US;
  float* U6 = sm + 6 * US;
  float* U7 = sm + 7 * US;
  float* U8 = sm + 8 * US;
  float* gC = sm + 9 * US;
  const int tid = get_tid(), lane = tid & 63, wave = tid >> 6, r = lane & 15, quad = lane >> 4;
  const bf16_t* Rb = (const bf16_t*)(ws + O_R);
  const bf16_t* Kb = (const bf16_t*)(ws + O_K);
  const bf16_t* Vb = (const bf16_t*)(ws + O_V);
  const bf16_t* Ab = (const bf16_t*)(ws + O_AB);
  const float* LW = (const float*)(ws + O_LOGW);
  float* bon = (float*)(ws + O_BON);
  float* CHP = (float*)(ws + O_CHP);
  float* CHQ = (float*)(ws + O_CHQ);
  bf16_t* CHG = (bf16_t*)(ws + O_CHG);
  bf16_t* CHY = (bf16_t*)(ws + O_CHY);
  const float* k_k = p->in[32];
  const float* k_a = p->in[33];
  const float* r_k = p->in[34];
  uint4 nR, nK, nV, nA;
  float4 nL0, nL1;
#define P9_PREFETCH(slot_)                                                        \
  {                                                                               \
    const int hl_ = (slot_) >> 7, c_ = (slot_) & 127;                             \
    const size_t gi_ = (size_t)(c_ * 64 + (tid >> 3)) * 2048 + (half * 16 + hl_) * 64 + (tid & 7) * 8; \
    nR = *(const uint4*)(Rb + gi_); nK = *(const uint4*)(Kb + gi_);               \
    nV = *(const uint4*)(Vb + gi_); nA = *(const uint4*)(Ab + gi_);               \
    nL0 = *(const float4*)(LW + gi_); nL1 = *(const float4*)(LW + gi_ + 4);       \
  }
  if ((int)blockIdx.x < 2048) P9_PREFETCH((int)blockIdx.x);
  for (int slot = blockIdx.x; slot < 2048; slot += gridDim.x) {
    const int hl = slot >> 7, c = slot & 127;
    const int hd = half * 16 + hl;
    {
      const int i = tid >> 3, kg = (tid & 7) * 8;
      const int t = c * 64 + i, ch = hd * 64 + kg;
      float rr[8], kk_[8], vv[8], aa[8], lw[8];
      unpack8(nR, rr);
      unpack8(nK, kk_);
      unpack8(nV, vv);
      unpack8(nA, aa);
      {
        float4 l0 = nL0, l1 = nL1;
        { const int ns_ = slot + (int)gridDim.x; P9_PREFETCH(ns_ < 2048 ? ns_ : slot); }
        lw[0] = l0.x; lw[1] = l0.y; lw[2] = l0.z; lw[3] = l0.w; lw[4] = l1.x; lw[5] = l1.y; lw[6] = l1.z; lw[7] = l1.w;
      }
      float kn[8], k2[8];
      float ss = 0.f, bs = 0.f;
#pragma unroll
      for (int j = 0; j < 8; j++) {
        kn[j] = kk_[j] * k_k[ch + j];
        ss += kn[j] * kn[j];
        k2[j] = kk_[j] * (1.f + (aa[j] - 1.f) * k_a[ch + j]);
        bs += rr[j] * k2[j] * r_k[ch + j];
      }
      ss += __shfl_xor(ss, 1); ss += __shfl_xor(ss, 2); ss += __shfl_xor(ss, 4);
      bs += __shfl_xor(bs, 1); bs += __shfl_xor(bs, 2); bs += __shfl_xor(bs, 4);
      const float inrm = 1.f / fmaxf(sqrtf(ss), 1e-12f);
      if ((tid & 7) == 0) bon[(size_t)t * 32 + hd] = bs;
#pragma unroll
      for (int j = 0; j < 8; j++) U5[i * LS + kg + j] = lw[j];
      __syncthreads();
      if (tid < 64) {
        float xs[64];
#pragma unroll
        for (int ii = 0; ii < 64; ii++) xs[ii] = U5[ii * LS + tid];
        float run = 0.f;
#pragma unroll
        for (int ii = 0; ii < 64; ii++) { run += xs[ii]; U5[ii * LS + tid] = run; }
        gC[tid] = __expf(run);
      }
      __syncthreads();
#pragma unroll
      for (int j = 0; j < 8; j++) {
        float L = U5[i * LS + kg + j];
        float Lp = L - lw[j];
        float eL = __expf(L), eLp = __expf(Lp), enL = __expf(-L);
        float kkn = kn[j] * inrm;
        int o = i * LS + kg + j;
        U3[o] = -kkn * eLp;
        U4[o] = rr[j] * eL;
        U0[o] = k2[j] * enL;
        U1[o] = kkn * aa[j] * enL;
        U2[o] = vv[j];
      }
    }
    __syncthreads();
    f32x4 ginit[2];
    {
      const int mI = wave >> 1, hf = wave & 1;
      const float* As_ = (mI < 2) ? U3 : U4;
      const float* Bs_ = (mI & 1) ? U1 : U0;
      float* dst = U5 + mI * US;
#pragma unroll
      for (int pass = 0; pass < 2; pass++) {
        const int it = (pass == 0) ? (hf ? 1 : 0) : (hf ? 2 : 3);
        f32x4 acc4[4];
#pragma unroll
        for (int jt = 0; jt < 4; jt++) acc4[jt] = f32x4{0.f, 0.f, 0.f, 0.f};
        const float* ap = As_ + (it * 16 + r) * LS + quad;
        const float* bp = Bs_ + r * LS + quad;
#pragma unroll 4
        for (int ks = 0; ks < 16; ks++) {
          const float av = ap[4 * ks];
#pragma unroll
          for (int jt = 0; jt < 4; jt++)
            if (jt <= it) acc4[jt] = __builtin_amdgcn_mfma_f32_16x16x4f32(av, bp[jt * 16 * LS + 4 * ks], acc4[jt], 0, 0, 0);
        }
#pragma unroll
        for (int jt = 0; jt < 4; jt++) {
#pragma unroll
          for (int v = 0; v < 4; v++) {
            int i = it * 16 + quad * 4 + v, j = jt * 16 + r;
            bool keep = (mI < 2) ? (j < i) : (j <= i);
            dst[i * LS + j] = keep ? acc4[jt][v] : 0.f;
          }
        }
      }
      const int it = wave >> 1;
#pragma unroll
      for (int x = 0; x < 2; x++) {
        int jt = (wave & 1) * 2 + x;
#pragma unroll
        for (int v = 0; v < 4; v++) ginit[x][v] = U4[(it * 16 + quad * 4 + v) * LS + jt * 16 + r];
      }
    }
    __syncthreads();
    {
      const int it = wave >> 1, jt0 = (wave & 1) * 2;
      f32x4 xa0 = f32x4{0.f, 0.f, 0.f, 0.f}, xa1 = f32x4{0.f, 0.f, 0.f, 0.f};
      const float* ap = U5 + (it * 16 + r) * LS + quad;
      const float* bp = U2 + quad * LS + jt0 * 16 + r;
#pragma unroll 4
      for (int ks = 0; ks < 16; ks++) {
        const float av = ap[4 * ks];
        xa0 = __builtin_amdgcn_mfma_f32_16x16x4f32(av, bp[4 * ks * LS], xa0, 0, 0, 0);
        xa1 = __builtin_amdgcn_mfma_f32_16x16x4f32(av, bp[4 * ks * LS + 16], xa1, 0, 0, 0);
      }
      __syncthreads();
#pragma unroll
      for (int v = 0; v < 4; v++) {
        U5[(it * 16 + quad * 4 + v) * LS + jt0 * 16 + r] = xa0[v];
        U5[(it * 16 + quad * 4 + v) * LS + jt0 * 16 + 16 + r] = xa1[v];
      }
    }
    __syncthreads();
    {
      float* Rb_ = (wave < 4) ? (U3 + wave * 16) : (U5 + (wave - 4) * 16);
#pragma unroll 1
      for (int blk = 0; blk < 4; blk++) {
        f32x4 sv;
#pragma unroll
        for (int v = 0; v < 4; v++) sv[v] = Rb_[(16 * blk + quad * 4 + v) * LS + r];
        {
          const float* ap = U6 + (16 * blk + r) * LS + quad;
          const float* bp = Rb_ + quad * LS + r;
          for (int ks = 0; ks < 4 * blk; ks++)
            sv = __builtin_amdgcn_mfma_f32_16x16x4f32(ap[4 * ks], bp[4 * ks * LS], sv, 0, 0, 0);
        }
        float nd[4][16];
#pragma unroll
        for (int v = 0; v < 4; v++)
#pragma unroll
          for (int i = 0; i < 16; i++) nd[v][i] = U6[(16 * blk + quad * 4 + v) * LS + 16 * blk + i];
#pragma unroll
        for (int i = 0; i < 15; i++) {
          const float ui = __shfl(sv[i & 3], (i >> 2) * 16 + r);
#pragma unroll
          for (int v = 0; v < 4; v++) sv[v] += nd[v][i] * ui;
        }
#pragma unroll
        for (int v = 0; v < 4; v++) Rb_[(16 * blk + quad * 4 + v) * LS + r] = sv[v];
        __builtin_amdgcn_s_waitcnt(0);
        __builtin_amdgcn_wave_barrier();
      }
    }
    __syncthreads();
    {
      const int it = wave >> 1, jt0 = (wave & 1) * 2;
      const size_t sbase = (size_t)slot * 4096;
      f32x4 g_[2], y1[2], y2[2], p_[2], q1[2], q2[2];
#pragma unroll
      for (int x = 0; x < 2; x++) {
        g_[x] = ginit[x];
        y1[x] = y2[x] = p_[x] = q1[x] = q2[x] = f32x4{0.f, 0.f, 0.f, 0.f};
      }
      const float* a_rb = U8 + (it * 16 + r) * LS + quad;
      const float* a_rk = U7 + (it * 16 + r) * LS + quad;
      const float* a_bt = U1 + quad * LS + it * 16 + r;
      const float* a_kt = U0 + quad * LS + it * 16 + r;
      const float* b_w1 = U3 + quad * LS + jt0 * 16 + r;
      const float* b_v = U2 + quad * LS + jt0 * 16 + r;
      const float* b_w2 = U5 + quad * LS + jt0 * 16 + r;
#pragma unroll 2
      for (int ks = 0; ks < 16; ks++) {
        const float arb = a_rb[4 * ks], ark = a_rk[4 * ks], abt = a_bt[4 * ks * LS], akt = a_kt[4 * ks * LS];
#pragma unroll
        for (int x = 0; x < 2; x++) {
          const float w1 = b_w1[4 * ks * LS + 16 * x], vv_ = b_v[4 * ks * LS + 16 * x], w2 = b_w2[4 * ks * LS + 16 * x];
          g_[x] = __builtin_amdgcn_mfma_f32_16x16x4f32(arb, w1, g_[x], 0, 0, 0);
          y1[x] = __builtin_amdgcn_mfma_f32_16x16x4f32(ark, vv_, y1[x], 0, 0, 0);
          y2[x] = __builtin_amdgcn_mfma_f32_16x16x4f32(arb, w2, y2[x], 0, 0, 0);
          p_[x] = __builtin_amdgcn_mfma_f32_16x16x4f32(abt, w1, p_[x], 0, 0, 0);
          q1[x] = __builtin_amdgcn_mfma_f32_16x16x4f32(akt, vv_, q1[x], 0, 0, 0);
          q2[x] = __builtin_amdgcn_mfma_f32_16x16x4f32(abt, w2, q2[x], 0, 0, 0);
        }
      }
#pragma unroll
      for (int x = 0; x < 2; x++) {
#pragma unroll
        for (int v = 0; v < 4; v++) {
          int row = it * 16 + quad * 4 + v, colx = (jt0 + x) * 16 + r;
          size_t o = sbase + row * 64 + colx;
          CHG[o] = f2bf(g_[x][v]);
          CHY[o] = f2bf(y1[x][v] + y2[x][v]);
          float gc = gC[row];
          CHP[o] = gc * (p_[x][v] + (row == colx ? 1.f : 0.f));
          CHQ[o] = gc * (q1[x][v] + q2[x][v]);
        }
      }
    }
    __syncthreads();
  }
}

__device__ __forceinline__ void phase10(KP p, int half, float* sm) {
  char* ws = p->ws;
  if (blockIdx.x >= 64) return;
  const int bidx = blockIdx.x;
  const int hl = bidx >> 2, vs = bidx & 3;
  const int tid = get_tid(), lane = tid & 63, wave = tid >> 6, r = lane & 15, q = lane >> 4;
  const float* CHP = (const float*)(ws + O_CHP);
  const float* CHQ = (const float*)(ws + O_CHQ);
  float* S0 = (float*)(ws + O_S0);
  float* Sb = sm;
  const size_t hbase = (size_t)(hl * 128) * 4096;
  if (wave < 4) {
    const float* Pb = CHP + hbase + (16 * wave + r) * 64 + 16 * q;
    const float* Qb = CHQ + hbase + (16 * wave + 4 * q) * 64 + vs * 16 + r;
    float4 A0, B0, C0, D0, A1, B1, C1, D1, A2, B2, C2, D2, A3, B3, C3, D3;
    f32x4 Q0, Q1, Q2, Q3;
#define PF_S(k_, c_)                                                         \
  {                                                                          \
    __builtin_amdgcn_sched_barrier(0);                                       \
    const size_t so_ = (size_t)min((c_), 127) * 4096;                        \
    A##k_ = *(const float4*)(Pb + so_);                                      \
    B##k_ = *(const float4*)(Pb + so_ + 4);                                  \
    C##k_ = *(const float4*)(Pb + so_ + 8);                                  \
    D##k_ = *(const float4*)(Pb + so_ + 12);                                 \
    Q##k_[0] = Qb[so_]; Q##k_[1] = Qb[so_ + 64]; Q##k_[2] = Qb[so_ + 128]; Q##k_[3] = Qb[so_ + 192]; \
    __builtin_amdgcn_sched_barrier(0);                                       \
  }
    f32x4 st = f32x4{0.f, 0.f, 0.f, 0.f};
#define STEP_S(k_, c_)                                                                         \
  {                                                                                            \
    float* sbuf = Sb + ((c_) & 1) * 16 * 68;                                                   \
    *(float4*)(sbuf + r * 68 + 16 * wave + 4 * q) = float4{st[0], st[1], st[2], st[3]};        \
    float a[16] = {A##k_.x, A##k_.y, A##k_.z, A##k_.w, B##k_.x, B##k_.y, B##k_.z, B##k_.w,      \
                   C##k_.x, C##k_.y, C##k_.z, C##k_.w, D##k_.x, D##k_.y, D##k_.z, D##k_.w};     \
    f32x4 acc = Q##k_;                                                                         \
    asm volatile("s_waitcnt lgkmcnt(0)\n\ts_barrier" ::: "memory");                            \
    f32x4 acc2 = f32x4{0.f, 0.f, 0.f, 0.f};                                                    \
    {                                                                                          \
      const float4 s0_ = *(const float4*)(sbuf + r * 68 + 16 * q), s1_ = *(const float4*)(sbuf + r * 68 + 16 * q + 4);  \
      const float4 s2_ = *(const float4*)(sbuf + r * 68 + 16 * q + 8), s3_ = *(const float4*)(sbuf + r * 68 + 16 * q + 12); \
      const float sv_[16] = {s0_.x, s0_.y, s0_.z, s0_.w, s1_.x, s1_.y, s1_.z, s1_.w, s2_.x, s2_.y, s2_.z, s2_.w, s3_.x, s3_.y, s3_.z, s3_.w}; \
      _Pragma("unroll") for (int ks = 0; ks < 16; ks += 2) {                                   \
        acc = __builtin_amdgcn_mfma_f32_16x16x4f32(a[ks], sv_[ks], acc, 0, 0, 0);              \
        acc2 = __builtin_amdgcn_mfma_f32_16x16x4f32(a[ks + 1], sv_[ks + 1], acc2, 0, 0, 0);    \
      }                                                                                        \
    }                                                                                          \
    PF_S(k_, (c_) + 4)                                                                         \
    _Pragma("unroll") for (int v = 0; v < 4; v++) acc[v] += acc2[v];                           \
    st = acc;                                                                                  \
  }
    PF_S(0, 0) PF_S(1, 1) PF_S(2, 2) PF_S(3, 3)
    for (int c = 0; c < 128; c += 4) {
      STEP_S(0, c) STEP_S(1, c + 1) STEP_S(2, c + 2) STEP_S(3, c + 3)
    }
  } else {
    const int w4 = wave - 4;
    for (int c = 0; c < 128; c++) {
      const float* sbuf = Sb + (c & 1) * 16 * 68;
      asm volatile("s_waitcnt lgkmcnt(0)\n\ts_barrier" ::: "memory");
      float* dst = S0 + hbase + (size_t)c * 4096 + vs * 16;
      const float4 sv4 = *(const float4*)(sbuf + r * 68 + 16 * w4 + 4 * q);
      const int k0_ = 16 * w4 + 4 * q;
      dst[(k0_ + 0) * 64 + r] = sv4.x; dst[(k0_ + 1) * 64 + r] = sv4.y; dst[(k0_ + 2) * 64 + r] = sv4.z; dst[(k0_ + 3) * 64 + r] = sv4.w;
    }
  }
}

__device__ __forceinline__ void phase10b(KP p, int half, float* sm) {
  char* ws = p->ws;
  constexpr int LS = 65;
  float* S0s = sm;
  float* Ys = sm + 64 * LS;
  const int tid = get_tid(), lane = tid & 63, wave = tid >> 6, r = lane & 15, quad = lane >> 4;
  const float* S0 = (const float*)(ws + O_S0);
  const bf16_t* CHG = (const bf16_t*)(ws + O_CHG);
  const bf16_t* CHY = (const bf16_t*)(ws + O_CHY);
  const bf16_t* Vb = (const bf16_t*)(ws + O_V);
  const bf16_t* Zs = (const bf16_t*)(ws + O_ZS);
  const float* bon = (const float*)(ws + O_BON);
  const float* lg = p->in[35];
  const float* lb = p->in[36];
  bf16_t* YR = (bf16_t*)(ws + O_YR);
  for (int slot = blockIdx.x; slot < 2048; slot += gridDim.x) {
    const int hl = slot >> 7, c = slot & 127, hd = half * 16 + hl;
    const size_t sbase = (size_t)slot * 4096;
    __syncthreads();
    for (int e = tid; e < 1024; e += NTHR) {
      const int k = e >> 4, v4 = (e & 15) * 4;
      const float4 f = *(const float4*)(S0 + sbase + k * 64 + v4);
      S0s[k * LS + v4] = f.x; S0s[k * LS + v4 + 1] = f.y; S0s[k * LS + v4 + 2] = f.z; S0s[k * LS + v4 + 3] = f.w;
    }
    const int it = wave >> 1, vt0 = (wave & 1) * 2;
    float a[16];
    {
      const bf16_t* G = CHG + sbase + (16 * it + r) * 64 + 16 * quad;
      unpack8(*(const uint4*)G, a);
      unpack8(*(const uint4*)(G + 8), a + 8);
    }
    f32x4 acc0, acc1;
#pragma unroll
    for (int v = 0; v < 4; v++) {
      acc0[v] = bf2f(CHY[sbase + (16 * it + 4 * quad + v) * 64 + vt0 * 16 + r]);
      acc1[v] = bf2f(CHY[sbase + (16 * it + 4 * quad + v) * 64 + vt0 * 16 + 16 + r]);
    }
    __syncthreads();
#pragma unroll
    for (int ks = 0; ks < 16; ks++) {
      acc0 = __builtin_amdgcn_mfma_f32_16x16x4f32(a[ks], S0s[(16 * quad + ks) * LS + vt0 * 16 + r], acc0, 0, 0, 0);
      acc1 = __builtin_amdgcn_mfma_f32_16x16x4f32(a[ks], S0s[(16 * quad + ks) * LS + vt0 * 16 + 16 + r], acc1, 0, 0, 0);
    }
#pragma unroll
    for (int v = 0; v < 4; v++) {
      Ys[(16 * it + 4 * quad + v) * LS + vt0 * 16 + r] = acc0[v];
      Ys[(16 * it + 4 * quad + v) * LS + vt0 * 16 + 16 + r] = acc1[v];
    }
    __syncthreads();
    {
      const int i = tid >> 3, vg = (tid & 7) * 8;
      const int t = c * 64 + i, ch = hd * 64 + vg;
      float y[8];
      float s = 0.f;
#pragma unroll
      for (int j = 0; j < 8; j++) { y[j] = Ys[i * LS + vg + j]; s += y[j]; }
      s += __shfl_xor(s, 1); s += __shfl_xor(s, 2); s += __shfl_xor(s, 4);
      const float mean = s * (1.f / 64.f);
      float vr = 0.f;
#pragma unroll
      for (int j = 0; j < 8; j++) { float d = y[j] - mean; vr += d * d; }
      vr += __shfl_xor(vr, 1); vr += __shfl_xor(vr, 2); vr += __shfl_xor(vr, 4);
      const float rstd = rsqrtf(vr * (1.f / 64.f) + 64e-5f);
      const float bo = bon[(size_t)t * 32 + hd];
      const size_t gi = (size_t)t * 2048 + ch;
      float vv[8], zz[8];
      unpack8(*(const uint4*)(Vb + gi), vv);
      unpack8(*(const uint4*)(Zs + gi), zz);
      float o[8];
#pragma unroll
      for (int j = 0; j < 8; j++) o[j] = ((y[j] - mean) * rstd * lg[ch + j] + lb[ch + j] + bo * vv[j]) * zz[j];
      uint4 u;
      u.x = pack2(o[0], o[1]); u.y = pack2(o[2], o[3]); u.z = pack2(o[4], o[5]); u.w = pack2(o[6], o[7]);
      *(uint4*)(YR + gi) = u;
    }
  }
}

__device__ __forceinline__ void phase11(KP p) {
  char* ws = p->ws;
  const int lane = get_tid() & 63, wave = get_tid() >> 6;
  const bf16_t* yraw = (const bf16_t*)(ws + O_YRAW);
  const bf16_t* Vb = (const bf16_t*)(ws + O_V);
  const bf16_t* Zs = (const bf16_t*)(ws + O_ZS);
  const float* bon = (const float*)(ws + O_BON);
  const float* lg = p->in[35];
  const float* lb = p->in[36];
  bf16_t* YR = (bf16_t*)(ws + O_YR);
  for (int t = blockIdx.x * 8 + wave; t < S_; t += gridDim.x * 8) {
    const size_t base = (size_t)t * 2048 + lane * 32;
    float y[32];
#pragma unroll
    for (int x = 0; x < 4; x++) unpack8(*(const uint4*)(yraw + base + 8 * x), y + 8 * x);
    float s = 0.f;
#pragma unroll
    for (int x = 0; x < 32; x++) s += y[x];
    s += __shfl_xor(s, 1);
    float mean = s * (1.f / 64.f);
    float vr = 0.f;
#pragma unroll
    for (int x = 0; x < 32; x++) { float d = y[x] - mean; vr += d * d; }
    vr += __shfl_xor(vr, 1);
    float rstd = rsqrtf(vr * (1.f / 64.f) + 64e-5f);
    float bo = bon[(size_t)t * 32 + (lane >> 1)];
#pragma unroll
    for (int x = 0; x < 4; x++) {
      float vv[8], zz[8];
      unpack8(*(const uint4*)(Vb + base + 8 * x), vv);
      unpack8(*(const uint4*)(Zs + base + 8 * x), zz);
      float o[8];
#pragma unroll
      for (int j = 0; j < 8; j++) {
        int ch = lane * 32 + 8 * x + j;
        o[j] = ((y[8 * x + j] - mean) * rstd * lg[ch] + lb[ch] + bo * vv[j]) * zz[j];
      }
      uint4 u;
      u.x = pack2(o[0], o[1]); u.y = pack2(o[2], o[3]); u.z = pack2(o[4], o[5]); u.w = pack2(o[6], o[7]);
      *(uint4*)(YR + base + 8 * x) = u;
    }
  }
}

__device__ __forceinline__ void phase13(KP p) {
  const int lane = get_tid() & 63, wave = get_tid() >> 6;
  const float* g = p->in[5];
  for (int row = blockIdx.x * 8 + wave; row < S_; row += gridDim.x * 8) {
    float* xr = p->out + (size_t)row * 2048;
    float4 v[8];
    float ss = 0.f;
#pragma unroll
    for (int j = 0; j < 8; j++) {
      v[j] = *(const float4*)(xr + lane * 4 + 256 * j);
      ss += v[j].x * v[j].x + v[j].y * v[j].y + v[j].z * v[j].z + v[j].w * v[j].w;
    }
    ss = wave_sum(ss);
    float rstd = rsqrtf(ss * (1.f / 2048.f) + 1e-6f);
#pragma unroll
    for (int j = 0; j < 8; j++) {
      int col = lane * 4 + 256 * j;
      float4 gg = *(const float4*)(g + col);
      float4 o;
      o.x = v[j].x * rstd * gg.x; o.y = v[j].y * rstd * gg.y; o.z = v[j].z * rstd * gg.z; o.w = v[j].w * rstd * gg.w;
      *(float4*)(xr + col) = o;
    }
  }
}

#include <vector>

#define XB_TMO      128
#define XB_XCNT(j)  (256  + 64 * (j))
#define XB_XSUB(j)  (1280 + 64 * (j))
#define XB_XGEN(j)  (2304 + 64 * (j))
#define XB_TOP      3328
#define XB_TOPGEN   3392
#define XCD_BAR_WORDS 3456
#define XB_SPIN_CAP (1u << 18)
#define LAS __attribute__((address_space(3)))

__device__ __forceinline__ unsigned xb_ld(unsigned* p)              { return __hip_atomic_load(p, __ATOMIC_RELAXED, __HIP_MEMORY_SCOPE_AGENT); }
__device__ __forceinline__ unsigned xb_add(unsigned* p, unsigned v) { return __hip_atomic_fetch_add(p, v, __ATOMIC_RELAXED, __HIP_MEMORY_SCOPE_AGENT); }
__device__ __forceinline__ unsigned xb_xcc_id() { return (unsigned)__builtin_amdgcn_s_getreg((3 << 11) | 20) & 0xFu; }
#define XB_SPIN(cond, bar) do { unsigned _sp = 0; while (cond) { __builtin_amdgcn_s_sleep(1); \
    if ((++_sp & 255u) == 0u) { if (xb_ld(&(bar)[XB_TMO])) break; if (_sp > XB_SPIN_CAP) { atomicAdd(&(bar)[XB_TMO], 1u); break; } } } } while (0)

struct XcdBarrier {
    unsigned* bar; unsigned x;
    volatile LAS unsigned* st;
};

__device__ __forceinline__ XcdBarrier xcd_barrier_post(unsigned* bar, volatile LAS unsigned* st) {
    XcdBarrier b; b.bar = bar; b.x = xb_xcc_id(); b.st = st;
    if (threadIdx.x == 0) (void)xb_add(&bar[XB_XCNT(b.x)], 1u);
    return b;
}
__device__ __forceinline__ void xcd_barrier_complete(unsigned* bar, unsigned x, unsigned& nloc, unsigned& nx) {
    const unsigned G = gridDim.x * gridDim.y * gridDim.z;
    unsigned sum, cnt, mine, sp = 0u;
    for (;;) {
        sum = 0u; cnt = 0u; mine = 0u;
#pragma unroll
        for (unsigned j = 0; j < 16; ++j) { const unsigned c = xb_ld(&bar[XB_XCNT(j)]); sum += c; cnt += (c > 0u) ? 1u : 0u; mine = (j == x) ? c : mine; }
        if (sum == G) break;
        __builtin_amdgcn_s_sleep(1);
        if ((++sp & 255u) == 0u) { if (xb_ld(&bar[XB_TMO])) break; if (sp > XB_SPIN_CAP) { atomicAdd(&bar[XB_TMO], 1u); break; } }
    }
    nloc = mine > 0u ? mine : 1u; nx = cnt > 0u ? cnt : 1u;
}

__device__ __forceinline__ void xcd_barrier(const XcdBarrier& b) {
    asm volatile("s_waitcnt vmcnt(0)" ::: "memory");
    __syncthreads();
    if (threadIdx.x == 0) {
        unsigned* bar = b.bar;
        __builtin_amdgcn_s_waitcnt(0);
        unsigned nloc = b.st[0], nx = b.st[1];
        if (nloc == 0u) { xcd_barrier_complete(bar, b.x, nloc, nx); b.st[0] = nloc; b.st[1] = nx; }
        const unsigned old = xb_add(&bar[XB_XSUB(b.x)], 1u);
        const unsigned gen = old / nloc;
        if (old + 1u == (gen + 1u) * nloc) {
            __builtin_amdgcn_fence(__ATOMIC_RELEASE, "agent");
            asm volatile("s_waitcnt vmcnt(0)" ::: "memory");
            const unsigned og = xb_add(&bar[XB_TOP], 1u);
            const unsigned tg = og / nx;
            if (og + 1u == (tg + 1u) * nx) xb_add(&bar[XB_TOPGEN], 1u);
            else XB_SPIN(xb_ld(&bar[XB_TOPGEN]) == tg, bar);
            __builtin_amdgcn_fence(__ATOMIC_ACQUIRE, "agent");
            xb_add(&bar[XB_XGEN(b.x)], 1u);
            asm volatile("s_waitcnt vmcnt(0)" ::: "memory");
        } else {
            XB_SPIN(xb_ld(&bar[XB_XGEN(b.x)]) == gen, bar);
            __builtin_amdgcn_fence(__ATOMIC_ACQUIRE, "agent");
            asm volatile("s_waitcnt vmcnt(0)" ::: "memory");
        }
    }
    __syncthreads();
}

__global__ void __launch_bounds__(NTHR) fwd_megakernel(Params p_unused) {
  extern __shared__ __attribute__((aligned(16))) char smem[];
  cg::grid_group grid = cg::this_grid();
  float* smf = (float*)smem;
  KP p = (KP)__builtin_amdgcn_kernarg_segment_ptr();
#define LAUNDER() asm volatile("" : "+s"(p))
  {
    volatile LAS unsigned* st0 = (volatile LAS unsigned*)(smem + 150528);
    if (threadIdx.x == 0) { st0[0] = 0u; st0[1] = 0u; st0[2] = 0u; st0[3] = 0u; }
    __syncthreads();
    (void)xcd_barrier_post((unsigned*)(p->ws + O_BAR), st0);
  }
#define GRID_BARRIER()                                                       \
  {                                                                          \
    XcdBarrier xb_;                                                          \
    xb_.bar = (unsigned*)(p->ws + O_BAR);                                    \
    xb_.x = xb_xcc_id();                                                     \
    xb_.st = (volatile LAS unsigned*)(smem + 150528);                        \
    xcd_barrier(xb_);                                                        \
  }
  phase0(p, smf);
  if (p->out == nullptr) grid.sync();
  GRID_BARRIER();
  LAUNDER();
  norm_phase(p, 0, p->in[0], (bf16_t*)(p->ws + O_H0), smf);
  GRID_BARRIER();
  LAUNDER();
  phase2(p, smem);
  GRID_BARRIER();
  LAUNDER();
  phase3(p, smem);
  GRID_BARRIER();
  LAUNDER();
  phase4(p, smem, 0);
  GRID_BARRIER();
  LAUNDER();
  outproj_phase(p, (const bf16_t*)(p->ws + O_Y), (const bf16_t*)(p->ws + O_WT_OUT), p->in[0], 0, smem);
  GRID_BARRIER();
  LAUNDER();
#if PROBE == 1
  phase2(p, smem);
  GRID_BARRIER();
  LAUNDER();
  phase3(p, smem);
  GRID_BARRIER();
  LAUNDER();
  phase4(p, smem, 1);
  GRID_BARRIER();
  LAUNDER();
  outproj_phase(p, (const bf16_t*)(p->ws + O_Y), (const bf16_t*)(p->ws + O_WT_OUT), p->in[0], 0, smem);
  GRID_BARRIER();
  LAUNDER();
#endif
#if PROBE == 2
  phase4(p, smem, 1);
  GRID_BARRIER();
  LAUNDER();
#endif
  norm_shift_phase(p, smf);
  GRID_BARRIER();
  LAUNDER();
  phase7(p, smem);
  GRID_BARRIER();
  LAUNDER();
  phase8(p, smem);
  GRID_BARRIER();
  LAUNDER();
  for (int half = 0; half < 2; half++) {
    phase9(p, half, smf);
    GRID_BARRIER();
    LAUNDER();
    phase10(p, half, smf);
    GRID_BARRIER();
    LAUNDER();
    phase10b(p, half, smf);
    GRID_BARRIER();
    LAUNDER();
  }
  outproj_phase(p, (const bf16_t*)(p->ws + O_YR), (const bf16_t*)(p->ws + O_WT_O), p->out, 1, smem);
  GRID_BARRIER();
  LAUNDER();
  phase13(p);
}

extern "C" void kernel_launch(void* const* d_in, const int* in_sizes, int n_in, void* d_out, int out_size, void* d_ws,
                              size_t ws_size, hipStream_t stream) {
  static int grid_blocks = 0;
  if (!grid_blocks) {
    int dev = 0, cus = 0, per_cu = 0;
    hipGetDevice(&dev);
    hipDeviceGetAttribute(&cus, hipDeviceAttributeMultiprocessorCount, dev);
    hipFuncSetAttribute((const void*)fwd_megakernel, hipFuncAttributeMaxDynamicSharedMemorySize, LDS_BYTES);
    hipOccupancyMaxActiveBlocksPerMultiprocessor(&per_cu, (const void*)fwd_megakernel, NTHR, LDS_BYTES);
    if (per_cu < 1) per_cu = 1;
    grid_blocks = cus * per_cu;
    if (ws_size < WS_NEED) fprintf(stderr, "workspace too small: %zu < %zu\n", ws_size, (size_t)WS_NEED);
  }
  Params hp{};
  for (int i = 0; i < 37; i++) hp.in[i] = (const float*)d_in[i];
  hp.out = (float*)d_out;
  hp.ws = (char*)d_ws;
  (void)hipMemsetAsync((char*)d_ws + O_BAR, 0, XCD_BAR_WORDS * sizeof(unsigned), stream);
  void* args[] = {&hp};
  hipError_t e = hipLaunchCooperativeKernel((const void*)fwd_megakernel, dim3(grid_blocks), dim3(NTHR), args, LDS_BYTES, stream);
  if (e != hipSuccess) fprintf(stderr, "cooperative launch failed: %s (grid %d)\n", hipGetErrorString(e), grid_blocks);
}
```

```cpp
#include <hip/hip_runtime.h>
#include <hip/hip_cooperative_groups.h>
#include <stdint.h>
#include <stdio.h>
namespace cg = cooperative_groups;

typedef unsigned short bf16_t;
using bf16x8 = __attribute__((ext_vector_type(8))) short;
using f32x4 = __attribute__((ext_vector_type(4))) float;

#ifndef PROBE
#define PROBE 0
#endif
#define S_ 8192
#define D_ 2048
#define NTHR 512

struct Params {
  const float* in[37];
  float* out;
  char* ws;
};
typedef const __attribute__((address_space(4))) Params* KP;

constexpr size_t MBy = 1u << 20;
constexpr size_t O_MODP = 0;
constexpr size_t O_MOD = 393216;
constexpr size_t O_CTR = 442368;
constexpr size_t O_CPE = 442624;
constexpr size_t O_W2T = 443392;
constexpr size_t O_HID = 459776;
constexpr size_t O_KCMP = 721920;
constexpr size_t O_VCMPT = 852992;
constexpr size_t O_BON = 984064;
constexpr size_t O_BAR = 2032640;
constexpr size_t O_WT_IN = 2 * MBy;
constexpr size_t O_WT_OUT = O_WT_IN + 20447232;
constexpr size_t O_WT_QB = O_WT_OUT + 8388608;
constexpr size_t O_WT_KVB = O_WT_QB + 1572864;
constexpr size_t O_W1T = O_WT_KVB + 2097152;
constexpr size_t O_WT_R = 34 * MBy;
constexpr size_t O_WT_K = 42 * MBy;
constexpr size_t O_WT_V = 50 * MBy;
constexpr size_t O_WT_Z = 58 * MBy;
constexpr size_t O_WT_O = 66 * MBy;
constexpr size_t O_WT_W1 = 74 * MBy;
constexpr size_t O_WT_A1 = O_WT_W1 + 524288;
constexpr size_t O_WT_W2 = O_WT_A1 + 524288;
constexpr size_t O_WT_A2 = O_WT_W2 + 524288;
constexpr size_t O_H0 = 76 * MBy;
constexpr size_t O_QN = 108 * MBy;
constexpr size_t O_KC = 124 * MBy;
constexpr size_t O_VC = O_KC + 2 * MBy + 65536;
constexpr size_t O_KS = O_VC + 2 * MBy + 65536;
constexpr size_t O_KW = O_KS + 2 * MBy;
constexpr size_t O_VST = O_KW + 2 * MBy;
constexpr size_t O_VWT = O_VST + 2 * MBy;
constexpr size_t O_ZN = 137 * MBy;
constexpr size_t O_ZM = 153 * MBy;
constexpr size_t O_QA = 169 * MBy;
constexpr size_t O_CKV = 177 * MBy;
constexpr size_t O_KPE = 185 * MBy;
constexpr size_t O_GATES = 187 * MBy;
constexpr size_t O_QM = 189 * MBy;
constexpr size_t O_KM = 213 * MBy;
constexpr size_t O_VMT = 237 * MBy;
constexpr size_t O_Y = 253 * MBy;
constexpr size_t O_ROPE = 285 * MBy;
constexpr size_t O_H1 = 76 * MBy;
constexpr size_t O_XK = 204 * MBy;
constexpr size_t O_XV = 236 * MBy;
constexpr size_t O_XZ = 268 * MBy;
constexpr size_t O_XW = 336 * MBy;
constexpr size_t O_XA = 2 * MBy;
constexpr size_t O_R = 108 * MBy;
constexpr size_t O_K = 140 * MBy;
constexpr size_t O_V = 172 * MBy;
constexpr size_t O_AB = 204 * MBy;
constexpr size_t O_LOGW = 236 * MBy;
constexpr size_t O_ZS = 300 * MBy;
constexpr size_t O_LW = 332 * MBy;
constexpr size_t O_LA = 334 * MBy;
constexpr size_t O_YRAW = 336 * MBy;
constexpr size_t O_S0 = 336 * MBy;
constexpr size_t O_CHP = 2 * MBy;
constexpr size_t O_CHQ = 34 * MBy;
constexpr size_t O_CHG = 76 * MBy;
constexpr size_t O_CHY = 92 * MBy;
constexpr size_t O_YR = 108 * MBy;
constexpr size_t WS_NEED = 368 * MBy;

constexpr int LDS_BYTES = 9 * 64 * 65 * 4 + 1024;

__device__ __forceinline__ int get_tid() { int t = threadIdx.x; asm volatile("" : "+v"(t)); return t; }
__device__ __forceinline__ float bf2f(bf16_t b) { return __uint_as_float(((uint32_t)b) << 16); }
typedef float float2_t __attribute__((ext_vector_type(2)));
typedef __bf16 bf16x2v __attribute__((ext_vector_type(2)));
__device__ __forceinline__ uint32_t pack2(float a, float b) {
  float2_t f = {a, b};
  bf16x2v h = __builtin_convertvector(f, bf16x2v);
  return *(uint32_t*)&h;
}
__device__ __forceinline__ bf16_t f2bf(float f) { return (bf16_t)(pack2(f, 0.f) & 0xffffu); }
__device__ __forceinline__ float siluf(float x) { return x / (1.f + __expf(-x)); }
__device__ __forceinline__ float sigmf(float x) { return 1.f / (1.f + __expf(-x)); }
__device__ __forceinline__ void unpack8(uint4 v, float* f) {
  f[0] = __uint_as_float(v.x << 16); f[1] = __uint_as_float(v.x & 0xffff0000u);
  f[2] = __uint_as_float(v.y << 16); f[3] = __uint_as_float(v.y & 0xffff0000u);
  f[4] = __uint_as_float(v.z << 16); f[5] = __uint_as_float(v.z & 0xffff0000u);
  f[6] = __uint_as_float(v.w << 16); f[7] = __uint_as_float(v.w & 0xffff0000u);
}
__device__ __forceinline__ f32x4 mfma_bf16(bf16x8 a, bf16x8 b, f32x4 c) {
  return __builtin_amdgcn_mfma_f32_16x16x32_bf16(a, b, c, 0, 0, 0);
}
__device__ __forceinline__ float4 ld_nt4(const float* p) {
  const f32x4 v = __builtin_nontemporal_load((const f32x4*)p);
  return float4{v[0], v[1], v[2], v[3]};
}
__device__ __forceinline__ float wave_sum(float v) {
#pragma unroll
  for (int o = 32; o > 0; o >>= 1) v += __shfl_xor(v, o);
  return v;
}

template <int AMODE, class Epi, class EpiS = int>
__device__ __forceinline__ void gemm_tile(const bf16_t* __restrict__ A, int lda, const bf16_t* __restrict__ Bt, int ldb,
                                          int K, int m0, int n0, char* smem, const float* __restrict__ mu, Epi epi, EpiS epiS = 0) {
  bf16_t* As = (bf16_t*)smem;
  const int tid = get_tid(), lane = tid & 63, wave = tid >> 6;
  const int wm = wave >> 1, wn = wave & 1, r = lane & 15, quad = lane >> 4;
  f32x4 acc[4][4];
#pragma unroll
  for (int i = 0; i < 4; i++)
#pragma unroll
    for (int j = 0; j < 4; j++) acc[i][j] = f32x4{0.f, 0.f, 0.f, 0.f};
  const int lrow = tid >> 3, lkc = (tid & 7) * 8;
  const int lsw = ((tid & 7) ^ (lrow & 7)) * 8;
  const int rsw0 = ((quad) ^ (r & 7)) * 8, rsw1 = ((4 + quad) ^ (r & 7)) * 8;
  uint4 xa0, xa1, xa2, xa3, xp0, xp1, xp2, xp3, xb0, xb1;
  const bf16_t* abase = A + (size_t)(m0 + lrow) * lda + lkc;
  const bf16_t* bbase = Bt + (size_t)(n0 + lrow) * ldb + lkc;
  const bool row0zero = (AMODE == 1) && (m0 + lrow == 0);
#define GL1(dst_, dstp_, i_, k0_)                                                     \
  {                                                                                   \
    const bf16_t* ap_ = abase + (size_t)(64 * (i_)) * lda + (k0_);                    \
    dst_ = *(const uint4*)ap_;                                                        \
    if (AMODE == 1) {                                                                 \
      if ((i_) == 0 && row0zero) dstp_ = uint4{0, 0, 0, 0};                           \
      else dstp_ = *(const uint4*)(ap_ - lda);                                        \
    }                                                                                 \
  }
#define GLOADS(...) GLOADS_(__VA_ARGS__)
#define GLOADS_(a0, a1, a2, a3, p0, p1, p2, p3, b0, b1, k0_)                           \
  {                                                                                   \
    __builtin_amdgcn_sched_barrier(0);                                                \
    GL1(a0, p0, 0, k0_) GL1(a1, p1, 1, k0_) GL1(a2, p2, 2, k0_) GL1(a3, p3, 3, k0_)   \
    b0 = *(const uint4*)(bbase + (k0_));                                              \
    b1 = *(const uint4*)(bbase + (size_t)64 * ldb + (k0_));                           \
    __builtin_amdgcn_sched_barrier(0);                                                \
  }
#define GS1(src_, srcp_, i_, As_, k0_)                                                                    \
  {                                                                                                       \
    uint4 v = src_;                                                                                       \
    if (AMODE == 1) {                                                                                     \
      float h[8], hp[8];                                                                                  \
      unpack8(src_, h);                                                                                   \
      unpack8(srcp_, hp);                                                                                 \
      const float4 m0v = *(const float4*)(mu + (k0_) + lkc);                                              \
      const float4 m1v = *(const float4*)(mu + (k0_) + lkc + 4);                                          \
      float o0 = h[0] + (hp[0] - h[0]) * m0v.x, o1 = h[1] + (hp[1] - h[1]) * m0v.y;                       \
      float o2 = h[2] + (hp[2] - h[2]) * m0v.z, o3 = h[3] + (hp[3] - h[3]) * m0v.w;                       \
      float o4 = h[4] + (hp[4] - h[4]) * m1v.x, o5 = h[5] + (hp[5] - h[5]) * m1v.y;                       \
      float o6 = h[6] + (hp[6] - h[6]) * m1v.z, o7 = h[7] + (hp[7] - h[7]) * m1v.w;                       \
      v.x = pack2(o0, o1); v.y = pack2(o2, o3); v.z = pack2(o4, o5); v.w = pack2(o6, o7);                 \
    }                                                                                                     \
    *(uint4*)(As_ + (lrow + 64 * (i_)) * 64 + lsw) = v;                                                   \
  }
#define GSTORES(...) GSTORES_(__VA_ARGS__)
#define GSTORES_(a0, a1, a2, a3, p0, p1, p2, p3, b0, b1, bi_, k0_)                      \
  {                                                                                   \
    bf16_t* As_ = As + (bi_) * (384 * 64);                                            \
    bf16_t* Bs_ = As_ + 256 * 64;                                                     \
    GS1(a0, p0, 0, As_, k0_) GS1(a1, p1, 1, As_, k0_) GS1(a2, p2, 2, As_, k0_) GS1(a3, p3, 3, As_, k0_) \
    *(uint4*)(Bs_ + lrow * 64 + lsw) = b0;                                            \
    *(uint4*)(Bs_ + (lrow + 64) * 64 + lsw) = b1;                                     \
  }
#define SET0 xa0, xa1, xa2, xa3, xp0, xp1, xp2, xp3, xb0, xb1
#define SET1 ya0, ya1, ya2, ya3, yp0, yp1, yp2, yp3, yb0, yb1
#define GCOMPUTE(bi_)                                                                                          \
  {                                                                                                            \
    const bf16_t* Ac = As + (bi_) * (384 * 64) + (wm * 64 + r) * 64;                                           \
    const bf16_t* Bc = As + (bi_) * (384 * 64) + 256 * 64 + (wn * 64 + r) * 64;                                \
    bf16x8 af0[4], bf0[4], af1[4], bf1[4];                                                                     \
    _Pragma("unroll") for (int mt = 0; mt < 4; mt++) af0[mt] = *(const bf16x8*)(Ac + mt * 1024 + rsw0);        \
    _Pragma("unroll") for (int nt = 0; nt < 4; nt++) bf0[nt] = *(const bf16x8*)(Bc + nt * 1024 + rsw0);        \
    _Pragma("unroll") for (int mt = 0; mt < 4; mt++) af1[mt] = *(const bf16x8*)(Ac + mt * 1024 + rsw1);        \
    _Pragma("unroll") for (int nt = 0; nt < 4; nt++) bf1[nt] = *(const bf16x8*)(Bc + nt * 1024 + rsw1);        \
    _Pragma("unroll") for (int mt = 0; mt < 4; mt++)                                                           \
      _Pragma("unroll") for (int nt = 0; nt < 4; nt++) acc[mt][nt] = mfma_bf16(af0[mt], bf0[nt], acc[mt][nt]); \
    _Pragma("unroll") for (int mt = 0; mt < 4; mt++)                                                           \
      _Pragma("unroll") for (int nt = 0; nt < 4; nt++) acc[mt][nt] = mfma_bf16(af1[mt], bf1[nt], acc[mt][nt]); \
  }
  const int nk = K >> 6;
  const int lastk = (nk - 1) * 64;
  GLOADS(SET0, 0);
  GSTORES(SET0, 0, 0);
  { const int kk1 = min(64, lastk); GLOADS(SET0, kk1); }
  __syncthreads();
  for (int it = 0; it < nk; it += 2) {
    if (it + 1 < nk) {
      const int ka = (it + 1) * 64, kb2 = min((it + 2) * 64, lastk);
      GSTORES(SET0, 1, ka);
      GLOADS(SET0, kb2);
    }
    GCOMPUTE(0);
    __syncthreads();
    if (it + 1 < nk) {
      const int ka = min((it + 2) * 64, lastk), kb2 = min((it + 3) * 64, lastk);
      GSTORES(SET0, 0, ka);
      GLOADS(SET0, kb2);
      GCOMPUTE(1);
      __syncthreads();
    }
  }
  epi(acc, m0 + wm * 64, n0 + wn * 64);
  if constexpr (!__is_same(EpiS, int)) {
    float* Cs = (float*)smem;
#pragma unroll
    for (int mt = 0; mt < 4; mt++)
#pragma unroll
      for (int nt = 0; nt < 4; nt++)
#pragma unroll
        for (int i = 0; i < 4; i++) Cs[(wm * 64 + mt * 16 + quad * 4 + i) * 132 + wn * 64 + nt * 16 + r] = acc[mt][nt][i];
    __syncthreads();
    epiS(Cs, m0, n0, tid);
    __syncthreads();
  }
}
#define STAGE_LOOP8(row, c8, va, vb)                        \
  for (int e_ = tid; e_ < 256 * 16; e_ += NTHR) {           \
    const int row = e_ >> 4, c8 = (e_ & 15) * 8;            \
    const float4 va = *(const float4*)(Cs + row * 132 + c8); \
    const float4 vb = *(const float4*)(Cs + row * 132 + c8 + 4);
#define STAGE_LOOP4(row, c4, va)                            \
  for (int e_ = tid; e_ < 256 * 32; e_ += NTHR) {           \
    const int row = e_ >> 5, c4 = (e_ & 31) * 4;            \
    const float4 va = *(const float4*)(Cs + row * 132 + c4);
#define STAGE_END }
__device__ __forceinline__ uint4 pack8(float4 a, float4 b) {
  uint4 u;
  u.x = pack2(a.x, a.y); u.y = pack2(a.z, a.w); u.z = pack2(b.x, b.y); u.w = pack2(b.z, b.w);
  return u;
}

__device__ __forceinline__ int g8_lds_byte(int r, int c) {
  int st = (r >> 4) * 2 + (c >> 5), rr = r & 15, cc = c & 31, ob = rr * 64 + cc * 2;
  return st * 1024 + (ob ^ (((ob >> 9) & 1) << 5));
}
__device__ __forceinline__ void g8_stage_rc(int b, int& R, int& C) {
  int st = b / 1024, sb = b % 1024, swz = sb ^ (((sb >> 9) & 1) << 5);
  R = (st >> 1) * 16 + swz / 64;
  C = (st & 1) * 32 + (swz % 64) / 2;
}
template <class EpiS>
__device__ __forceinline__ void gemm256_tile(const bf16_t* __restrict__ A, int lda, const bf16_t* __restrict__ Bt, int ldb, int K,
                                             int brow, int bcol, char* smem, EpiS epiS) {
  constexpr int G8_HT = 128 * 64;
  bf16_t* shm = (bf16_t*)smem;
  typedef __attribute__((address_space(1))) const void* gptr_t;
  typedef __attribute__((address_space(3))) void* lptr_t;
  const int tid = get_tid();
  const int wid = tid >> 6, lane = tid & 63, wr = wid >> 2, wc = wid & 3, fr = lane & 15, fq = lane >> 4;
  unsigned oa0, oa1, ob0, ob1;
  {
    int sr0, sc0, sr1, sc1;
    g8_stage_rc(tid * 16, sr0, sc0);
    g8_stage_rc(tid * 16 + 8192, sr1, sc1);
    oa0 = (unsigned)(sr0 * lda + sc0); oa1 = (unsigned)(sr1 * lda + sc1);
    ob0 = (unsigned)(sr0 * ldb + sc0); ob1 = (unsigned)(sr1 * ldb + sc1);
  }
#define G8_SA(b, h) (shm + ((b) * 2 + (h)) * G8_HT)
#define G8_SB(b, h) (shm + (4 + (b) * 2 + (h)) * G8_HT)
#define G8_STAGE(P, BASE, LD, br, kt, O0, O1)                                                                      \
  do {                                                                                                             \
    const bf16_t* g_ = (BASE) + (size_t)(br) * (LD) + (size_t)(kt) * 64;                                           \
    __builtin_amdgcn_global_load_lds((gptr_t)(g_ + O0), (lptr_t)((char*)(P) + tid * 16), 16, 0, 0);               \
    __builtin_amdgcn_global_load_lds((gptr_t)(g_ + O1), (lptr_t)((char*)(P) + tid * 16 + 8192), 16, 0, 0);        \
  } while (0)
#define G8_LDA(dst, b, h)                                                                                          \
  _Pragma("unroll") for (int m = 0; m < 4; ++m) _Pragma("unroll") for (int k = 0; k < 2; ++k)                      \
    dst[m][k] = *reinterpret_cast<const bf16x8*>((char*)G8_SA(b, h) + g8_lds_byte(wr * 64 + m * 16 + fr, k * 32 + fq * 8))
#define G8_LDB(dst, b, h)                                                                                          \
  _Pragma("unroll") for (int n = 0; n < 2; ++n) _Pragma("unroll") for (int k = 0; k < 2; ++k)                      \
    dst[n][k] = *reinterpret_cast<const bf16x8*>((char*)G8_SB(b, h) + g8_lds_byte(wc * 32 + n * 16 + fr, k * 32 + fq * 8))
#define G8_MMA(ai, bj, At_, Bt_)                                                                                   \
  do {                                                                                                             \
    __builtin_amdgcn_s_setprio(1);                                                                                 \
    _Pragma("unroll") for (int m = 0; m < 4; ++m) _Pragma("unroll") for (int n = 0; n < 2; ++n)                    \
      _Pragma("unroll") for (int k = 0; k < 2; ++k)                                                                \
        acc[ai][bj][m][n] = __builtin_amdgcn_mfma_f32_16x16x32_bf16(At_[m][k], Bt_[n][k], acc[ai][bj][m][n], 0, 0, 0); \
    __builtin_amdgcn_s_setprio(0);                                                                                 \
  } while (0)
#define G8_WAIT_V(n) asm volatile("s_waitcnt vmcnt(" #n ")" ::: "memory")
#define G8_WAIT_L(n) asm volatile("s_waitcnt lgkmcnt(" #n ")" ::: "memory")
#define G8_BAR __builtin_amdgcn_s_barrier()
#define G8_SCHED __builtin_amdgcn_sched_barrier(0)
  f32x4 acc[2][2][4][2];
#pragma unroll
  for (int a_ = 0; a_ < 2; a_++)
#pragma unroll
    for (int b_ = 0; b_ < 2; b_++)
#pragma unroll
      for (int m = 0; m < 4; m++)
#pragma unroll
        for (int n = 0; n < 2; n++) acc[a_][b_][m][n] = f32x4{0.f, 0.f, 0.f, 0.f};
  bf16x8 At[4][2], B0[2][2], B1[2][2];
  const int nt = K / 64;
  __syncthreads();
  G8_STAGE(G8_SB(0, 0), Bt, ldb, bcol, 0, ob0, ob1); G8_STAGE(G8_SA(0, 0), A, lda, brow, 0, oa0, oa1);
  G8_STAGE(G8_SB(0, 1), Bt, ldb, bcol + 128, 0, ob0, ob1); G8_STAGE(G8_SA(0, 1), A, lda, brow + 128, 0, oa0, oa1);
  if (wr == 1) G8_BAR;
  G8_WAIT_V(4); G8_BAR;
  G8_STAGE(G8_SB(1, 0), Bt, ldb, bcol, 1, ob0, ob1); G8_STAGE(G8_SA(1, 0), A, lda, brow, 1, oa0, oa1); G8_STAGE(G8_SB(1, 1), Bt, ldb, bcol + 128, 1, ob0, ob1);
  G8_WAIT_V(6); G8_BAR;
  for (int t = 0; t < nt - 2; t += 2) {
    G8_LDB(B0, 0, 0); G8_SCHED; G8_LDA(At, 0, 0); G8_STAGE(G8_SA(1, 1), A, lda, brow + 128, t + 1, oa0, oa1);
    G8_WAIT_L(8); G8_BAR; G8_WAIT_L(0); G8_MMA(0, 0, At, B0); G8_BAR; G8_SCHED;
    G8_LDB(B1, 0, 1); G8_STAGE(G8_SB(0, 0), Bt, ldb, bcol, t + 2, ob0, ob1);
    G8_BAR; G8_WAIT_L(0); G8_MMA(0, 1, At, B1); G8_BAR;
    G8_LDA(At, 0, 1); G8_STAGE(G8_SA(0, 0), A, lda, brow, t + 2, oa0, oa1);
    G8_BAR; G8_WAIT_L(0); G8_MMA(1, 0, At, B0); G8_BAR; G8_SCHED;
    G8_STAGE(G8_SB(0, 1), Bt, ldb, bcol + 128, t + 2, ob0, ob1);
    G8_WAIT_V(6); G8_BAR; G8_MMA(1, 1, At, B1); G8_BAR;
    G8_LDB(B0, 1, 0); G8_SCHED; G8_LDA(At, 1, 0); G8_STAGE(G8_SA(0, 1), A, lda, brow + 128, t + 2, oa0, oa1);
    G8_WAIT_L(8); G8_BAR; G8_WAIT_L(0); G8_MMA(0, 0, At, B0); G8_BAR; G8_SCHED;
    G8_LDB(B1, 1, 1); G8_STAGE(G8_SB(1, 0), Bt, ldb, bcol, t + 3, ob0, ob1);
    G8_BAR; G8_WAIT_L(0); G8_MMA(0, 1, At, B1); G8_BAR;
    G8_LDA(At, 1, 1); G8_STAGE(G8_SA(1, 0), A, lda, brow, t + 3, oa0, oa1);
    G8_BAR; G8_WAIT_L(0); G8_MMA(1, 0, At, B0); G8_BAR; G8_SCHED;
    G8_STAGE(G8_SB(1, 1), Bt, ldb, bcol + 128, t + 3, ob0, ob1);
    G8_WAIT_V(6); G8_BAR; G8_MMA(1, 1, At, B1); G8_BAR;
  }
  { G8_LDB(B0, 0, 0); G8_LDA(At, 0, 0); G8_STAGE(G8_SA(1, 1), A, lda, brow + 128, nt - 1, oa0, oa1);
    G8_BAR; G8_WAIT_L(0); G8_MMA(0, 0, At, B0); G8_BAR;
    G8_LDB(B1, 0, 1); G8_BAR; G8_WAIT_L(0); G8_MMA(0, 1, At, B1); G8_BAR;
    G8_LDA(At, 0, 1); G8_WAIT_V(4); G8_BAR; G8_WAIT_L(0); G8_MMA(1, 0, At, B0); G8_MMA(1, 1, At, B1); G8_BAR; }
  { G8_LDB(B0, 1, 0); G8_LDA(At, 1, 0); G8_WAIT_V(2); G8_BAR; G8_WAIT_L(0); G8_MMA(0, 0, At, B0); G8_BAR;
    G8_LDB(B1, 1, 1); G8_WAIT_V(0); G8_BAR; G8_WAIT_L(0); G8_MMA(0, 1, At, B1); G8_BAR;
    G8_LDA(At, 1, 1); G8_BAR; G8_WAIT_L(0); G8_MMA(1, 0, At, B0); G8_MMA(1, 1, At, B1); G8_BAR; }
  if (wr == 0) G8_BAR;
  float* Cs = (float*)smem;
#pragma unroll
  for (int bj = 0; bj < 2; bj++) {
    __syncthreads();
#pragma unroll
    for (int ai = 0; ai < 2; ai++)
#pragma unroll
      for (int m = 0; m < 4; m++)
#pragma unroll
        for (int n = 0; n < 2; n++)
#pragma unroll
          for (int j = 0; j < 4; j++)
            Cs[(ai * 128 + wr * 64 + m * 16 + fq * 4 + j) * 132 + wc * 32 + n * 16 + fr] = acc[ai][bj][m][n][j];
    __syncthreads();
    epiS(Cs, brow, bcol + bj * 128, tid);
  }
  __syncthreads();
}
__device__ __forceinline__ void g8_map(int wgid, int nM, int nN, int& pm, int& pn) {
  const int nwg = nM * nN;
  { int q = nwg / 8, r = nwg % 8, xcd = wgid % 8, off = wgid / 8;
    wgid = (xcd < r ? xcd * (q + 1) : r * (q + 1) + (xcd - r) * q) + off; }
  const int nig = 8 * nN, gid = wgid / nig, fm = gid * 8, gsz = min(nM - fm, 8);
  pm = fm + ((wgid % nig) % gsz);
  pn = (wgid % nig) / gsz;
}

__device__ __forceinline__ float rope_inv(int i) { return exp2f(-(float)i * (13.287712379549449f / 32.f)); }
__device__ __forceinline__ void conv_finish(float4 v0, float4 v1, float s0, float s1, bf16_t* __restrict__ dst, int lddst, int ndst0, int k0,
                                            float* sm) {
  const int tid = get_tid();
  const int kr = tid >> 4, nc = (tid & 15) * 4;
  sm[kr * 65 + nc + 0] = v0.x * s0; sm[kr * 65 + nc + 1] = v0.y * s0; sm[kr * 65 + nc + 2] = v0.z * s0; sm[kr * 65 + nc + 3] = v0.w * s0;
  sm[(kr + 32) * 65 + nc + 0] = v1.x * s1; sm[(kr + 32) * 65 + nc + 1] = v1.y * s1; sm[(kr + 32) * 65 + nc + 2] = v1.z * s1; sm[(kr + 32) * 65 + nc + 3] = v1.w * s1;
  __syncthreads();
  {
    int n = tid >> 3, kc = (tid & 7) * 8;
    float o[8];
#pragma unroll
    for (int j = 0; j < 8; j++) o[j] = sm[(kc + j) * 65 + n];
    uint4 v;
    v.x = pack2(o[0], o[1]); v.y = pack2(o[2], o[3]); v.z = pack2(o[4], o[5]); v.w = pack2(o[6], o[7]);
    *(uint4*)(dst + (size_t)(ndst0 + n) * lddst + k0 + kc) = v;
  }
  __syncthreads();
}

__device__ __forceinline__ void phase0(KP p, float* sm) {
  const int tid = get_tid();
  char* ws = p->ws;
  if (blockIdx.x == 0 && tid < 16) ((unsigned int*)(ws + O_CTR))[tid] = 0u;
  const int NCONV = 9410;
  bool have_prev = false;
  float4 pv0 = float4{0.f, 0.f, 0.f, 0.f}, pv1 = pv0;
  float ps0 = 1.f, ps1 = 1.f;
  bf16_t* pdst = nullptr;
  int plddst = 0, pndst0 = 0, pk0 = 0;
  const int total = 130 + NCONV;
  for (int item = blockIdx.x; item < total; item += gridDim.x) {
    if (item < 96) {
      int l = item / 48, rem = item % 48, cb = rem / 8, ks = rem % 8;
      int c4 = (tid & 255) * 4, rh = tid >> 8;
      const float* W = p->in[3] + (size_t)l * 2048 * 6144 + cb * 1024 + c4;
      const float* c = p->in[1];
      float4 a = float4{0.f, 0.f, 0.f, 0.f};
      int rbase = ks * 256 + rh * 128;
#pragma unroll 4
      for (int i = 0; i < 128; i++) {
        int row = rbase + i;
        float sc = siluf(c[row]);
        float4 w = ld_nt4(W + (size_t)row * 6144);
        a.x += sc * w.x; a.y += sc * w.y; a.z += sc * w.z; a.w += sc * w.w;
      }
      if (rh == 1) { sm[c4] = a.x; sm[c4 + 1] = a.y; sm[c4 + 2] = a.z; sm[c4 + 3] = a.w; }
      __syncthreads();
      if (rh == 0) {
        a.x += sm[c4]; a.y += sm[c4 + 1]; a.z += sm[c4 + 2]; a.w += sm[c4 + 3];
        float* dst = (float*)(ws + O_MODP) + (size_t)(ks * 2 + l) * 6144 + cb * 1024 + c4;
        *(float4*)dst = a;
      }
      __syncthreads();
    } else if (item < 98) {
      int ty = item - 96;
      const float* pe = p->in[ty ? 12 : 8];
      const float* w1 = p->in[ty ? 13 : 9];
      const float* b1 = p->in[ty ? 14 : 10];
      int e = tid & 63, part = tid >> 6;
      float a = 0.f;
      for (int i = 0; i < 256; i++) { int k = part * 256 + i; a += pe[k] * w1[(size_t)k * 64 + e]; }
      sm[part * 64 + e] = a;
      __syncthreads();
      if (tid < 64) {
        float s = b1[tid];
        for (int q = 0; q < 8; q++) s += sm[q * 64 + tid];
        ((float*)(ws + O_CPE))[ty * 64 + tid] = s;
      }
      __syncthreads();
    } else if (item < 130) {
      float* rope = (float*)(ws + O_ROPE);
      const int base = (item - 98) * 8192;
      for (int e = tid; e < 8192; e += NTHR) {
        const int idx = base + e, t = idx >> 5, ii = idx & 31;
        float sn, cs;
        sincosf((float)t * rope_inv(ii), &sn, &cs);
        *(float2*)(rope + (size_t)idx * 2) = float2{cs, sn};
      }
    } else {
      int ci = item - 130;
      const float* src; int ldsrc, Kvalid, ktiles; bf16_t* dst; int lddst; const float* scale = nullptr;
      int kt, nt, nsrc0, nvalid = 64, ndst0;
      if (ci < 2496) {
        src = p->in[6]; ldsrc = 4976; Kvalid = 2048; ktiles = 32; dst = (bf16_t*)(ws + O_WT_IN); lddst = 2048;
        kt = ci % 32; nt = ci / 32;
        int my = nt * 64;
        ndst0 = my;
        if (my < 1792) nsrc0 = my;
        else if (my < 3840) nsrc0 = my + 48;
        else if (my < 4864) nsrc0 = my + 112;
        else if (my < 4928) nsrc0 = my - 976;
        else { nsrc0 = 1792; nvalid = 48; }
      } else {
        ci -= 2496;
        int mid;
        if (ci < 1024) { mid = 1; }
        else if (ci < 1024 + 192) { mid = 2; ci -= 1024; }
        else if (ci < 1024 + 192 + 256) { mid = 3; ci -= 1216; }
        else if (ci < 1472 + 5120) { ci -= 1472; mid = 4 + ci / 1024; ci %= 1024; }
        else if (ci < 6592 + 128) { ci -= 6592; mid = 9 + ci / 64; ci %= 64; }
        else if (ci < 6720 + 128) { ci -= 6720; mid = 11 + ci / 64; ci %= 64; }
        else if (ci < 6848 + 64) { ci -= 6848; mid = 13 + ci / 32; ci %= 32; }
        else { ci -= 6912; mid = 15 + ci; ci = 0; }
        switch (mid) {
          case 1: src = p->in[7]; ldsrc = 2048; Kvalid = 2048; ktiles = 32; dst = (bf16_t*)(ws + O_WT_OUT); lddst = 2048; break;
          case 2: src = p->in[17]; ldsrc = 1536; Kvalid = 512; ktiles = 8; dst = (bf16_t*)(ws + O_WT_QB); lddst = 512; scale = p->in[16]; break;
          case 3: src = p->in[19]; ldsrc = 2048; Kvalid = 512; ktiles = 8; dst = (bf16_t*)(ws + O_WT_KVB); lddst = 512; scale = p->in[18]; break;
          case 4: src = p->in[21]; ldsrc = 2048; Kvalid = 2048; ktiles = 32; dst = (bf16_t*)(ws + O_WT_R); lddst = 2048; break;
          case 5: src = p->in[22]; ldsrc = 2048; Kvalid = 2048; ktiles = 32; dst = (bf16_t*)(ws + O_WT_K); lddst = 2048; break;
          case 6: src = p->in[23]; ldsrc = 2048; Kvalid = 2048; ktiles = 32; dst = (bf16_t*)(ws + O_WT_V); lddst = 2048; break;
          case 7: src = p->in[24]; ldsrc = 2048; Kvalid = 2048; ktiles = 32; dst = (bf16_t*)(ws + O_WT_Z); lddst = 2048; break;
          case 8: src = p->in[25]; ldsrc = 2048; Kvalid = 2048; ktiles = 32; dst = (bf16_t*)(ws + O_WT_O); lddst = 2048; break;
          case 9: src = p->in[27]; ldsrc = 96; Kvalid = 2048; ktiles = 32; dst = (bf16_t*)(ws + O_WT_W1); lddst = 2048; break;
          case 10: src = p->in[30]; ldsrc = 96; Kvalid = 2048; ktiles = 32; dst = (bf16_t*)(ws + O_WT_A1); lddst = 2048; break;
          case 11: src = p->in[28]; ldsrc = 2048; Kvalid = 96; ktiles = 2; dst = (bf16_t*)(ws + O_WT_W2); lddst = 128; break;
          case 12: src = p->in[31]; ldsrc = 2048; Kvalid = 96; ktiles = 2; dst = (bf16_t*)(ws + O_WT_A2); lddst = 128; break;
          case 13: src = p->in[9]; ldsrc = 64; Kvalid = 2048; ktiles = 32; dst = (bf16_t*)(ws + O_W1T); lddst = 2048; break;
          case 14: src = p->in[13]; ldsrc = 64; Kvalid = 2048; ktiles = 32; dst = (bf16_t*)(ws + O_W1T) + 64 * 2048; lddst = 2048; break;
          case 15: src = p->in[11]; ldsrc = 64; Kvalid = 64; ktiles = 1; dst = (bf16_t*)(ws + O_W2T); lddst = 64; break;
          default: src = p->in[15]; ldsrc = 64; Kvalid = 64; ktiles = 1; dst = (bf16_t*)(ws + O_W2T) + 64 * 64; lddst = 64; break;
        }
        kt = ci % ktiles; nt = ci / ktiles;
        nsrc0 = nt * 64; ndst0 = nt * 64;
        if (mid == 9 || mid == 10) { if (nt == 1) nvalid = 32; }
      }
      const int k0 = kt * 64;
      const int kr = tid >> 4, nc = (tid & 15) * 4;
      float4 v0 = float4{0.f, 0.f, 0.f, 0.f}, v1 = v0;
      float s0 = 1.f, s1 = 1.f;
      if (k0 + kr < Kvalid && nc < nvalid) {
        v0 = ld_nt4(src + (size_t)(k0 + kr) * ldsrc + nsrc0 + nc);
        if (scale) s0 = scale[k0 + kr];
      }
      if (k0 + kr + 32 < Kvalid && nc < nvalid) {
        v1 = ld_nt4(src + (size_t)(k0 + kr + 32) * ldsrc + nsrc0 + nc);
        if (scale) s1 = scale[k0 + kr + 32];
      }
      if (have_prev) conv_finish(pv0, pv1, ps0, ps1, pdst, plddst, pndst0, pk0, sm);
      pv0 = v0; pv1 = v1; ps0 = s0; ps1 = s1; pdst = dst; plddst = lddst; pndst0 = ndst0; pk0 = k0;
      have_prev = true;
    }
  }
  if (have_prev) conv_finish(pv0, pv1, ps0, ps1, pdst, plddst, pndst0, pk0, sm);
}

__device__ __forceinline__ void norm_phase(KP p, int layer, const float* __restrict__ xsrc, bf16_t* __restrict__ hdst, float* sm) {
  const int tid = get_tid(), lane = tid & 63, wave = tid >> 6;
  const float* modp = (const float*)(p->ws + O_MODP);
  const float* ada_b = p->in[4];
  const float* g = p->in[2] + layer * 2048;
  for (int col = tid; col < 2048; col += NTHR) {
    float sh = ada_b[layer * 6144 + col], sc = ada_b[layer * 6144 + 2048 + col];
    for (int ks = 0; ks < 8; ks++) {
      sh += modp[(size_t)(ks * 2 + layer) * 6144 + col];
      sc += modp[(size_t)(ks * 2 + layer) * 6144 + 2048 + col];
    }
    sm[col] = g[col] * (1.f + sc);
    sm[2048 + col] = sh;
  }
  if (layer == 0 && blockIdx.x == 0) {
    float* mod = (float*)(p->ws + O_MOD);
    for (int i = tid; i < 12288; i += NTHR) {
      int l = i / 6144, col = i % 6144;
      float v = ada_b[i];
      for (int ks = 0; ks < 8; ks++) v += modp[(size_t)(ks * 2 + l) * 6144 + col];
      mod[i] = v;
    }
  }
  __syncthreads();
  for (int row = blockIdx.x * 8 + wave; row < S_; row += gridDim.x * 8) {
    const float* xr = xsrc + (size_t)row * 2048;
    float4 v[8];
    float ss = 0.f;
#pragma unroll
    for (int j = 0; j < 8; j++) {
      v[j] = ld_nt4(xr + lane * 4 + 256 * j);
      ss += v[j].x * v[j].x + v[j].y * v[j].y + v[j].z * v[j].z + v[j].w * v[j].w;
    }
    ss = wave_sum(ss);
    float rstd = rsqrtf(ss * (1.f / 2048.f) + 1e-6f);
#pragma unroll
    for (int j = 0; j < 8; j++) {
      int col = lane * 4 + 256 * j;
      float o0 = v[j].x * rstd * sm[col] + sm[2048 + col];
      float o1 = v[j].y * rstd * sm[col + 1] + sm[2048 + col + 1];
      float o2 = v[j].z * rstd * sm[col + 2] + sm[2048 + col + 2];
      float o3 = v[j].w * rstd * sm[col + 3] + sm[2048 + col + 3];
      uint2 o;
      o.x = pack2(o0, o1); o.y = pack2(o2, o3);
      *(uint2*)(hdst + (size_t)row * 2048 + col) = o;
    }
  }
}

__device__ __forceinline__ void norm_shift_phase(KP p, float* sm) {
  const int tid = get_tid(), lane = tid & 63, wave = tid >> 6;
  const int layer = 1;
  char* ws = p->ws;
  const float* modp = (const float*)(ws + O_MODP);
  const float* ada_b = p->in[4];
  const float* g = p->in[2] + layer * 2048;
  const float* mu = p->in[20];
  const float* xsrc = p->out;
  for (int col = tid; col < 2048; col += NTHR) {
    float sh = ada_b[layer * 6144 + col], sc = ada_b[layer * 6144 + 2048 + col];
    for (int ks = 0; ks < 8; ks++) {
      sh += modp[(size_t)(ks * 2 + layer) * 6144 + col];
      sc += modp[(size_t)(ks * 2 + layer) * 6144 + 2048 + col];
    }
    sm[col] = g[col] * (1.f + sc);
    sm[2048 + col] = sh;
  }
  __syncthreads();
  bf16_t* dst0 = (bf16_t*)(ws + O_H1);
  bf16_t* dst1 = (bf16_t*)(ws + O_XW);
  bf16_t* dst2 = (bf16_t*)(ws + O_XK);
  bf16_t* dst3 = (bf16_t*)(ws + O_XV);
  bf16_t* dst4 = (bf16_t*)(ws + O_XA);
  bf16_t* dst5 = (bf16_t*)(ws + O_XZ);
  for (int row = blockIdx.x * 8 + wave; row < S_; row += gridDim.x * 8) {
    const float* xr = xsrc + (size_t)row * 2048;
    float4 v[8], vp[8];
    float ss = 0.f, sp = 0.f;
#pragma unroll
    for (int j = 0; j < 8; j++) {
      v[j] = *(const float4*)(xr + lane * 4 + 256 * j);
      ss += v[j].x * v[j].x + v[j].y * v[j].y + v[j].z * v[j].z + v[j].w * v[j].w;
      if (row > 0) vp[j] = *(const float4*)(xr - 2048 + lane * 4 + 256 * j);
      else vp[j] = float4{0.f, 0.f, 0.f, 0.f};
      sp += vp[j].x * vp[j].x + vp[j].y * vp[j].y + vp[j].z * vp[j].z + vp[j].w * vp[j].w;
    }
    ss = wave_sum(ss);
    sp = wave_sum(sp);
    const float rstd = rsqrtf(ss * (1.f / 2048.f) + 1e-6f);
    const float rstdp = rsqrtf(sp * (1.f / 2048.f) + 1e-6f);
#pragma unroll
    for (int j = 0; j < 8; j++) {
      const int col = lane * 4 + 256 * j;
      float h[4], hp[4];
      h[0] = v[j].x * rstd * sm[col] + sm[2048 + col];
      h[1] = v[j].y * rstd * sm[col + 1] + sm[2048 + col + 1];
      h[2] = v[j].z * rstd * sm[col + 2] + sm[2048 + col + 2];
      h[3] = v[j].w * rstd * sm[col + 3] + sm[2048 + col + 3];
      if (row > 0) {
        hp[0] = vp[j].x * rstdp * sm[col] + sm[2048 + col];
        hp[1] = vp[j].y * rstdp * sm[col + 1] + sm[2048 + col + 1];
        hp[2] = vp[j].z * rstdp * sm[col + 2] + sm[2048 + col + 2];
        hp[3] = vp[j].w * rstdp * sm[col + 3] + sm[2048 + col + 3];
      } else { hp[0] = hp[1] = hp[2] = hp[3] = 0.f; }
      const unsigned ob = ((unsigned)row * 2048u + (unsigned)col) * 2u;
#define MIXOUT(dst_, mi_)                                                              \
      {                                                                                \
        const float4 m4 = *(const float4*)(mu + (mi_) * 2048 + col);                   \
        uint2 u;                                                                       \
        u.x = pack2(h[0] + (hp[0] - h[0]) * m4.x, h[1] + (hp[1] - h[1]) * m4.y);       \
        u.y = pack2(h[2] + (hp[2] - h[2]) * m4.z, h[3] + (hp[3] - h[3]) * m4.w);       \
        *(uint2*)((char*)dst_ + ob) = u;                                               \
      }
      MIXOUT(dst0, 0) MIXOUT(dst1, 1) MIXOUT(dst2, 2) MIXOUT(dst3, 3) MIXOUT(dst4, 4) MIXOUT(dst5, 5)
    }
  }
}

__device__ __forceinline__ float4 silu4(float4 v) { return float4{siluf(v.x), siluf(v.y), siluf(v.z), siluf(v.w)}; }
__device__ __forceinline__ float4 sigm4(float4 v) { return float4{sigmf(v.x), sigmf(v.y), sigmf(v.z), sigmf(v.w)}; }
__device__ __forceinline__ void phase2(KP p, char* smem) {
  char* ws = p->ws;
  const bf16_t* A = (const bf16_t*)(ws + O_H0);
  const bf16_t* Bt = (const bf16_t*)(ws + O_WT_IN);
  const int lane = get_tid() & 63, r = lane & 15, quad = lane >> 4;
  bf16_t* qn = (bf16_t*)(ws + O_QN);
  bf16_t* zn = (bf16_t*)(ws + O_ZN);
  bf16_t* zm = (bf16_t*)(ws + O_ZM);
  bf16_t* qa = (bf16_t*)(ws + O_QA);
  bf16_t* ckv = (bf16_t*)(ws + O_CKV);
  float* kpe = (float*)(ws + O_KPE);
  float* gates = (float*)(ws + O_GATES);
  auto epiD = [&](f32x4(&acc)[4][4], int row0, int col0) {
    if (col0 < 1024 || col0 >= 1792) return;
    const int idx = (col0 - 1024) >> 7;
    if (idx != 3 && idx != 5) return;
#pragma unroll
    for (int nt = 0; nt < 4; nt++) {
      const int cc = col0 + nt * 16 + r - 1024, g = (cc >> 6) & 1, d = cc & 63;
#pragma unroll
      for (int mt = 0; mt < 4; mt++) {
        const int rw = row0 + mt * 16 + quad * 4;
        const f32x4 v = acc[mt][nt];
        bf16_t* dst = (bf16_t*)(ws + (idx == 3 ? O_VST : O_VWT)) + (((size_t)g * 256 + (rw >> 5)) * 64 + d) * 32 + (rw & 31);
        uint2 o; o.x = pack2(v[0], v[1]); o.y = pack2(v[2], v[3]);
        *(uint2*)dst = o;
      }
    }
  };
  auto epiS = [&](const float* Cs, int m0, int n0, int tid) {
    STAGE_LOOP8(row, c8, va, vb)
      const int c = n0 + c8;
      const size_t t = (size_t)(m0 + row);
      if (c < 1024) {
        *(uint4*)(qn + t * 1024 + c) = pack8(va, vb);
      } else if (c < 1792) {
        const int cc = c - 1024, idx = cc >> 7, g = (cc >> 6) & 1, d = cc & 63;
        if (idx != 3 && idx != 5) {
          const size_t off = idx == 0 ? O_KC : idx == 1 ? O_VC : idx == 2 ? O_KS : O_KW;
          *(uint4*)((bf16_t*)(ws + off) + ((size_t)g * S_ + t) * 64 + d) = pack8(va, vb);
        }
      } else if (c < 2816) {
        *(uint4*)(zn + t * 1024 + (c - 1792)) = pack8(silu4(va), silu4(vb));
      } else if (c < 3328) {
        *(uint4*)(qa + t * 512 + (c - 2816)) = pack8(va, vb);
      } else if (c < 3840) {
        *(uint4*)(ckv + t * 512 + (c - 3328)) = pack8(va, vb);
      } else if (c < 4864) {
        *(uint4*)(zm + t * 1024 + (c - 3840)) = pack8(silu4(va), silu4(vb));
      } else if (c < 4928) {
        *(float4*)(kpe + t * 64 + (c - 4864)) = va;
        *(float4*)(kpe + t * 64 + (c - 4864) + 4) = vb;
      } else if (c < 4976) {
        *(float4*)(gates + t * 48 + (c - 4928)) = sigm4(va);
        *(float4*)(gates + t * 48 + (c - 4928) + 4) = sigm4(vb);
      }
    STAGE_END
  };
  auto epiS2 = [&](const float* Cs, int m0, int n0, int tid) {
    if (n0 == 1408 || n0 == 1664) {
      bf16_t* vb_ = (bf16_t*)(ws + (n0 == 1408 ? O_VST : O_VWT));
      for (int e_ = tid; e_ < 128 * 32; e_ += NTHR) {
        const int col = e_ & 127, rg = e_ >> 7;
        float f[8];
#pragma unroll
        for (int j = 0; j < 8; j++) f[j] = Cs[(rg * 8 + j) * 132 + col];
        const int t = m0 + rg * 8, g = col >> 6, d = col & 63;
        uint4 u;
        u.x = pack2(f[0], f[1]); u.y = pack2(f[2], f[3]); u.z = pack2(f[4], f[5]); u.w = pack2(f[6], f[7]);
        *(uint4*)(vb_ + (((size_t)g * 256 + (t >> 5)) * 64 + d) * 32 + (t & 31)) = u;
      }
    } else {
      epiS(Cs, m0, n0, tid);
    }
  };
  auto epiNone = [&](f32x4(&acc)[4][4], int row0, int col0) {};
  (void)epiD;
  const int nbig = 32 * 16, nsmall = 32 * 7;
  for (int t = blockIdx.x; t < nbig + nsmall; t += gridDim.x) {
    if (t < nbig) {
      int pm, pn;
      g8_map(t, 32, 16, pm, pn);
      gemm256_tile(A, 2048, Bt, 2048, 2048, pm * 256, pn * 256, smem, epiS2);
    } else {
      const int u = t - nbig;
      const int mt = u & 31, nt = 32 + (u >> 5);
      gemm_tile<0>(A, 2048, Bt, 2048, 2048, mt * 256, nt * 128, smem, nullptr, epiNone, epiS);
    }
  }
}


__device__ __forceinline__ void phase3(KP p, char* smem) {
  char* ws = p->ws;
  float* rstd_s = (float*)(smem + 136 * 1024);
  const float* rope = (const float*)(ws + O_ROPE);
  auto epiNone = [&](f32x4(&acc)[4][4], int row0, int col0) {};
  const int total = 8 + 192 + 256 + 32;
  for (int item = blockIdx.x; item < total; item += gridDim.x) {
    if (item < 8) {
      int prob = item >> 1, mtile = item & 1;
      int ty = prob >> 1, g = prob & 1;
      const bf16_t* A = (const bf16_t*)(ws + (ty ? O_VC : O_KC)) + (size_t)g * S_ * 64;
      const bf16_t* Bt = (const bf16_t*)(ws + O_W1T);
      bf16_t* hid = (bf16_t*)(ws + O_HID) + (size_t)prob * 512 * 64;
      const float* cpe = (const float*)(ws + O_CPE) + ty * 64;
      auto epi1 = [&](f32x4(&acc)[4][4], int row0, int col0) {
        if ((col0 >> 6) != ty) return;
        const int lane = get_tid() & 63, r = lane & 15, quad = lane >> 4;
#pragma unroll
        for (int nt = 0; nt < 4; nt++) {
          int e = nt * 16 + r;
          float b = cpe[e];
#pragma unroll
          for (int mt = 0; mt < 4; mt++) {
            int rw = row0 + mt * 16 + quad * 4;
#pragma unroll
            for (int i = 0; i < 4; i++) hid[(size_t)(rw + i) * 64 + e] = f2bf(siluf(acc[mt][nt][i] + b));
          }
        }
      };
      gemm_tile<0>(A, 1024, Bt, 2048, 2048, mtile * 256, 0, smem, nullptr, epi1);
      __threadfence();
      __syncthreads();
      bf16_t* kcmp = (bf16_t*)(ws + O_KCMP) + (size_t)g * 512 * 64;
      bf16_t* vcmpT = (bf16_t*)(ws + O_VCMPT) + (size_t)g * 64 * 512;
      auto epi2 = [&](f32x4(&acc)[4][4], int row0, int col0) {
        if ((col0 >> 6) != ty) return;
        const int lane = get_tid() & 63, r = lane & 15, quad = lane >> 4;
#pragma unroll
        for (int nt = 0; nt < 4; nt++) {
          int d = nt * 16 + r;
#pragma unroll
          for (int mt = 0; mt < 4; mt++) {
            int rw = row0 + mt * 16 + quad * 4;
            f32x4 v = acc[mt][nt];
#pragma unroll
            for (int i = 0; i < 4; i++) if (rw + i >= 511) v[i] = 0.f;
            if (ty == 0) {
#pragma unroll
              for (int i = 0; i < 4; i++) kcmp[(size_t)(rw + i) * 64 + d] = f2bf(v[i]);
            } else {
              uint2 o; o.x = pack2(v[0], v[1]); o.y = pack2(v[2], v[3]);
              *(uint2*)(vcmpT + ((size_t)(rw >> 5) * 64 + d) * 32 + (rw & 31)) = o;
            }
          }
        }
      };
      gemm_tile<0>(hid, 64, (const bf16_t*)(ws + O_W2T), 64, 64, mtile * 256, 0, smem, nullptr, epi2);
    } else if (item < 8 + 192 + 256) {
      int it = item - 8;
      bool isq = it < 192;
      if (!isq) it -= 192;
      int mt_, nt_;
      g8_map(it, 32, isq ? 6 : 8, mt_, nt_);
      const bf16_t* A = (const bf16_t*)(ws + (isq ? O_QA : O_CKV));
      __syncthreads();
      {
        const int tid = get_tid();
        int row = tid >> 1, hf = tid & 1;
        const bf16_t* ap = A + (size_t)(mt_ * 256 + row) * 512 + hf * 256;
        float ss = 0.f;
#pragma unroll 4
        for (int j = 0; j < 32; j++) {
          float f[8];
          unpack8(*(const uint4*)(ap + j * 8), f);
#pragma unroll
          for (int q = 0; q < 8; q++) ss += f[q] * f[q];
        }
        ss += __shfl_xor(ss, 1);
        if (hf == 0) rstd_s[row] = rsqrtf(ss * (1.f / 512.f) + 1e-6f);
      }
      __syncthreads();
      if (isq) {
        bf16_t* qm = (bf16_t*)(ws + O_QM);
        auto epiS = [&](const float* Cs, int m0, int n0, int tid) {
          STAGE_LOOP8(row, c8, va, vb)
            const int c = n0 + c8, hd = c / 192, dd = c - hd * 192;
            const int t = m0 + row;
            const float rs = rstd_s[row];
            bf16_t* dst = qm + ((size_t)hd * S_ + t) * 192;
            if (dd < 128) {
              float4 a = va, b = vb;
              a.x *= rs; a.y *= rs; a.z *= rs; a.w *= rs; b.x *= rs; b.y *= rs; b.z *= rs; b.w *= rs;
              *(uint4*)(dst + dd) = pack8(a, b);
            } else if (dd < 160) {
              const int i0 = dd - 128;
              const float4 xa = *(const float4*)(Cs + row * 132 + c8 + 32), xb = *(const float4*)(Cs + row * 132 + c8 + 36);
              const float x1[8] = {va.x * rs, va.y * rs, va.z * rs, va.w * rs, vb.x * rs, vb.y * rs, vb.z * rs, vb.w * rs};
              const float x2[8] = {xa.x * rs, xa.y * rs, xa.z * rs, xa.w * rs, xb.x * rs, xb.y * rs, xb.z * rs, xb.w * rs};
              const float* rp = rope + ((size_t)t * 32 + i0) * 2;
              float o1[8], o2[8];
#pragma unroll
              for (int j = 0; j < 4; j++) {
                const float4 cs = *(const float4*)(rp + 4 * j);
                o1[2 * j] = x1[2 * j] * cs.x - x2[2 * j] * cs.y;
                o2[2 * j] = x1[2 * j] * cs.y + x2[2 * j] * cs.x;
                o1[2 * j + 1] = x1[2 * j + 1] * cs.z - x2[2 * j + 1] * cs.w;
                o2[2 * j + 1] = x1[2 * j + 1] * cs.w + x2[2 * j + 1] * cs.z;
              }
              uint4 u1, u2;
              u1.x = pack2(o1[0], o1[1]); u1.y = pack2(o1[2], o1[3]); u1.z = pack2(o1[4], o1[5]); u1.w = pack2(o1[6], o1[7]);
              u2.x = pack2(o2[0], o2[1]); u2.y = pack2(o2[2], o2[3]); u2.z = pack2(o2[4], o2[5]); u2.w = pack2(o2[6], o2[7]);
              *(uint4*)(dst + 128 + i0) = u1;
              *(uint4*)(dst + 160 + i0) = u2;
            }
          STAGE_END
        };
        gemm256_tile(A, 512, (const bf16_t*)(ws + O_WT_QB), 512, 512, mt_ * 256, nt_ * 256, smem, epiS);
      } else {
        bf16_t* km = (bf16_t*)(ws + O_KM);
        bf16_t* vmT = (bf16_t*)(ws + O_VMT);
        auto epiD = [&](f32x4(&acc)[4][4], int row0, int col0) {
          const int lane = get_tid() & 63, r = lane & 15, quad = lane >> 4;
          int hd = col0 >> 8, dd0 = col0 & 255;
          if (dd0 < 128) return;
          int lrow0 = row0 - mt_ * 256;
#pragma unroll
          for (int nt = 0; nt < 4; nt++)
#pragma unroll
            for (int mt = 0; mt < 4; mt++) {
              int rl = lrow0 + mt * 16 + quad * 4;
              int t = mt_ * 256 + rl;
              f32x4 v = acc[mt][nt];
#pragma unroll
              for (int i = 0; i < 4; i++) v[i] *= rstd_s[rl + i];
              int d = dd0 - 128 + nt * 16 + r;
              uint2 o; o.x = pack2(v[0], v[1]); o.y = pack2(v[2], v[3]);
              *(uint2*)(vmT + ((size_t)hd * 128 + d) * S_ + t) = o;
            }
        };
        auto epiS = [&](const float* Cs, int m0, int n0, int tid) {
          STAGE_LOOP8(row, c8, va, vb)
            const int c = n0 + c8, hd = c >> 8, dd = c & 255;
            if (dd < 128) {
              const float rs = rstd_s[row];
              float4 a = va, b = vb;
              a.x *= rs; a.y *= rs; a.z *= rs; a.w *= rs; b.x *= rs; b.y *= rs; b.z *= rs; b.w *= rs;
              *(uint4*)(km + ((size_t)hd * S_ + m0 + row) * 192 + dd) = pack8(a, b);
            }
          STAGE_END
        };
        (void)epiD;
        auto epiS2 = [&](const float* Cs, int m0, int n0, int tid) {
          if ((n0 & 255) == 128) {
            const int hd = n0 >> 8;
            for (int e_ = tid; e_ < 128 * 32; e_ += NTHR) {
              const int col = e_ & 127, rg = e_ >> 7;
              float f[8];
#pragma unroll
              for (int j = 0; j < 8; j++) f[j] = Cs[(rg * 8 + j) * 132 + col] * rstd_s[rg * 8 + j];
              uint4 u;
              u.x = pack2(f[0], f[1]); u.y = pack2(f[2], f[3]); u.z = pack2(f[4], f[5]); u.w = pack2(f[6], f[7]);
              *(uint4*)(vmT + ((size_t)hd * 128 + col) * S_ + m0 + rg * 8) = u;
            }
          } else {
            epiS(Cs, m0, n0, tid);
          }
        };
        gemm256_tile(A, 512, (const bf16_t*)(ws + O_WT_KVB), 512, 512, mt_ * 256, nt_ * 256, smem, epiS2);
      }
    } else {
      int it = item - (8 + 192 + 256);
      const float* kpe = (const float*)(ws + O_KPE);
      bf16_t* km = (bf16_t*)(ws + O_KM);
      const int tid = get_tid();
      for (int e = tid; e < 256 * 32; e += NTHR) {
        int t = it * 256 + (e >> 5), ii = e & 31;
        float x1 = kpe[(size_t)t * 64 + ii], x2 = kpe[(size_t)t * 64 + 32 + ii];
        const float2 cs = *(const float2*)(rope + ((size_t)t * 32 + ii) * 2);
        bf16_t o1 = f2bf(x1 * cs.x - x2 * cs.y), o2 = f2bf(x1 * cs.y + x2 * cs.x);
#pragma unroll
        for (int hd = 0; hd < 8; hd++) {
          bf16_t* dst = km + ((size_t)hd * S_ + t) * 192 + 128;
          dst[ii] = o1; dst[32 + ii] = o2;
        }
      }
    }
  }
}

template <int DQK, int NCT>
__device__ __forceinline__ void qk_step(const bf16_t* __restrict__ Kb, int ldk, int kb, const bf16x8 (&qf)[DQK / 32][NCT],
                                        f32x4 (&s)[2][NCT], int r, int quad) {
#pragma unroll
  for (int sub = 0; sub < 2; sub++) {
    const bf16_t* kp = Kb + (size_t)(kb + sub * 16 + r) * ldk + quad * 8;
#pragma unroll
    for (int ct = 0; ct < NCT; ct++) s[sub][ct] = f32x4{0.f, 0.f, 0.f, 0.f};
#pragma unroll
    for (int ks = 0; ks < DQK / 32; ks++) {
      bf16x8 kf = *(const bf16x8*)(kp + ks * 32);
#pragma unroll
      for (int ct = 0; ct < NCT; ct++) s[sub][ct] = mfma_bf16(kf, qf[ks][ct], s[sub][ct]);
    }
  }
}

template <int DV, int NCT>
__device__ __forceinline__ void pv_step(const bf16_t* __restrict__ VT, size_t ldv, int kb, const bf16x8 (&pf)[NCT],
                                        f32x4 (&o)[DV / 16][NCT], int r, int quad) {
#pragma unroll
  for (int dt = 0; dt < DV / 16; dt++) {
    const bf16_t* vp = VT + (size_t)(dt * 16 + r) * ldv + kb + quad * 4;
    uint2 lo = *(const uint2*)vp;
    uint2 hi = *(const uint2*)(vp + 16);
    uint4 u = uint4{lo.x, lo.y, hi.x, hi.y};
    bf16x8 vf = *(bf16x8*)&u;
#pragma unroll
    for (int ct = 0; ct < NCT; ct++) o[dt][ct] = mfma_bf16(vf, pf[ct], o[dt][ct]);
  }
}

template <int DV>
__device__ __forceinline__ bf16x8 softmax_step(float (&sc)[8], unsigned vmask, float& m, float& l, f32x4 (&o)[DV / 16][1]) {
  return bf16x8{};
}

__device__ __forceinline__ float quad_max(float v) {
  v = fmaxf(v, __shfl_xor(v, 16));
  v = fmaxf(v, __shfl_xor(v, 32));
  return v;
}
__device__ __forceinline__ float quad_sum(float v) {
  v += __shfl_xor(v, 16);
  v += __shfl_xor(v, 32);
  return v;
}

#define SOFTMAX_UPDATE(DVT, NCTV, ct, sc, vm, mvar, lvar, oarr, pfout)                                   \
  {                                                                                                      \
    float mx_ = -1e30f;                                                                                  \
    _Pragma("unroll") for (int j_ = 0; j_ < 8; j_++) if ((vm >> j_) & 1) mx_ = fmaxf(mx_, sc[j_]);       \
    mx_ = quad_max(mx_);                                                                                 \
    const float mn_ = fmaxf(mvar, mx_);                                                                  \
    if (__ballot(mn_ > mvar) != 0ull) {                                                                  \
      const float al_ = __builtin_amdgcn_exp2f(mvar - mn_);                                              \
      lvar *= al_;                                                                                       \
      _Pragma("unroll") for (int dt_ = 0; dt_ < DVT / 16; dt_++) {                                       \
        oarr[dt_][ct][0] *= al_; oarr[dt_][ct][1] *= al_; oarr[dt_][ct][2] *= al_; oarr[dt_][ct][3] *= al_; \
      }                                                                                                  \
      mvar = mn_;                                                                                        \
    }                                                                                                    \
    float pp_[8];                                                                                        \
    float ls_ = 0.f;                                                                                     \
    _Pragma("unroll") for (int j_ = 0; j_ < 8; j_++) {                                                   \
      pp_[j_] = ((vm >> j_) & 1) ? __builtin_amdgcn_exp2f(sc[j_] - mn_) : 0.f;                           \
      ls_ += pp_[j_];                                                                                    \
    }                                                                                                    \
    lvar += ls_;                                                                                         \
    uint4 u_;                                                                                            \
    u_.x = pack2(pp_[0], pp_[1]); u_.y = pack2(pp_[2], pp_[3]);                                          \
    u_.z = pack2(pp_[4], pp_[5]); u_.w = pack2(pp_[6], pp_[7]);                                          \
    pfout = *(bf16x8*)&u_;                                                                               \
  }

#define SOFTMAX_UPDATE16(DVT, ct, sc, vm, mvar, lvar, oarr, pfa, pfb)                                    \
  {                                                                                                      \
    float mx_ = -1e30f;                                                                                  \
    _Pragma("unroll") for (int j_ = 0; j_ < 16; j_++) if ((vm >> j_) & 1) mx_ = fmaxf(mx_, sc[j_]);      \
    mx_ = quad_max(mx_);                                                                                 \
    const float mn_ = fmaxf(mvar, mx_);                                                                  \
    if (__ballot(mn_ > mvar) != 0ull) {                                                                  \
      const float al_ = __builtin_amdgcn_exp2f(mvar - mn_);                                              \
      lvar *= al_;                                                                                       \
      _Pragma("unroll") for (int dt_ = 0; dt_ < DVT / 16; dt_++) {                                       \
        oarr[dt_][ct][0] *= al_; oarr[dt_][ct][1] *= al_; oarr[dt_][ct][2] *= al_; oarr[dt_][ct][3] *= al_; \
      }                                                                                                  \
      mvar = mn_;                                                                                        \
    }                                                                                                    \
    float pp_[16];                                                                                       \
    float ls_ = 0.f;                                                                                     \
    _Pragma("unroll") for (int j_ = 0; j_ < 16; j_++) {                                                  \
      pp_[j_] = ((vm >> j_) & 1) ? __builtin_amdgcn_exp2f(sc[j_] - mn_) : 0.f;                           \
      ls_ += pp_[j_];                                                                                    \
    }                                                                                                    \
    lvar += ls_;                                                                                         \
    uint4 ua_, ub_;                                                                                      \
    ua_.x = pack2(pp_[0], pp_[1]); ua_.y = pack2(pp_[2], pp_[3]);                                        \
    ua_.z = pack2(pp_[4], pp_[5]); ua_.w = pack2(pp_[6], pp_[7]);                                        \
    ub_.x = pack2(pp_[8], pp_[9]); ub_.y = pack2(pp_[10], pp_[11]);                                      \
    ub_.z = pack2(pp_[12], pp_[13]); ub_.w = pack2(pp_[14], pp_[15]);                                    \
    pfa = *(bf16x8*)&ua_;                                                                                \
    pfb = *(bf16x8*)&ub_;                                                                                \
  }

struct KF { bf16x8 k[2][2]; };
struct VF { bf16x8 v[4]; };
__device__ __forceinline__ void load_kf(KF& f, const bf16_t* __restrict__ Kb, int kb, int r, int quad) {
#pragma unroll
  for (int sub = 0; sub < 2; sub++)
#pragma unroll
    for (int ks = 0; ks < 2; ks++) f.k[sub][ks] = *(const bf16x8*)(Kb + (size_t)(kb + sub * 16 + r) * 64 + ks * 32 + quad * 8);
}
__device__ __forceinline__ void load_vf(VF& f, const bf16_t* __restrict__ VT, size_t ldv, int kb, int r, int quad) {
  (void)ldv;
  const bf16_t* vb = VT + (size_t)(kb >> 5) * 2048 + r * 32 + quad * 4;
#pragma unroll
  for (int dt = 0; dt < 4; dt++) {
    const bf16_t* vp = vb + dt * 512;
    uint2 lo = *(const uint2*)vp;
    uint2 hi = *(const uint2*)(vp + 16);
    uint4 u = uint4{lo.x, lo.y, hi.x, hi.y};
    f.v[dt] = *(bf16x8*)&u;
  }
}
__device__ __forceinline__ void qk_from(const KF& f, const bf16x8 (&qf)[2][2], f32x4 (&s)[2][2]) {
#pragma unroll
  for (int sub = 0; sub < 2; sub++)
#pragma unroll
    for (int ct = 0; ct < 2; ct++) {
      s[sub][ct] = f32x4{0.f, 0.f, 0.f, 0.f};
#pragma unroll
      for (int ks = 0; ks < 2; ks++) s[sub][ct] = mfma_bf16(f.k[sub][ks], qf[ks][ct], s[sub][ct]);
    }
}
__device__ __forceinline__ void pv_from(const VF& f, const bf16x8 (&pf)[2], f32x4 (&o)[4][2]) {
#pragma unroll
  for (int dt = 0; dt < 4; dt++)
#pragma unroll
    for (int ct = 0; ct < 2; ct++) o[dt][ct] = mfma_bf16(f.v[dt], pf[ct], o[dt][ct]);
}

__device__ __forceinline__ void nsa_item(KP p, int g, int tile, float* wsm) {
  char* ws = p->ws;
  const int lane = get_tid() & 63, r = lane & 15, quad = lane >> 4;
  float* impc = wsm;
  float* vals = wsm + 2048;
  const bf16_t* qn = (const bf16_t*)(ws + O_QN);
  const bf16_t* kcmp = (const bf16_t*)(ws + O_KCMP) + (size_t)g * 512 * 64;
  const bf16_t* vcmpT = (const bf16_t*)(ws + O_VCMPT) + (size_t)g * 64 * 512;
  const bf16_t* ksb = (const bf16_t*)(ws + O_KS) + (size_t)g * S_ * 64;
  const bf16_t* kwb = (const bf16_t*)(ws + O_KW) + (size_t)g * S_ * 64;
  const bf16_t* vsT = (const bf16_t*)(ws + O_VST) + (size_t)g * 64 * S_;
  const bf16_t* vwT = (const bf16_t*)(ws + O_VWT) + (size_t)g * 64 * S_;
  const float* gates = (const float*)(ws + O_GATES);
  const int t0 = tile * 4;
  const int head = g * 8 + (r & 7);
  const float slope = exp2f(-0.5f * (float)(head + 1)) * 1.4426950408889634f;
  const float qs2 = 0.125f * 1.4426950408889634f;
  int tok[2];
  bf16x8 qf[2][2];
#pragma unroll
  for (int ct = 0; ct < 2; ct++) {
    tok[ct] = t0 + ct * 2 + (r >> 3);
#pragma unroll
    for (int ks = 0; ks < 2; ks++) qf[ks][ct] = *(const bf16x8*)(qn + (size_t)tok[ct] * 1024 + head * 64 + ks * 32 + quad * 8);
  }
  f32x4 oacc[4][2];
#pragma unroll
  for (int dt = 0; dt < 4; dt++)
#pragma unroll
    for (int ct = 0; ct < 2; ct++) oacc[dt][ct] = f32x4{0.f, 0.f, 0.f, 0.f};
  f32x4 o[4][2];
  float m[2], l[2];
  for (int i = lane; i < 2048; i += 64) impc[i] = 0.f;
  const int tlast = t0 + 3;
  if (tlast >= 31) {
    const int nmax = (tlast - 31) >> 4;
    const int nsteps = (nmax >> 5) + 1;
    const int lastkb = (nsteps - 1) * 32;
    m[0] = m[1] = -1e30f; l[0] = l[1] = 0.f;
    {
      KF kc_, kn_;
      load_kf(kc_, kcmp, 0, r, quad);
      for (int st = 0; st < nsteps; st++) {
        const int kb = st * 32;
        load_kf(kn_, kcmp, min(kb + 32, lastkb), r, quad);
        f32x4 s[2][2];
        qk_from(kc_, qf, s);
#pragma unroll
        for (int ct = 0; ct < 2; ct++) {
          float mx = -1e30f;
          float sc[8];
          unsigned vm = 0;
#pragma unroll
          for (int j = 0; j < 8; j++) {
            int n = kb + (j >> 2) * 16 + quad * 4 + (j & 3);
            int ce = n * 16 + 31;
            sc[j] = s[j >> 2][ct][j & 3] * qs2 - slope * (float)(tok[ct] - ce);
            if (ce <= tok[ct]) { vm |= 1u << j; mx = fmaxf(mx, sc[j]); }
          }
          mx = quad_max(mx);
          float mn = fmaxf(m[ct], mx);
          float al = __builtin_amdgcn_exp2f(m[ct] - mn);
          float ls = 0.f;
#pragma unroll
          for (int j = 0; j < 8; j++) if ((vm >> j) & 1) ls += __builtin_amdgcn_exp2f(sc[j] - mn);
          l[ct] = l[ct] * al + ls;
          m[ct] = mn;
        }
        kc_ = kn_;
      }
    }
    float il[2];
#pragma unroll
    for (int ct = 0; ct < 2; ct++) { float lt = quad_sum(l[ct]); il[ct] = lt > 0.f ? 1.f / lt : 0.f; }
#pragma unroll
    for (int dt = 0; dt < 4; dt++)
#pragma unroll
      for (int ct = 0; ct < 2; ct++) o[dt][ct] = f32x4{0.f, 0.f, 0.f, 0.f};
    {
      KF kc_, kn_;
      VF vc_, vn_;
      load_kf(kc_, kcmp, 0, r, quad);
      load_vf(vc_, vcmpT, 512, 0, r, quad);
      for (int st = 0; st < nsteps; st++) {
        const int kb = st * 32;
        const int nkb = min(kb + 32, lastkb);
        load_kf(kn_, kcmp, nkb, r, quad);
        load_vf(vn_, vcmpT, 512, nkb, r, quad);
        f32x4 s[2][2];
        qk_from(kc_, qf, s);
        bf16x8 pf[2];
#pragma unroll
        for (int ct = 0; ct < 2; ct++) {
          float pp[8];
#pragma unroll
          for (int j = 0; j < 8; j++) {
            int n = kb + (j >> 2) * 16 + quad * 4 + (j & 3);
            int ce = n * 16 + 31;
            float sc = s[j >> 2][ct][j & 3] * qs2 - slope * (float)(tok[ct] - ce);
            pp[j] = (ce <= tok[ct]) ? __builtin_amdgcn_exp2f(sc - m[ct]) * il[ct] : 0.f;
            float hs = pp[j];
            hs += __shfl_xor(hs, 1);
            hs += __shfl_xor(hs, 2);
            hs += __shfl_xor(hs, 4);
            if ((r & 7) == 0) impc[(ct * 2 + (r >> 3)) * 512 + n] = hs;
          }
          uint4 u;
          u.x = pack2(pp[0], pp[1]); u.y = pack2(pp[2], pp[3]); u.z = pack2(pp[4], pp[5]); u.w = pack2(pp[6], pp[7]);
          pf[ct] = *(bf16x8*)&u;
        }
        pv_from(vc_, pf, o);
        kc_ = kn_;
        vc_ = vn_;
      }
    }
#pragma unroll
    for (int ct = 0; ct < 2; ct++) {
      float gt = gates[(size_t)tok[ct] * 48 + head * 3 + 0];
#pragma unroll
      for (int dt = 0; dt < 4; dt++)
#pragma unroll
        for (int i = 0; i < 4; i++) oacc[dt][ct][i] += gt * o[dt][ct][i];
    }
  }
  __builtin_amdgcn_s_waitcnt(0);
  __builtin_amdgcn_wave_barrier();
  unsigned long long mlo[4], mhi[4];
  const int cur = t0 >> 6;
#pragma unroll
  for (int tk = 0; tk < 4; tk++) {
    float va, vb;
    {
      int j = lane;
      float s5 = 0.f;
#pragma unroll
      for (int q = -1; q <= 3; q++) { int n = 4 * j + q; if (n >= 0) s5 += impc[tk * 512 + n]; }
      va = (j > cur) ? -1e30f : ((j == 0 || j == cur || j == cur - 1) ? 1e9f : s5);
      j = lane + 64;
      s5 = 0.f;
#pragma unroll
      for (int q = -1; q <= 3; q++) { int n = 4 * j + q; if (n < 512) s5 += impc[tk * 512 + n]; }
      vb = (j > cur) ? -1e30f : ((j == cur || j == cur - 1) ? 1e9f : s5);
    }
    __builtin_amdgcn_wave_barrier();
    vals[lane] = va;
    vals[lane + 64] = vb;
    __builtin_amdgcn_s_waitcnt(0);
    __builtin_amdgcn_wave_barrier();
    int ra_ = 0, rb_ = 0;
    for (int jj = 0; jj <= cur; jj += 4) {
      const float4 x4 = *(const float4*)(vals + jj);
      const float xs_[4] = {x4.x, x4.y, x4.z, x4.w};
#pragma unroll
      for (int e = 0; e < 4; e++) {
        const float x = xs_[e];
        ra_ += (x > va || (x == va && jj + e < lane)) ? 1 : 0;
        rb_ += (x > vb || (x == vb && jj + e < lane + 64)) ? 1 : 0;
      }
    }
    mlo[tk] = __ballot(ra_ < 16);
    mhi[tk] = __ballot(rb_ < 16);
    __builtin_amdgcn_wave_barrier();
  }
  unsigned long long mylo[2], myhi[2];
#pragma unroll
  for (int ct = 0; ct < 2; ct++) {
    int ti = ct * 2 + (r >> 3);
    mylo[ct] = (ti == 0) ? mlo[0] : (ti == 1) ? mlo[1] : (ti == 2) ? mlo[2] : mlo[3];
    myhi[ct] = (ti == 0) ? mhi[0] : (ti == 1) ? mhi[1] : (ti == 2) ? mhi[2] : mhi[3];
  }
  const unsigned long long ulo = mlo[0] | mlo[1] | mlo[2] | mlo[3];
  const unsigned long long uhi = mhi[0] | mhi[1] | mhi[2] | mhi[3];
  {
    m[0] = m[1] = -1e30f; l[0] = l[1] = 0.f;
#pragma unroll
    for (int dt = 0; dt < 4; dt++)
#pragma unroll
      for (int ct = 0; ct < 2; ct++) o[dt][ct] = f32x4{0.f, 0.f, 0.f, 0.f};
    const unsigned long long vlo = (cur >= 63) ? ~0ull : ((1ull << (cur + 1)) - 1ull);
    const unsigned long long vhi = (cur < 64) ? 0ull : ((cur - 64 >= 63) ? ~0ull : ((1ull << (cur - 63)) - 1ull));
    unsigned long long wlo = ulo & vlo, whi = uhi & vhi;
    while ((wlo | whi) != 0ull) {
      int j;
      if (wlo != 0ull) { j = __builtin_ctzll(wlo); wlo &= wlo - 1ull; }
      else { j = 64 + __builtin_ctzll(whi); whi &= whi - 1ull; }
      const int kb = j * 64;
      KF k0_, k1_;
      VF v0_, v1_;
      load_kf(k0_, ksb, kb, r, quad);
      load_kf(k1_, ksb, kb + 32, r, quad);
      load_vf(v0_, vsT, S_, kb, r, quad);
      load_vf(v1_, vsT, S_, kb + 32, r, quad);
      f32x4 s0[2][2], s1[2][2];
      qk_from(k0_, qf, s0);
      qk_from(k1_, qf, s1);
      bf16x8 pfa[2], pfb[2];
#pragma unroll
      for (int ct = 0; ct < 2; ct++) {
        const unsigned bit = (unsigned)(((j < 64) ? (mylo[ct] >> j) : (myhi[ct] >> (j - 64))) & 1ull);
        float sc[16];
        unsigned vm = 0;
#pragma unroll
        for (int q = 0; q < 8; q++) {
          const int pos = kb + (q >> 2) * 16 + quad * 4 + (q & 3);
          sc[q] = s0[q >> 2][ct][q & 3] * qs2 - slope * (float)(tok[ct] - pos);
          sc[8 + q] = s1[q >> 2][ct][q & 3] * qs2 - slope * (float)(tok[ct] - pos - 32);
          if (bit && pos <= tok[ct]) vm |= 1u << q;
          if (bit && pos + 32 <= tok[ct]) vm |= 1u << (8 + q);
        }
        SOFTMAX_UPDATE16(64, ct, sc, vm, m[ct], l[ct], o, pfa[ct], pfb[ct]);
      }
      pv_from(v0_, pfa, o);
      pv_from(v1_, pfb, o);
    }
#pragma unroll
    for (int ct = 0; ct < 2; ct++) {
      float lt = quad_sum(l[ct]);
      float gt = gates[(size_t)tok[ct] * 48 + head * 3 + 1] * (lt > 0.f ? 1.f / lt : 0.f);
#pragma unroll
      for (int dt = 0; dt < 4; dt++)
#pragma unroll
        for (int i = 0; i < 4; i++) oacc[dt][ct][i] += gt * o[dt][ct][i];
    }
  }
  {
    m[0] = m[1] = -1e30f; l[0] = l[1] = 0.f;
#pragma unroll
    for (int dt = 0; dt < 4; dt++)
#pragma unroll
      for (int ct = 0; ct < 2; ct++) o[dt][ct] = f32x4{0.f, 0.f, 0.f, 0.f};
    int start = t0 - 511;
    if (start < 0) start = 0;
    start &= ~31;
    const int lastkb = tlast & ~31;
    KF kc_, kn_;
    VF vc_, vn_;
    load_kf(kc_, kwb, start, r, quad);
    load_vf(vc_, vwT, S_, start, r, quad);
    for (int kb = start; kb <= lastkb; kb += 32) {
      const int nkb = min(kb + 32, lastkb);
      load_kf(kn_, kwb, nkb, r, quad);
      load_vf(vn_, vwT, S_, nkb, r, quad);
      f32x4 s[2][2];
      qk_from(kc_, qf, s);
      bf16x8 pf[2];
#pragma unroll
      for (int ct = 0; ct < 2; ct++) {
        float sc[8];
        unsigned vm = 0;
#pragma unroll
        for (int q = 0; q < 8; q++) {
          int pos = kb + (q >> 2) * 16 + quad * 4 + (q & 3);
          int d = tok[ct] - pos;
          sc[q] = s[q >> 2][ct][q & 3] * qs2 - slope * (float)d;
          if (d >= 0 && d < 512) vm |= 1u << q;
        }
        SOFTMAX_UPDATE(64, 2, ct, sc, vm, m[ct], l[ct], o, pf[ct]);
      }
      pv_from(vc_, pf, o);
      kc_ = kn_;
      vc_ = vn_;
    }
#pragma unroll
    for (int ct = 0; ct < 2; ct++) {
      float lt = quad_sum(l[ct]);
      float gt = gates[(size_t)tok[ct] * 48 + head * 3 + 2] * (lt > 0.f ? 1.f / lt : 0.f);
#pragma unroll
      for (int dt = 0; dt < 4; dt++)
#pragma unroll
        for (int i = 0; i < 4; i++) oacc[dt][ct][i] += gt * o[dt][ct][i];
    }
  }
  const bf16_t* zn = (const bf16_t*)(ws + O_ZN);
  bf16_t* Y = (bf16_t*)(ws + O_Y);
#pragma unroll
  for (int ct = 0; ct < 2; ct++)
#pragma unroll
    for (int dt = 0; dt < 4; dt++) {
      int d = dt * 16 + quad * 4;
      uint2 zz = *(const uint2*)(zn + (size_t)tok[ct] * 1024 + head * 64 + d);
      float z0 = __uint_as_float(zz.x << 16), z1 = __uint_as_float(zz.x & 0xffff0000u);
      float z2 = __uint_as_float(zz.y << 16), z3 = __uint_as_float(zz.y & 0xffff0000u);
      uint2 ov;
      ov.x = pack2(oacc[dt][ct][0] * z0, oacc[dt][ct][1] * z1);
      ov.y = pack2(oacc[dt][ct][2] * z2, oacc[dt][ct][3] * z3);
      *(uint2*)(Y + (size_t)tok[ct] * 2048 + head * 64 + d) = ov;
    }
  __builtin_amdgcn_wave_barrier();
}

__device__ __forceinline__ void mla_block_item(KP p, int hd, int tile, char* smem) {
  char* ws = p->ws;
  const int tid = get_tid(), lane = tid & 63, wave = tid >> 6, r = lane & 15, quad = lane >> 4;
  const bf16_t* qm = (const bf16_t*)(ws + O_QM) + (size_t)hd * S_ * 192;
  const bf16_t* km = (const bf16_t*)(ws + O_KM) + (size_t)hd * S_ * 192;
  const bf16_t* vmT = (const bf16_t*)(ws + O_VMT) + (size_t)hd * 128 * S_;
  bf16_t* Kbuf = (bf16_t*)smem;
  bf16_t* Vbuf = (bf16_t*)(smem + 51200);
  const int t0 = tile * 256 + wave * 32;
  bf16x8 qf[6][2];
  int tok[2];
#pragma unroll
  for (int ct = 0; ct < 2; ct++) {
    tok[ct] = t0 + ct * 16 + r;
#pragma unroll
    for (int ks = 0; ks < 6; ks++) qf[ks][ct] = *(const bf16x8*)(qm + (size_t)tok[ct] * 192 + ks * 32 + quad * 8);
  }
  f32x4 o[8][2];
#pragma unroll
  for (int dt = 0; dt < 8; dt++)
#pragma unroll
    for (int ct = 0; ct < 2; ct++) o[dt][ct] = f32x4{0.f, 0.f, 0.f, 0.f};
  float m[2] = {-1e30f, -1e30f}, l[2] = {0.f, 0.f};
  const float scale = 0.07216878364870322f * 1.4426950408889634f;
  const int nsteps = 4 * (tile + 1);
  const int kr0 = tid / 24, kc0 = (tid % 24) * 8;
  const int kr1 = (tid + 512) / 24, kc1 = ((tid + 512) % 24) * 8;
  const int kr2 = (tid + 1024) / 24, kc2 = ((tid + 1024) % 24) * 8;
  const int vr0 = tid >> 3, vc0 = (tid & 7) * 8;
  const int vr1 = (tid + 512) >> 3;
  uint4 k0r, k1r, k2r, v0r, v1r;
#define MLA_GLOAD(kb_)                                                   \
  {                                                                      \
    k0r = *(const uint4*)(km + (size_t)((kb_) + kr0) * 192 + kc0);       \
    k1r = *(const uint4*)(km + (size_t)((kb_) + kr1) * 192 + kc1);       \
    k2r = *(const uint4*)(km + (size_t)((kb_) + kr2) * 192 + kc2);       \
    v0r = *(const uint4*)(vmT + (size_t)vr0 * S_ + (kb_) + vc0);         \
    v1r = *(const uint4*)(vmT + (size_t)vr1 * S_ + (kb_) + vc0);         \
  }
#define MLA_LSTORE(bi_)                                                  \
  {                                                                      \
    bf16_t* Kb_ = Kbuf + (bi_) * 64 * 200;                               \
    bf16_t* Vb_ = Vbuf + (bi_) * 128 * 72;                               \
    *(uint4*)(Kb_ + kr0 * 200 + kc0) = k0r;                              \
    *(uint4*)(Kb_ + kr1 * 200 + kc1) = k1r;                              \
    *(uint4*)(Kb_ + kr2 * 200 + kc2) = k2r;                              \
    *(uint4*)(Vb_ + vr0 * 72 + vc0) = v0r;                               \
    *(uint4*)(Vb_ + vr1 * 72 + vc0) = v1r;                               \
  }
  __syncthreads();
  MLA_GLOAD(0);
  MLA_LSTORE(0);
  __syncthreads();
  for (int st = 0; st < nsteps; st++) {
    const int kb = st * 64;
    if (st + 1 < nsteps) MLA_GLOAD(kb + 64);
    if (kb <= t0 + 31) {
      const bf16_t* Kb_ = Kbuf + (st & 1) * 64 * 200;
      const bf16_t* Vb_ = Vbuf + (st & 1) * 128 * 72;
#pragma unroll
      for (int hf = 0; hf < 2; hf++) {
        if (kb + hf * 32 <= t0 + 31) {
          f32x4 s[2][2];
          qk_step<192, 2>(Kb_, 200, hf * 32, qf, s, r, quad);
          bf16x8 pf[2];
          if (kb + hf * 32 + 31 <= t0) {
#pragma unroll
            for (int ct = 0; ct < 2; ct++) {
              float sc[8];
              const unsigned vm = 0xffu;
#pragma unroll
              for (int j = 0; j < 8; j++) sc[j] = s[j >> 2][ct][j & 3] * scale;
              SOFTMAX_UPDATE(128, 2, ct, sc, vm, m[ct], l[ct], o, pf[ct]);
            }
          } else {
#pragma unroll
            for (int ct = 0; ct < 2; ct++) {
              float sc[8];
              unsigned vm = 0;
#pragma unroll
              for (int j = 0; j < 8; j++) {
                int key = kb + hf * 32 + (j >> 2) * 16 + quad * 4 + (j & 3);
                sc[j] = s[j >> 2][ct][j & 3] * scale;
                if (key <= tok[ct]) vm |= 1u << j;
              }
              SOFTMAX_UPDATE(128, 2, ct, sc, vm, m[ct], l[ct], o, pf[ct]);
            }
          }
          pv_step<128, 2>(Vb_, 72, hf * 32, pf, o, r, quad);
        }
      }
    }
    if (st + 1 < nsteps) MLA_LSTORE((st + 1) & 1);
    __syncthreads();
  }
  const bf16_t* zm = (const bf16_t*)(ws + O_ZM);
  bf16_t* Y = (bf16_t*)(ws + O_Y);
#pragma unroll
  for (int ct = 0; ct < 2; ct++) {
    float lt = quad_sum(l[ct]);
    float il = lt > 0.f ? 1.f / lt : 0.f;
#pragma unroll
    for (int dt = 0; dt < 8; dt++) {
      int d = dt * 16 + quad * 4;
      const bf16_t* zp = zm + (size_t)tok[ct] * 1024 + hd * 128 + d;
      uint2 zz = *(const uint2*)zp;
      float z0 = __uint_as_float(zz.x << 16), z1 = __uint_as_float(zz.x & 0xffff0000u);
      float z2 = __uint_as_float(zz.y << 16), z3 = __uint_as_float(zz.y & 0xffff0000u);
      uint2 ov;
      ov.x = pack2(o[dt][ct][0] * il * z0, o[dt][ct][1] * il * z1);
      ov.y = pack2(o[dt][ct][2] * il * z2, o[dt][ct][3] * il * z3);
      *(uint2*)(Y + (size_t)tok[ct] * 2048 + 1024 + hd * 128 + d) = ov;
    }
  }
}

__device__ __forceinline__ void phase4(KP p, char* smem, int cidx) {
  const int lane = get_tid() & 63, wave = get_tid() >> 6;
  unsigned int* ctr = (unsigned int*)(p->ws + O_CTR) + cidx;
  for (int item = blockIdx.x; item < 256; item += gridDim.x) {
    int tile = 31 - (item >> 3), hd = item & 7;
    mla_block_item(p, hd, tile, smem);
  }
  __syncthreads();
  float* wsm = (float*)(smem + (size_t)wave * 8704);
  const int NNSA = 4096;
  for (;;) {
    int item = 0;
    if (lane == 0) item = (int)atomicAdd(ctr, 1u);
    item = __builtin_amdgcn_readfirstlane(item);
    if (item >= NNSA) break;
    int tile = 2047 - (item >> 1), g = item & 1;
    nsa_item(p, g, tile, wsm);
  }
}

__device__ __forceinline__ void outproj_phase(KP p, const bf16_t* A, const bf16_t* Bt, const float* xres, int layer, char* smem) {
  const float* gate = (const float*)(p->ws + O_MOD) + layer * 6144 + 4096;
  float* out = p->out;
  auto epiD = [&](f32x4(&acc)[4][4], int row0, int col0) {};
  auto epiS = [&](const float* Cs, int m0, int n0, int tid) {
    STAGE_LOOP4(row, c4, v)
      const size_t idx = (size_t)(m0 + row) * 2048 + n0 + c4;
      const float4 x = ld_nt4(xres + idx);
      const float4 g = *(const float4*)(gate + n0 + c4);
      float4 o;
      o.x = x.x + g.x * v.x; o.y = x.y + g.y * v.y; o.z = x.z + g.z * v.z; o.w = x.w + g.w * v.w;
      *(float4*)(out + idx) = o;
    STAGE_END
  };
  for (int t = blockIdx.x; t < 32 * 8; t += gridDim.x) {
    int pm, pn;
    g8_map(t, 32, 8, pm, pn);
    gemm256_tile(A, 2048, Bt, 2048, 2048, pm * 256, pn * 256, smem, epiS);
  }
}


__device__ __forceinline__ void phase7(KP p, char* smem) {
  char* ws = p->ws;
  auto epiD = [&](f32x4(&acc)[4][4], int row0, int col0) {};
  const int total = 1024 + 64;
  for (int item = blockIdx.x; item < total; item += gridDim.x) {
    if (item >= 1024) {
      const int li = item - 1024;
      int which = li >> 5, mt_ = li & 31;
      bf16_t* dst = (bf16_t*)(ws + (which ? O_LA : O_LW));
      auto epiS = [&](const float* Cs, int m0, int n0, int tid) {
        STAGE_LOOP8(row, c8, va, vb)
          float4 a = va, b = vb;
          if (which == 0) {
            a.x = tanhf(a.x); a.y = tanhf(a.y); a.z = tanhf(a.z); a.w = tanhf(a.w);
            b.x = tanhf(b.x); b.y = tanhf(b.y); b.z = tanhf(b.z); b.w = tanhf(b.w);
          }
          *(uint4*)(dst + (size_t)(m0 + row) * 128 + c8) = pack8(a, b);
        STAGE_END
      };
      gemm_tile<0>((const bf16_t*)(ws + (which ? O_XA : O_XW)), 2048, (const bf16_t*)(ws + (which ? O_WT_A1 : O_WT_W1)), 2048, 2048, mt_ * 256, 0, smem,
                   nullptr, epiD, epiS);
    } else {
      const int prob = item >> 8, tt = item & 255;
      int pm, pn;
      g8_map(tt, 32, 8, pm, pn);
      const size_t woff = prob == 0 ? O_WT_R : prob == 1 ? O_WT_K : prob == 2 ? O_WT_V : O_WT_Z;
      bf16_t* dst = (bf16_t*)(ws + (prob == 0 ? O_R : prob == 1 ? O_K : prob == 2 ? O_V : O_ZS));
      auto epiS = [&](const float* Cs, int m0, int n0, int tid) {
        STAGE_LOOP8(row, c8, va, vb)
          float4 a = va, b = vb;
          if (prob == 3) {
            a.x = siluf(a.x); a.y = siluf(a.y); a.z = siluf(a.z); a.w = siluf(a.w);
            b.x = siluf(b.x); b.y = siluf(b.y); b.z = siluf(b.z); b.w = siluf(b.w);
          }
          *(uint4*)(dst + (size_t)(m0 + row) * 2048 + n0 + c8) = pack8(a, b);
        STAGE_END
      };
      const size_t aoff = prob == 0 ? O_H1 : prob == 1 ? O_XK : prob == 2 ? O_XV : O_XZ;
      gemm256_tile((const bf16_t*)(ws + aoff), 2048, (const bf16_t*)(ws + woff), 2048, 2048, pm * 256, pn * 256, smem, epiS);
    }
  }
}

__device__ __forceinline__ float logdecay_of(float v) {
  return -0.6065306597126334f / (1.f + __expf(-v));
}
__device__ __forceinline__ void phase8(KP p, char* smem) {
  char* ws = p->ws;
  auto epiD = [&](f32x4(&acc)[4][4], int row0, int col0) {};
  for (int item = blockIdx.x; item < 2 * 512; item += gridDim.x) {
    int which = item >> 9, tt = item & 511;
    int mt_ = tt & 31, nt_ = tt >> 5;
    const float* bias = p->in[which ? 29 : 26];
    float* logw = (float*)(ws + O_LOGW);
    bf16_t* ab = (bf16_t*)(ws + O_AB);
    auto epiS = [&](const float* Cs, int m0, int n0, int tid) {
      if (which == 0) {
        STAGE_LOOP4(row, c4, v)
          const float4 b = *(const float4*)(bias + n0 + c4);
          float4 o;
          o.x = logdecay_of(v.x + b.x); o.y = logdecay_of(v.y + b.y); o.z = logdecay_of(v.z + b.z); o.w = logdecay_of(v.w + b.w);
          *(float4*)(logw + (size_t)(m0 + row) * 2048 + n0 + c4) = o;
        STAGE_END
      } else {
        STAGE_LOOP8(row, c8, va, vb)
          const float4 b0 = *(const float4*)(bias + n0 + c8), b1 = *(const float4*)(bias + n0 + c8 + 4);
          float4 a, b;
          a.x = sigmf(va.x + b0.x); a.y = sigmf(va.y + b0.y); a.z = sigmf(va.z + b0.z); a.w = sigmf(va.w + b0.w);
          b.x = sigmf(vb.x + b1.x); b.y = sigmf(vb.y + b1.y); b.z = sigmf(vb.z + b1.z); b.w = sigmf(vb.w + b1.w);
          *(uint4*)(ab + (size_t)(m0 + row) * 2048 + n0 + c8) = pack8(a, b);
        STAGE_END
      }
    };
    gemm_tile<0>((const bf16_t*)(ws + (which ? O_LA : O_LW)), 128, (const bf16_t*)(ws + (which ? O_WT_A2 : O_WT_W2)), 128, 128,
                 mt_ * 256, nt_ * 128, smem, nullptr, epiD, epiS);
  }
}

__device__ __forceinline__ f32x4 mmt(const float* A, int ars, int acs, const float* B, int brs, int bcs, int nks, f32x4 acc,
                                     int lane) {
  const int r = lane & 15, q = lane >> 4;
  const float* ap = A + r * ars + q * acs;
  const float* bp = B + q * brs + r * bcs;
#pragma unroll 4
  for (int ks = 0; ks < nks; ks++) {
    acc = __builtin_amdgcn_mfma_f32_16x16x4f32(ap[4 * ks * acs], bp[4 * ks * brs], acc, 0, 0, 0);
  }
  return acc;
}

__device__ __forceinline__ void phase9(KP p, int half, float* sm) {
  char* ws = p->ws;
  constexpr int LS = 65;
  constexpr int US = 64 * LS;
  float* U0 = sm;
  float* U1 = sm + 1 * US;
  float* U2 = sm + 2 * US;
  float* U3 = sm + 3 * US;
  float* U4 = sm + 4 * US;
  float* U5 = sm + 5 * US;
  float* U6 = sm + 6 * US;
  float* U7 = sm + 7 * US;
  float* U8 = sm + 8 * US;
  float* gC = sm + 9 * US;
  const int tid = get_tid(), lane = tid & 63, wave = tid >> 6, r = lane & 15, quad = lane >> 4;
  const bf16_t* Rb = (const bf16_t*)(ws + O_R);
  const bf16_t* Kb = (const bf16_t*)(ws + O_K);
  const bf16_t* Vb = (const bf16_t*)(ws + O_V);
  const bf16_t* Ab = (const bf16_t*)(ws + O_AB);
  const float* LW = (const float*)(ws + O_LOGW);
  float* bon = (float*)(ws + O_BON);
  float* CHP = (float*)(ws + O_CHP);
  float* CHQ = (float*)(ws + O_CHQ);
  bf16_t* CHG = (bf16_t*)(ws + O_CHG);
  bf16_t* CHY = (bf16_t*)(ws + O_CHY);
  const float* k_k = p->in[32];
  const float* k_a = p->in[33];
  const float* r_k = p->in[34];
  uint4 nR, nK, nV, nA;
  float4 nL0, nL1;
#define P9_PREFETCH(slot_)                                                        \
  {                                                                               \
    const int hl_ = (slot_) >> 7, c_ = (slot_) & 127;                             \
    const size_t gi_ = (size_t)(c_ * 64 + (tid >> 3)) * 2048 + (half * 16 + hl_) * 64 + (tid & 7) * 8; \
    nR = *(const uint4*)(Rb + gi_); nK = *(const uint4*)(Kb + gi_);               \
    nV = *(const uint4*)(Vb + gi_); nA = *(const uint4*)(Ab + gi_);               \
    nL0 = *(const float4*)(LW + gi_); nL1 = *(const float4*)(LW + gi_ + 4);       \
  }
  if ((int)blockIdx.x < 2048) P9_PREFETCH((int)blockIdx.x);
  for (int slot = blockIdx.x; slot < 2048; slot += gridDim.x) {
    const int hl = slot >> 7, c = slot & 127;
    const int hd = half * 16 + hl;
    {
      const int i = tid >> 3, kg = (tid & 7) * 8;
      const int t = c * 64 + i, ch = hd * 64 + kg;
      float rr[8], kk_[8], vv[8], aa[8], lw[8];
      unpack8(nR, rr);
      unpack8(nK, kk_);
      unpack8(nV, vv);
      unpack8(nA, aa);
      {
        float4 l0 = nL0, l1 = nL1;
        { const int ns_ = slot + (int)gridDim.x; P9_PREFETCH(ns_ < 2048 ? ns_ : slot); }
        lw[0] = l0.x; lw[1] = l0.y; lw[2] = l0.z; lw[3] = l0.w; lw[4] = l1.x; lw[5] = l1.y; lw[6] = l1.z; lw[7] = l1.w;
      }
      float kn[8], k2[8];
      float ss = 0.f, bs = 0.f;
#pragma unroll
      for (int j = 0; j < 8; j++) {
        kn[j] = kk_[j] * k_k[ch + j];
        ss += kn[j] * kn[j];
        k2[j] = kk_[j] * (1.f + (aa[j] - 1.f) * k_a[ch + j]);
        bs += rr[j] * k2[j] * r_k[ch + j];
      }
      ss += __shfl_xor(ss, 1); ss += __shfl_xor(ss, 2); ss += __shfl_xor(ss, 4);
      bs += __shfl_xor(bs, 1); bs += __shfl_xor(bs, 2); bs += __shfl_xor(bs, 4);
      const float inrm = 1.f / fmaxf(sqrtf(ss), 1e-12f);
      if ((tid & 7) == 0) bon[(size_t)t * 32 + hd] = bs;
#pragma unroll
      for (int j = 0; j < 8; j++) U5[i * LS + kg + j] = lw[j];
      __syncthreads();
      if (tid < 64) {
        float xs[64];
#pragma unroll
        for (int ii = 0; ii < 64; ii++) xs[ii] = U5[ii * LS + tid];
        float run = 0.f;
#pragma unroll
        for (int ii = 0; ii < 64; ii++) { run += xs[ii]; U5[ii * LS + tid] = run; }
        gC[tid] = __expf(run);
      }
      __syncthreads();
#pragma unroll
      for (int j = 0; j < 8; j++) {
        float L = U5[i * LS + kg + j];
        float Lp = L - lw[j];
        float eL = __expf(L), eLp = __expf(Lp), enL = __expf(-L);
        float kkn = kn[j] * inrm;
        int o = i * LS + kg + j;
        U3[o] = -kkn * eLp;
        U4[o] = rr[j] * eL;
        U0[o] = k2[j] * enL;
        U1[o] = kkn * aa[j] * enL;
        U2[o] = vv[j];
      }
    }
    __syncthreads();
    f32x4 ginit[2];
    {
      const int mI = wave >> 1, hf = wave & 1;
      const float* As_ = (mI < 2) ? U3 : U4;
      const float* Bs_ = (mI & 1) ? U1 : U0;
      float* dst = U5 + mI * US;
#pragma unroll
      for (int pass = 0; pass < 2; pass++) {
        const int it = (pass == 0) ? (hf ? 1 : 0) : (hf ? 2 : 3);
        f32x4 acc4[4];
#pragma unroll
        for (int jt = 0; jt < 4; jt++) acc4[jt] = f32x4{0.f, 0.f, 0.f, 0.f};
        const float* ap = As_ + (it * 16 + r) * LS + quad;
        const float* bp = Bs_ + r * LS + quad;
#pragma unroll 4
        for (int ks = 0; ks < 16; ks++) {
          const float av = ap[4 * ks];
#pragma unroll
          for (int jt = 0; jt < 4; jt++)
            if (jt <= it) acc4[jt] = __builtin_amdgcn_mfma_f32_16x16x4f32(av, bp[jt * 16 * LS + 4 * ks], acc4[jt], 0, 0, 0);
        }
#pragma unroll
        for (int jt = 0; jt < 4; jt++) {
#pragma unroll
          for (int v = 0; v < 4; v++) {
            int i = it * 16 + quad * 4 + v, j = jt * 16 + r;
            bool keep = (mI < 2) ? (j < i) : (j <= i);
            dst[i * LS + j] = keep ? acc4[jt][v] : 0.f;
          }
        }
      }
      const int it = wave >> 1;
#pragma unroll
      for (int x = 0; x < 2; x++) {
        int jt = (wave & 1) * 2 + x;
#pragma unroll
        for (int v = 0; v < 4; v++) ginit[x][v] = U4[(it * 16 + quad * 4 + v) * LS + jt * 16 + r];
      }
    }
    __syncthreads();
    {
      const int it = wave >> 1, jt0 = (wave & 1) * 2;
      f32x4 xa0 = f32x4{0.f, 0.f, 0.f, 0.f}, xa1 = f32x4{0.f, 0.f, 0.f, 0.f};
      const float* ap = U5 + (it * 16 + r) * LS + quad;
      const float* bp = U2 + quad * LS + jt0 * 16 + r;
#pragma unroll 4
      for (int ks = 0; ks < 16; ks++) {
        const float av = ap[4 * ks];
        xa0 = __builtin_amdgcn_mfma_f32_16x16x4f32(av, bp[4 * ks * LS], xa0, 0, 0, 0);
        xa1 = __builtin_amdgcn_mfma_f32_16x16x4f32(av, bp[4 * ks * LS + 16], xa1, 0, 0, 0);
      }
      __syncthreads();
#pragma unroll
      for (int v = 0; v < 4; v++) {
        U5[(it * 16 + quad * 4 + v) * LS + jt0 * 16 + r] = xa0[v];
        U5[(it * 16 + quad * 4 + v) * LS + jt0 * 16 + 16 + r] = xa1[v];
      }
    }
    __syncthreads();
    {
      float* Rb_ = (wave < 4) ? (U3 + wave * 16) : (U5 + (wave - 4) * 16);
#pragma unroll 1
      for (int blk = 0; blk < 4; blk++) {
        f32x4 sv;
#pragma unroll
        for (int v = 0; v < 4; v++) sv[v] = Rb_[(16 * blk + quad * 4 + v) * LS + r];
        {
          const float* ap = U6 + (16 * blk + r) * LS + quad;
          const float* bp = Rb_ + quad * LS + r;
          for (int ks = 0; ks < 4 * blk; ks++)
            sv = __builtin_amdgcn_mfma_f32_16x16x4f32(ap[4 * ks], bp[4 * ks * LS], sv, 0, 0, 0);
        }
        float nd[4][16];
#pragma unroll
        for (int v = 0; v < 4; v++)
#pragma unroll
          for (int i = 0; i < 16; i++) nd[v][i] = U6[(16 * blk + quad * 4 + v) * LS + 16 * blk + i];
#pragma unroll
        for (int i = 0; i < 15; i++) {
          const float ui = __shfl(sv[i & 3], (i >> 2) * 16 + r);
#pragma unroll
          for (int v = 0; v < 4; v++) sv[v] += nd[v][i] * ui;
        }
#pragma unroll
        for (int v = 0; v < 4; v++) Rb_[(16 * blk + quad * 4 + v) * LS + r] = sv[v];
        __builtin_amdgcn_s_waitcnt(0);
        __builtin_amdgcn_wave_barrier();
      }
    }
    __syncthreads();
    {
      const int it = wave >> 1, jt0 = (wave & 1) * 2;
      const size_t sbase = (size_t)slot * 4096;
      f32x4 g_[2], y1[2], y2[2], p_[2], q1[2], q2[2];
#pragma unroll
      for (int x = 0; x < 2; x++) {
        g_[x] = ginit[x];
        y1[x] = y2[x] = p_[x] = q1[x] = q2[x] = f32x4{0.f, 0.f, 0.f, 0.f};
      }
      const float* a_rb = U8 + (it * 16 + r) * LS + quad;
      const float* a_rk = U7 + (it * 16 + r) * LS + quad;
      const float* a_bt = U1 + quad * LS + it * 16 + r;
      const float* a_kt = U0 + quad * LS + it * 16 + r;
      const float* b_w1 = U3 + quad * LS + jt0 * 16 + r;
      const float* b_v = U2 + quad * LS + jt0 * 16 + r;
      const float* b_w2 = U5 + quad * LS + jt0 * 16 + r;
#pragma unroll 2
      for (int ks = 0; ks < 16; ks++) {
        const float arb = a_rb[4 * ks], ark = a_rk[4 * ks], abt = a_bt[4 * ks * LS], akt = a_kt[4 * ks * LS];
#pragma unroll
        for (int x = 0; x < 2; x++) {
          const float w1 = b_w1[4 * ks * LS + 16 * x], vv_ = b_v[4 * ks * LS + 16 * x], w2 = b_w2[4 * ks * LS + 16 * x];
          g_[x] = __builtin_amdgcn_mfma_f32_16x16x4f32(arb, w1, g_[x], 0, 0, 0);
          y1[x] = __builtin_amdgcn_mfma_f32_16x16x4f32(ark, vv_, y1[x], 0, 0, 0);
          y2[x] = __builtin_amdgcn_mfma_f32_16x16x4f32(arb, w2, y2[x], 0, 0, 0);
          p_[x] = __builtin_amdgcn_mfma_f32_16x16x4f32(abt, w1, p_[x], 0, 0, 0);
          q1[x] = __builtin_amdgcn_mfma_f32_16x16x4f32(akt, vv_, q1[x], 0, 0, 0);
          q2[x] = __builtin_amdgcn_mfma_f32_16x16x4f32(abt, w2, q2[x], 0, 0, 0);
        }
      }
#pragma unroll
      for (int x = 0; x < 2; x++) {
#pragma unroll
        for (int v = 0; v < 4; v++) {
          int row = it * 16 + quad * 4 + v, colx = (jt0 + x) * 16 + r;
          size_t o = sbase + row * 64 + colx;
          CHG[o] = f2bf(g_[x][v]);
          CHY[o] = f2bf(y1[x][v] + y2[x][v]);
          float gc = gC[row];
          CHP[o] = gc * (p_[x][v] + (row == colx ? 1.f : 0.f));
          CHQ[o] = gc * (q1[x][v] + q2[x][v]);
        }
      }
    }
    __syncthreads();
  }
}

__device__ __forceinline__ void phase10(KP p, int half, float* sm) {
  char* ws = p->ws;
  if (blockIdx.x >= 64) return;
  const int bidx = blockIdx.x;
  const int hl = bidx >> 2, vs = bidx & 3;
  const int tid = get_tid(), lane = tid & 63, wave = tid >> 6, r = lane & 15, q = lane >> 4;
  const float* CHP = (const float*)(ws + O_CHP);
  const float* CHQ = (const float*)(ws + O_CHQ);
  float* S0 = (float*)(ws + O_S0);
  float* Sb = sm;
  const size_t hbase = (size_t)(hl * 128) * 4096;
  if (wave < 4) {
    const float* Pb = CHP + hbase + (16 * wave + r) * 64 + 16 * q;
    const float* Qb = CHQ + hbase + (16 * wave + 4 * q) * 64 + vs * 16 + r;
    float4 A0, B0, C0, D0, A1, B1, C1, D1, A2, B2, C2, D2, A3, B3, C3, D3;
    f32x4 Q0, Q1, Q2, Q3;
#define PF_S(k_, c_)                                                         \
  {                                                                          \
    __builtin_amdgcn_sched_barrier(0);                                       \
    const size_t so_ = (size_t)min((c_), 127) * 4096;                        \
    A##k_ = *(const float4*)(Pb + so_);                                      \
    B##k_ = *(const float4*)(Pb + so_ + 4);                                  \
    C##k_ = *(const float4*)(Pb + so_ + 8);                                  \
    D##k_ = *(const float4*)(Pb + so_ + 12);                                 \
    Q##k_[0] = Qb[so_]; Q##k_[1] = Qb[so_ + 64]; Q##k_[2] = Qb[so_ + 128]; Q##k_[3] = Qb[so_ + 192]; \
    __builtin_amdgcn_sched_barrier(0);                                       \
  }
    f32x4 st = f32x4{0.f, 0.f, 0.f, 0.f};
#define STEP_S(k_, c_)                                                                         \
  {                                                                                            \
    float* sbuf = Sb + ((c_) & 1) * 16 * 68;                                                   \
    *(float4*)(sbuf + r * 68 + 16 * wave + 4 * q) = float4{st[0], st[1], st[2], st[3]};        \
    float a[16] = {A##k_.x, A##k_.y, A##k_.z, A##k_.w, B##k_.x, B##k_.y, B##k_.z, B##k_.w,      \
                   C##k_.x, C##k_.y, C##k_.z, C##k_.w, D##k_.x, D##k_.y, D##k_.z, D##k_.w};     \
    f32x4 acc = Q##k_;                                                                         \
    asm volatile("s_waitcnt lgkmcnt(0)\n\ts_barrier" ::: "memory");                            \
    f32x4 acc2 = f32x4{0.f, 0.f, 0.f, 0.f};                                                    \
    {                                                                                          \
      const float4 s0_ = *(const float4*)(sbuf + r * 68 + 16 * q), s1_ = *(const float4*)(sbuf + r * 68 + 16 * q + 4);  \
      const float4 s2_ = *(const float4*)(sbuf + r * 68 + 16 * q + 8), s3_ = *(const float4*)(sbuf + r * 68 + 16 * q + 12); \
      const float sv_[16] = {s0_.x, s0_.y, s0_.z, s0_.w, s1_.x, s1_.y, s1_.z, s1_.w, s2_.x, s2_.y, s2_.z, s2_.w, s3_.x, s3_.y, s3_.z, s3_.w}; \
      _Pragma("unroll") for (int ks = 0; ks < 16; ks += 2) {                                   \
        acc = __builtin_amdgcn_mfma_f32_16x16x4f32(a[ks], sv_[ks], acc, 0, 0, 0);              \
        acc2 = __builtin_amdgcn_mfma_f32_16x16x4f32(a[ks + 1], sv_[ks + 1], acc2, 0, 0, 0);    \
      }                                                                                        \
    }                                                                                          \
    PF_S(k_, (c_) + 4)                                                                         \
    _Pragma("unroll") for (int v = 0; v < 4; v++) acc[v] += acc2[v];                           \
    st = acc;                                                                                  \
  }
    PF_S(0, 0) PF_S(1, 1) PF_S(2, 2) PF_S(3, 3)
    for (int c = 0; c < 128; c += 4) {
      STEP_S(0, c) STEP_S(1, c + 1) STEP_S(2, c + 2) STEP_S(3, c + 3)
    }
  } else {
    const int w4 = wave - 4;
    for (int c = 0; c < 128; c++) {
      const float* sbuf = Sb + (c & 1) * 16 * 68;
      asm volatile("s_waitcnt lgkmcnt(0)\n\ts_barrier" ::: "memory");
      float* dst = S0 + hbase + (size_t)c * 4096 + vs * 16;
      const float4 sv4 = *(const float4*)(sbuf + r * 68 + 16 * w4 + 4 * q);
      const int k0_ = 16 * w4 + 4 * q;
      dst[(k0_ + 0) * 64 + r] = sv4.x; dst[(k0_ + 1) * 64 + r] = sv4.y; dst[(k0_ + 2) * 64 + r] = sv4.z; dst[(k0_ + 3) * 64 + r] = sv4.w;
    }
  }
}

__device__ __forceinline__ void phase10b(KP p, int half, float* sm) {
  char* ws = p->ws;
  constexpr int LS = 65;
  float* S0s = sm;
  float* Ys = sm + 64 * LS;
  const int tid = get_tid(), lane = tid & 63, wave = tid >> 6, r = lane & 15, quad = lane >> 4;
  const float* S0 = (const float*)(ws + O_S0);
  const bf16_t* CHG = (const bf16_t*)(ws + O_CHG);
  const bf16_t* CHY = (const bf16_t*)(ws + O_CHY);
  const bf16_t* Vb = (const bf16_t*)(ws + O_V);
  const bf16_t* Zs = (const bf16_t*)(ws + O_ZS);
  const float* bon = (const float*)(ws + O_BON);
  const float* lg = p->in[35];
  const float* lb = p->in[36];
  bf16_t* YR = (bf16_t*)(ws + O_YR);
  for (int slot = blockIdx.x; slot < 2048; slot += gridDim.x) {
    const int hl = slot >> 7, c = slot & 127, hd = half * 16 + hl;
    const size_t sbase = (size_t)slot * 4096;
    __syncthreads();
    for (int e = tid; e < 1024; e += NTHR) {
      const int k = e >> 4, v4 = (e & 15) * 4;
      const float4 f = *(const float4*)(S0 + sbase + k * 64 + v4);
      S0s[k * LS + v4] = f.x; S0s[k * LS + v4 + 1] = f.y; S0s[k * LS + v4 + 2] = f.z; S0s[k * LS + v4 + 3] = f.w;
    }
    const int it = wave >> 1, vt0 = (wave & 1) * 2;
    float a[16];
    {
      const bf16_t* G = CHG + sbase + (16 * it + r) * 64 + 16 * quad;
      unpack8(*(const uint4*)G, a);
      unpack8(*(const uint4*)(G + 8), a + 8);
    }
    f32x4 acc0, acc1;
#pragma unroll
    for (int v = 0; v < 4; v++) {
      acc0[v] = bf2f(CHY[sbase + (16 * it + 4 * quad + v) * 64 + vt0 * 16 + r]);
      acc1[v] = bf2f(CHY[sbase + (16 * it + 4 * quad + v) * 64 + vt0 * 16 + 16 + r]);
    }
    __syncthreads();
#pragma unroll
    for (int ks = 0; ks < 16; ks++) {
      acc0 = __builtin_amdgcn_mfma_f32_16x16x4f32(a[ks], S0s[(16 * quad + ks) * LS + vt0 * 16 + r], acc0, 0, 0, 0);
      acc1 = __builtin_amdgcn_mfma_f32_16x16x4f32(a[ks], S0s[(16 * quad + ks) * LS + vt0 * 16 + 16 + r], acc1, 0, 0, 0);
    }
#pragma unroll
    for (int v = 0; v < 4; v++) {
      Ys[(16 * it + 4 * quad + v) * LS + vt0 * 16 + r] = acc0[v];
      Ys[(16 * it + 4 * quad + v) * LS + vt0 * 16 + 16 + r] = acc1[v];
    }
    __syncthreads();
    {
      const int i = tid >> 3, vg = (tid & 7) * 8;
      const int t = c * 64 + i, ch = hd * 64 + vg;
      float y[8];
      float s = 0.f;
#pragma unroll
      for (int j = 0; j < 8; j++) { y[j] = Ys[i * LS + vg + j]; s += y[j]; }
      s += __shfl_xor(s, 1); s += __shfl_xor(s, 2); s += __shfl_xor(s, 4);
      const float mean = s * (1.f / 64.f);
      float vr = 0.f;
#pragma unroll
      for (int j = 0; j < 8; j++) { float d = y[j] - mean; vr += d * d; }
      vr += __shfl_xor(vr, 1); vr += __shfl_xor(vr, 2); vr += __shfl_xor(vr, 4);
      const float rstd = rsqrtf(vr * (1.f / 64.f) + 64e-5f);
      const float bo = bon[(size_t)t * 32 + hd];
      const size_t gi = (size_t)t * 2048 + ch;
      float vv[8], zz[8];
      unpack8(*(const uint4*)(Vb + gi), vv);
      unpack8(*(const uint4*)(Zs + gi), zz);
      float o[8];
#pragma unroll
      for (int j = 0; j < 8; j++) o[j] = ((y[j] - mean) * rstd * lg[ch + j] + lb[ch + j] + bo * vv[j]) * zz[j];
      uint4 u;
      u.x = pack2(o[0], o[1]); u.y = pack2(o[2], o[3]); u.z = pack2(o[4], o[5]); u.w = pack2(o[6], o[7]);
      *(uint4*)(YR + gi) = u;
    }
  }
}

__device__ __forceinline__ void phase11(KP p) {
  char* ws = p->ws;
  const int lane = get_tid() & 63, wave = get_tid() >> 6;
  const bf16_t* yraw = (const bf16_t*)(ws + O_YRAW);
  const bf16_t* Vb = (const bf16_t*)(ws + O_V);
  const bf16_t* Zs = (const bf16_t*)(ws + O_ZS);
  const float* bon = (const float*)(ws + O_BON);
  const float* lg = p->in[35];
  const float* lb = p->in[36];
  bf16_t* YR = (bf16_t*)(ws + O_YR);
  for (int t = blockIdx.x * 8 + wave; t < S_; t += gridDim.x * 8) {
    const size_t base = (size_t)t * 2048 + lane * 32;
    float y[32];
#pragma unroll
    for (int x = 0; x < 4; x++) unpack8(*(const uint4*)(yraw + base + 8 * x), y + 8 * x);
    float s = 0.f;
#pragma unroll
    for (int x = 0; x < 32; x++) s += y[x];
    s += __shfl_xor(s, 1);
    float mean = s * (1.f / 64.f);
    float vr = 0.f;
#pragma unroll
    for (int x = 0; x < 32; x++) { float d = y[x] - mean; vr += d * d; }
    vr += __shfl_xor(vr, 1);
    float rstd = rsqrtf(vr * (1.f / 64.f) + 64e-5f);
    float bo = bon[(size_t)t * 32 + (lane >> 1)];
#pragma unroll
    for (int x = 0; x < 4; x++) {
      float vv[8], zz[8];
      unpack8(*(const uint4*)(Vb + base + 8 * x), vv);
      unpack8(*(const uint4*)(Zs + base + 8 * x), zz);
      float o[8];
#pragma unroll
      for (int j = 0; j < 8; j++) {
        int ch = lane * 32 + 8 * x + j;
        o[j] = ((y[8 * x + j] - mean) * rstd * lg[ch] + lb[ch] + bo * vv[j]) * zz[j];
      }
      uint4 u;
      u.x = pack2(o[0], o[1]); u.y = pack2(o[2], o[3]); u.z = pack2(o[4], o[5]); u.w = pack2(o[6], o[7]);
      *(uint4*)(YR + base + 8 * x) = u;
    }
  }
}

__device__ __forceinline__ void phase13(KP p) {
  const int lane = get_tid() & 63, wave = get_tid() >> 6;
  const float* g = p->in[5];
  for (int row = blockIdx.x * 8 + wave; row < S_; row += gridDim.x * 8) {
    float* xr = p->out + (size_t)row * 2048;
    float4 v[8];
    float ss = 0.f;
#pragma unroll
    for (int j = 0; j < 8; j++) {
      v[j] = *(const float4*)(xr + lane * 4 + 256 * j);
      ss += v[j].x * v[j].x + v[j].y * v[j].y + v[j].z * v[j].z + v[j].w * v[j].w;
    }
    ss = wave_sum(ss);
    float rstd = rsqrtf(ss * (1.f / 2048.f) + 1e-6f);
#pragma unroll
    for (int j = 0; j < 8; j++) {
      int col = lane * 4 + 256 * j;
      float4 gg = *(const float4*)(g + col);
      float4 o;
      o.x = v[j].x * rstd * gg.x; o.y = v[j].y * rstd * gg.y; o.z = v[j].z * rstd * gg.z; o.w = v[j].w * rstd * gg.w;
      __builtin_nontemporal_store(f32x4{o.x, o.y, o.z, o.w}, (f32x4*)(xr + col));
    }
  }
}

#include <vector>

#define XB_TMO      128
#define XB_XCNT(j)  (256  + 64 * (j))
#define XB_XSUB(j)  (1280 + 64 * (j))
#define XB_XGEN(j)  (2304 + 64 * (j))
#define XB_TOP      3328
#define XB_TOPGEN   3392
#define XCD_BAR_WORDS 3456
#define XB_SPIN_CAP (1u << 18)
#define LAS __attribute__((address_space(3)))

__device__ __forceinline__ unsigned xb_ld(unsigned* p)              { return __hip_atomic_load(p, __ATOMIC_RELAXED, __HIP_MEMORY_SCOPE_AGENT); }
__device__ __forceinline__ unsigned xb_add(unsigned* p, unsigned v) { return __hip_atomic_fetch_add(p, v, __ATOMIC_RELAXED, __HIP_MEMORY_SCOPE_AGENT); }
__device__ __forceinline__ unsigned xb_xcc_id() { return (unsigned)__builtin_amdgcn_s_getreg((3 << 11) | 20) & 0xFu; }
#define XB_SPIN(cond, bar) do { unsigned _sp = 0; while (cond) { __builtin_amdgcn_s_sleep(1); \
    if ((++_sp & 255u) == 0u) { if (xb_ld(&(bar)[XB_TMO])) break; if (_sp > XB_SPIN_CAP) { atomicAdd(&(bar)[XB_TMO], 1u); break; } } } } while (0)

struct XcdBarrier {
    unsigned* bar; unsigned x;
    volatile LAS unsigned* st;
};

__device__ __forceinline__ XcdBarrier xcd_barrier_post(unsigned* bar, volatile LAS unsigned* st) {
    XcdBarrier b; b.bar = bar; b.x = xb_xcc_id(); b.st = st;
    if (threadIdx.x == 0) (void)xb_add(&bar[XB_XCNT(b.x)], 1u);
    return b;
}
__device__ __forceinline__ void xcd_barrier_complete(unsigned* bar, unsigned x, unsigned& nloc, unsigned& nx) {
    const unsigned G = gridDim.x * gridDim.y * gridDim.z;
    unsigned sum, cnt, mine, sp = 0u;
    for (;;) {
        sum = 0u; cnt = 0u; mine = 0u;
#pragma unroll
        for (unsigned j = 0; j < 16; ++j) { const unsigned c = xb_ld(&bar[XB_XCNT(j)]); sum += c; cnt += (c > 0u) ? 1u : 0u; mine = (j == x) ? c : mine; }
        if (sum == G) break;
        __builtin_amdgcn_s_sleep(1);
        if ((++sp & 255u) == 0u) { if (xb_ld(&bar[XB_TMO])) break; if (sp > XB_SPIN_CAP) { atomicAdd(&bar[XB_TMO], 1u); break; } }
    }
    nloc = mine > 0u ? mine : 1u; nx = cnt > 0u ? cnt : 1u;
}

__device__ __forceinline__ void xcd_barrier(const XcdBarrier& b) {
    asm volatile("s_waitcnt vmcnt(0)" ::: "memory");
    __syncthreads();
    if (threadIdx.x == 0) {
        unsigned* bar = b.bar;
        __builtin_amdgcn_s_waitcnt(0);
        unsigned nloc = b.st[0], nx = b.st[1];
        if (nloc == 0u) { xcd_barrier_complete(bar, b.x, nloc, nx); b.st[0] = nloc; b.st[1] = nx; }
        const unsigned old = xb_add(&bar[XB_XSUB(b.x)], 1u);
        const unsigned gen = old / nloc;
        if (old + 1u == (gen + 1u) * nloc) {
            __builtin_amdgcn_fence(__ATOMIC_RELEASE, "agent");
            asm volatile("s_waitcnt vmcnt(0)" ::: "memory");
            const unsigned og = xb_add(&bar[XB_TOP], 1u);
            const unsigned tg = og / nx;
            if (og + 1u == (tg + 1u) * nx) xb_add(&bar[XB_TOPGEN], 1u);
            else XB_SPIN(xb_ld(&bar[XB_TOPGEN]) == tg, bar);
            __builtin_amdgcn_fence(__ATOMIC_ACQUIRE, "agent");
            xb_add(&bar[XB_XGEN(b.x)], 1u);
            asm volatile("s_waitcnt vmcnt(0)" ::: "memory");
        } else {
            XB_SPIN(xb_ld(&bar[XB_XGEN(b.x)]) == gen, bar);
            __builtin_amdgcn_fence(__ATOMIC_ACQUIRE, "agent");
            asm volatile("s_waitcnt vmcnt(0)" ::: "memory");
        }
    }
    __syncthreads();
}

__global__ void __launch_bounds__(NTHR) fwd_megakernel(Params p_unused) {
  extern __shared__ __attribute__((aligned(16))) char smem[];
  cg::grid_group grid = cg::this_grid();
  float* smf = (float*)smem;
  KP p = (KP)__builtin_amdgcn_kernarg_segment_ptr();
#define LAUNDER() asm volatile("" : "+s"(p))
  {
    volatile LAS unsigned* st0 = (volatile LAS unsigned*)(smem + 150528);
    if (threadIdx.x == 0) { st0[0] = 0u; st0[1] = 0u; st0[2] = 0u; st0[3] = 0u; }
    __syncthreads();
    (void)xcd_barrier_post((unsigned*)(p->ws + O_BAR), st0);
  }
#define GRID_BARRIER()                                                       \
  {                                                                          \
    XcdBarrier xb_;                                                          \
    xb_.bar = (unsigned*)(p->ws + O_BAR);                                    \
    xb_.x = xb_xcc_id();                                                     \
    xb_.st = (volatile LAS unsigned*)(smem + 150528);                        \
    xcd_barrier(xb_);                                                        \
  }
  phase0(p, smf);
  if (p->out == nullptr) grid.sync();
  GRID_BARRIER();
  LAUNDER();
  norm_phase(p, 0, p->in[0], (bf16_t*)(p->ws + O_H0), smf);
  GRID_BARRIER();
  LAUNDER();
  phase2(p, smem);
  GRID_BARRIER();
  LAUNDER();
  phase3(p, smem);
  GRID_BARRIER();
  LAUNDER();
  phase4(p, smem, 0);
  GRID_BARRIER();
  LAUNDER();
  outproj_phase(p, (const bf16_t*)(p->ws + O_Y), (const bf16_t*)(p->ws + O_WT_OUT), p->in[0], 0, smem);
  GRID_BARRIER();
  LAUNDER();
#if PROBE == 1
  phase2(p, smem);
  GRID_BARRIER();
  LAUNDER();
  phase3(p, smem);
  GRID_BARRIER();
  LAUNDER();
  phase4(p, smem, 1);
  GRID_BARRIER();
  LAUNDER();
  outproj_phase(p, (const bf16_t*)(p->ws + O_Y), (const bf16_t*)(p->ws + O_WT_OUT), p->in[0], 0, smem);
  GRID_BARRIER();
  LAUNDER();
#endif
#if PROBE == 2
  phase4(p, smem, 1);
  GRID_BARRIER();
  LAUNDER();
#endif
  norm_shift_phase(p, smf);
  GRID_BARRIER();
  LAUNDER();
  phase7(p, smem);
  GRID_BARRIER();
  LAUNDER();
  phase8(p, smem);
  GRID_BARRIER();
  LAUNDER();
  for (int half = 0; half < 2; half++) {
    phase9(p, half, smf);
    GRID_BARRIER();
    LAUNDER();
    phase10(p, half, smf);
    GRID_BARRIER();
    LAUNDER();
    phase10b(p, half, smf);
    GRID_BARRIER();
    LAUNDER();
  }
  outproj_phase(p, (const bf16_t*)(p->ws + O_YR), (const bf16_t*)(p->ws + O_WT_O), p->out, 1, smem);
  GRID_BARRIER();
  LAUNDER();
  phase13(p);
}

extern "C" void kernel_launch(void* const* d_in, const int* in_sizes, int n_in, void* d_out, int out_size, void* d_ws,
                              size_t ws_size, hipStream_t stream) {
  static int grid_blocks = 0;
  if (!grid_blocks) {
    int dev = 0, cus = 0, per_cu = 0;
    hipGetDevice(&dev);
    hipDeviceGetAttribute(&cus, hipDeviceAttributeMultiprocessorCount, dev);
    hipFuncSetAttribute((const void*)fwd_megakernel, hipFuncAttributeMaxDynamicSharedMemorySize, LDS_BYTES);
    hipOccupancyMaxActiveBlocksPerMultiprocessor(&per_cu, (const void*)fwd_megakernel, NTHR, LDS_BYTES);
    if (per_cu < 1) per_cu = 1;
    grid_blocks = cus * per_cu;
    if (ws_size < WS_NEED) fprintf(stderr, "workspace too small: %zu < %zu\n", ws_size, (size_t)WS_NEED);
  }
  Params hp{};
  for (int i = 0; i < 37; i++) hp.in[i] = (const float*)d_in[i];
  hp.out = (float*)d_out;
  hp.ws = (char*)d_ws;
  (void)hipMemsetAsync((char*)d_ws + O_BAR, 0, XCD_BAR_WORDS * sizeof(unsigned), stream);
  void* args[] = {&hp};
  hipError_t e = hipLaunchCooperativeKernel((const void*)fwd_megakernel, dim3(grid_blocks), dim3(NTHR), args, LDS_BYTES, stream);
  if (e != hipSuccess) fprintf(stderr, "cooperative launch failed: %s (grid %d)\n", hipGetErrorString(e), grid_blocks);
}
```
